# Optimizing an MI355X kernel written in HIP

```python
import math
import jax, jax.numpy as jnp
from jax import lax
import numpy as np

D_MODEL = 2048
BATCH = 8
SEQ = 2048
DEPTH = 4

GRID_W = 64
CTX_LEN = 256
N_MIXERS = 2
N_MODS = 6
RMS_EPS = 1e-6
NEG_INF = -1e30
HEAD_DIM = 128
N_Q_HEADS = D_MODEL // HEAD_DIM
N_KV_HEADS = 4
GQA_GROUP = N_Q_HEADS // N_KV_HEADS
WINDOW = 128
ATTN_BLOCK = 128
ROPE_BASE = 10000.0
HY_ORDER = 2
HY_SHORT_W = 3
HY_EMB_BANDS = 16
HY_EMB_DIM = 1 + 2 * HY_EMB_BANDS
HY_FILTER_HIDDEN = 64
HY_INNER_MLPS = 2
HY_MOD_SHIFT = 0.05
HY_N_DIR = 2
PEER_HEADS = 8
PEER_N_KEYS = 128
PEER_N_EXPERTS = PEER_N_KEYS * PEER_N_KEYS
PEER_D_KEY = 256
PEER_HALF = PEER_D_KEY // 2
PEER_TOPK = 16
PEER_CHUNK = 128

N_ATTN_LAYERS = (DEPTH + N_MIXERS - 1) // N_MIXERS
N_HYENA_LAYERS = DEPTH // N_MIXERS

kernel_name = "hybrid_swa_hyena_peer_dit"


def rms_norm(x, g):
    xf = x.astype(jnp.float32)
    y = xf * lax.rsqrt(jnp.mean(xf * xf, axis=-1, keepdims=True) + RMS_EPS)
    return (y * g.astype(jnp.float32)).astype(x.dtype)


def modulate(h, g, shift, scale):
    return rms_norm(h, g) * (1 + scale) + shift


def axial_rope_tables(seq_len):
    rows = seq_len // GRID_W
    row = jnp.repeat(jnp.arange(rows), GRID_W).astype(jnp.float32)
    col = jnp.tile(jnp.arange(GRID_W), rows).astype(jnp.float32)
    n_freq = HEAD_DIM // 4
    inv = ROPE_BASE ** (-jnp.arange(n_freq, dtype=jnp.float32) / n_freq)
    ar, ac = row[:, None] * inv, col[:, None] * inv
    ang = jnp.concatenate([ar, ar, ac, ac], axis=-1)
    return jnp.cos(ang), jnp.sin(ang)


def apply_rope(x, cos, sin):
    x1, x2, x3, x4 = jnp.split(x, 4, axis=-1)
    rot = jnp.concatenate([-x2, x1, -x4, x3], axis=-1)
    out = x.astype(jnp.float32) * cos[:, None, :] + rot.astype(jnp.float32) * sin[:, None, :]
    return out.astype(x.dtype)


def sink_softmax(s, sink):
    m = jnp.maximum(jnp.max(s, axis=-1, keepdims=True), sink)
    p = jnp.exp(s - m)
    return p / (jnp.sum(p, axis=-1, keepdims=True) + jnp.exp(sink - m))


def windowed_gqa_with_sink(h_lat, h_ctx, w_qkv, w_o, sink, with_ctx_queries):
    B, L, _ = h_lat.shape
    C = h_ctx.shape[1]
    nb = L // ATTN_BLOCK
    qd, kvd = N_Q_HEADS * HEAD_DIM, N_KV_HEADS * HEAD_DIM
    scale = HEAD_DIM ** -0.5
    sink = sink.astype(jnp.float32).reshape(N_KV_HEADS, GQA_GROUP, 1, 1)

    q_l, k_l, v_l = jnp.split(h_lat @ w_qkv, [qd, qd + kvd], axis=-1)
    cos, sin = axial_rope_tables(L)
    q_l = apply_rope(q_l.reshape(B, L, N_Q_HEADS, HEAD_DIM), cos, sin)
    k_l = apply_rope(k_l.reshape(B, L, N_KV_HEADS, HEAD_DIM), cos, sin)
    v_l = v_l.reshape(B, L, N_KV_HEADS, HEAD_DIM)

    k_c, v_c = jnp.split(h_ctx @ w_qkv[:, qd:], 2, axis=-1)
    k_c = k_c.reshape(B, C, N_KV_HEADS, HEAD_DIM)
    v_c = v_c.reshape(B, C, N_KV_HEADS, HEAD_DIM)

    qb = q_l.reshape(B, nb, ATTN_BLOCK, N_KV_HEADS, GQA_GROUP, HEAD_DIM)

    def band(t):
        tp = jnp.pad(t, ((0, 0), (ATTN_BLOCK, ATTN_BLOCK), (0, 0), (0, 0)))
        tp = tp.reshape(B, nb + 2, ATTN_BLOCK, N_KV_HEADS, HEAD_DIM)
        return jnp.concatenate([tp[:, :-2], tp[:, 1:-1], tp[:, 2:]], axis=2)

    kw, vw = band(k_l), band(v_l)
    s_win = jnp.einsum('bnqhgd,bnkhd->bnhgqk', qb, kw, preferred_element_type=jnp.float32) * scale
    a = jnp.arange(ATTN_BLOCK)[:, None]
    kb = jnp.arange(3 * ATTN_BLOCK)[None, :]
    near = jnp.abs(kb - a - ATTN_BLOCK) <= WINDOW
    kpos = (jnp.arange(nb)[:, None, None] - 1) * ATTN_BLOCK + kb[None]
    valid = near[None] & (kpos >= 0) & (kpos < L)
    s_win = jnp.where(valid[None, :, None, None], s_win, NEG_INF)
    s_ctx = jnp.einsum('bnqhgd,bkhd->bnhgqk', qb, k_c, preferred_element_type=jnp.float32) * scale

    p = sink_softmax(jnp.concatenate([s_win, s_ctx], axis=-1), sink).astype(v_l.dtype)
    p_win, p_ctx = p[..., :3 * ATTN_BLOCK], p[..., 3 * ATTN_BLOCK:]
    o = (jnp.einsum('bnhgqk,bnkhd->bnqhgd', p_win, vw)
         + jnp.einsum('bnhgqk,bkhd->bnqhgd', p_ctx, v_c))
    y_lat = o.reshape(B, L, qd) @ w_o

    y_ctx = None
    if with_ctx_queries:
        q_c = (h_ctx @ w_qkv[:, :qd]).reshape(B, C, N_KV_HEADS, GQA_GROUP, HEAD_DIM)
        s_cc = jnp.einsum('bqhgd,bkhd->bhgqk', q_c, k_c, preferred_element_type=jnp.float32) * scale
        p_cc = sink_softmax(s_cc, sink).astype(v_c.dtype)
        y_ctx = jnp.einsum('bhgqk,bkhd->bqhgd', p_cc, v_c).reshape(B, C, qd) @ w_o
    return y_lat, y_ctx


def centred_short_conv(x, w, b):
    L = x.shape[1]
    r = HY_SHORT_W // 2
    xp = jnp.pad(x, ((0, 0), (r, r), (0, 0)))
    out = b
    for j in range(HY_SHORT_W):
        out = out + xp[:, j:j + L] * w[j]
    return out


def hyena_filter_spectra(L, f_w1, f_b1, f_w2, f_b2, f_w3, decay):
    f32 = jnp.float32
    t = jnp.arange(L, dtype=f32)
    t01 = t / L
    bands = jnp.arange(1, HY_EMB_BANDS + 1, dtype=f32)
    ang = 2.0 * math.pi * t[:, None] * bands[None, :] / L
    z = jnp.concatenate([t01[:, None], jnp.cos(ang), jnp.sin(ang)], axis=-1)
    h = jnp.sin(z @ f_w1.astype(f32) + f_b1.astype(f32))
    for i in range(HY_INNER_MLPS):
        h = jnp.sin(h @ f_w2[i].astype(f32) + f_b2[i].astype(f32))
    h = (h @ f_w3.astype(f32)).reshape(L, HY_ORDER, HY_N_DIR, D_MODEL)
    window = jnp.exp(-t01[:, None, None] * jnp.abs(decay.astype(f32))[None]) + HY_MOD_SHIFT
    h = h * window[:, :, None, :]
    fwd, bwd = h[:, :, 0], h[:, :, 1]
    filt2l = jnp.concatenate([fwd, jnp.zeros((1, HY_ORDER, D_MODEL), f32), bwd[1:][::-1]], axis=0)
    return jnp.fft.rfft(filt2l, axis=0)


def long_conv(z, spec, bias):
    L = z.shape[1]
    zf = z.astype(jnp.float32)
    y = jnp.fft.irfft(jnp.fft.rfft(zf, n=2 * L, axis=1) * spec[None], n=2 * L, axis=1)[:, :L]
    return (y + zf * bias.astype(jnp.float32)).astype(z.dtype)


def hyena_sequence(h, w_in, conv_w, conv_b, f_w1, f_b1, f_w2, f_b2, f_w3, decay, fbias, w_out):
    L = h.shape[1]
    u = centred_short_conv(h @ w_in, conv_w, conv_b)
    v, x1, x2 = jnp.split(u, 3, axis=-1)
    spec = hyena_filter_spectra(L, f_w1, f_b1, f_w2, f_b2, f_w3, decay)
    z = x1 * long_conv(v, spec[:, 0], fbias[0])
    y = x2 * long_conv(z, spec[:, 1], fbias[1])
    return y @ w_out


def peer_ffn(h, w_q, keys1, keys2, u_tab, v_tab):
    B, L, D = h.shape
    chunks = h.reshape((B * L) // PEER_CHUNK, PEER_CHUNK, D)

    def one_chunk(xc):
        q = (xc @ w_q).reshape(PEER_CHUNK, PEER_HEADS, PEER_D_KEY)
        q1, q2 = q[..., :PEER_HALF], q[..., PEER_HALF:]
        s1 = jnp.einsum('chd,hkd->chk', q1, keys1, preferred_element_type=jnp.float32)
        s2 = jnp.einsum('chd,hkd->chk', q2, keys2, preferred_element_type=jnp.float32)
        v1, i1 = lax.top_k(s1, PEER_TOPK)
        v2, i2 = lax.top_k(s2, PEER_TOPK)
        cand_s = (v1[..., :, None] + v2[..., None, :]).reshape(PEER_CHUNK, PEER_HEADS, PEER_TOPK * PEER_TOPK)
        cand_i = (i1[..., :, None] * PEER_N_KEYS + i2[..., None, :]).reshape(PEER_CHUNK, PEER_HEADS, PEER_TOPK * PEER_TOPK)
        top_s, pos = lax.top_k(cand_s, PEER_TOPK)
        idx = jnp.take_along_axis(cand_i, pos, axis=-1)
        g = jax.nn.softmax(top_s, axis=-1)
        u = jnp.take(u_tab, idx, axis=0)
        act = jax.nn.gelu(jnp.einsum('chkd,cd->chk', u, xc, preferred_element_type=jnp.float32), approximate=False)
        v = jnp.take(v_tab, idx, axis=0)
        return jnp.einsum('chk,chkd->cd', (g * act).astype(xc.dtype), v)

    return lax.map(one_chunk, chunks).reshape(B, L, D)


def setup_inputs(seed: int = 0) -> dict:
    key = jax.random.key(seed)
    ks = jax.random.split(key, 32)
    f32 = jnp.float32
    D = D_MODEL
    qkv_w = N_Q_HEADS * HEAD_DIM + 2 * N_KV_HEADS * HEAD_DIM

    def nrm(k, shape, s):
        return jax.random.normal(k, shape, f32) * s

    decay_base = jnp.abs(jnp.linspace(math.log(1e-2) / 0.3, math.log(1e-2) / 1.5, D, dtype=f32))
    return {
        "x": nrm(ks[0], (BATCH, SEQ, D), 1.0),
        "c": nrm(ks[1], (BATCH, D), 1.0),
        "ctx": nrm(ks[2], (BATCH, CTX_LEN, D), 1.0),
        "c_ctx": nrm(ks[3], (D,), 1.0),
        "ada_w": nrm(ks[4], (DEPTH, D, N_MODS * D), 0.5 * D ** -0.5),
        "ada_b": nrm(ks[5], (DEPTH, N_MODS * D), 0.02),
        "norm_mix_g": 1.0 + nrm(ks[6], (DEPTH, D), 0.02),
        "norm_ffn_g": 1.0 + nrm(ks[7], (DEPTH, D), 0.02),
        "final_g": 1.0 + nrm(ks[8], (D,), 0.02),
        "attn_w_qkv": nrm(ks[9], (N_ATTN_LAYERS, D, qkv_w), D ** -0.5),
        "attn_w_o": nrm(ks[10], (N_ATTN_LAYERS, N_Q_HEADS * HEAD_DIM, D), (N_Q_HEADS * HEAD_DIM) ** -0.5),
        "attn_sink": nrm(ks[11], (N_ATTN_LAYERS, N_Q_HEADS), 1.0),
        "hy_w_in": nrm(ks[12], (N_HYENA_LAYERS, D, 3 * D), D ** -0.5),
        "hy_conv_w": nrm(ks[13], (N_HYENA_LAYERS, HY_SHORT_W, 3 * D), HY_SHORT_W ** -0.5),
        "hy_conv_b": nrm(ks[14], (N_HYENA_LAYERS, 3 * D), 0.02),
        "hy_f_w1": nrm(ks[15], (N_HYENA_LAYERS, HY_EMB_DIM, HY_FILTER_HIDDEN), HY_EMB_DIM ** -0.5),
        "hy_f_b1": nrm(ks[16], (N_HYENA_LAYERS, HY_FILTER_HIDDEN), 0.1),
        "hy_f_w2": nrm(ks[17], (N_HYENA_LAYERS, HY_INNER_MLPS, HY_FILTER_HIDDEN, HY_FILTER_HIDDEN), HY_FILTER_HIDDEN ** -0.5),
        "hy_f_b2": nrm(ks[18], (N_HYENA_LAYERS, HY_INNER_MLPS, HY_FILTER_HIDDEN), 0.1),
        "hy_f_w3": nrm(ks[19], (N_HYENA_LAYERS, HY_FILTER_HIDDEN, HY_ORDER * HY_N_DIR * D), 0.01),
        "hy_decay": decay_base[None, None, :] * (1.0 + nrm(ks[20], (N_HYENA_LAYERS, HY_ORDER, D), 0.05)),
        "hy_fbias": nrm(ks[21], (N_HYENA_LAYERS, HY_ORDER, D), 0.1),
        "hy_w_out": nrm(ks[22], (N_HYENA_LAYERS, D, D), D ** -0.5),
        "peer_w_q": nrm(ks[23], (DEPTH, D, PEER_HEADS * PEER_D_KEY), D ** -0.5),
        "peer_keys1": nrm(ks[24], (DEPTH, PEER_HEADS, PEER_N_KEYS, PEER_HALF), PEER_HALF ** -0.5),
        "peer_keys2": nrm(ks[25], (DEPTH, PEER_HEADS, PEER_N_KEYS, PEER_HALF), PEER_HALF ** -0.5),
        "peer_u": nrm(ks[26], (DEPTH, PEER_N_EXPERTS, D), D ** -0.5),
        "peer_v": nrm(ks[27], (DEPTH, PEER_N_EXPERTS, D), 0.25),
    }


def reference(x, c, ctx, c_ctx, ada_w, ada_b, norm_mix_g, norm_ffn_g, final_g,
              attn_w_qkv, attn_w_o, attn_sink,
              hy_w_in, hy_conv_w, hy_conv_b, hy_f_w1, hy_f_b1, hy_f_w2, hy_f_b2, hy_f_w3,
              hy_decay, hy_fbias, hy_w_out,
              peer_w_q, peer_keys1, peer_keys2, peer_u, peer_v):
    D = D_MODEL
    last_attn = max(i for i in range(DEPTH) if i % N_MIXERS == 0)
    cond_lat = jax.nn.silu(c)[:, None, :]
    cond_ctx = jax.nn.silu(c_ctx)[None, None, :]
    h_lat, h_ctx = x, ctx
    for i in range(DEPTH):
        is_attn = (i % N_MIXERS) == 0
        j = i // N_MIXERS
        ctx_update = i < last_attn
        sh1, sc1, g1, sh2, sc2, g2 = jnp.split(cond_lat @ ada_w[i] + ada_b[i], N_MODS, axis=-1)
        a_lat = modulate(h_lat, norm_mix_g[i], sh1, sc1)
        if ctx_update:
            csh1, csc1, cg1, csh2, csc2, cg2 = jnp.split(cond_ctx @ ada_w[i] + ada_b[i], N_MODS, axis=-1)
        else:
            csh1, csc1 = jnp.split(cond_ctx @ ada_w[i][:, :2 * D] + ada_b[i][:2 * D], 2, axis=-1)

        if is_attn:
            a_ctx = modulate(h_ctx, norm_mix_g[i], csh1, csc1)
            y_lat, y_ctx = windowed_gqa_with_sink(a_lat, a_ctx, attn_w_qkv[j], attn_w_o[j],
                                                  attn_sink[j], ctx_update)
        else:
            hy_args = (hy_w_in[j], hy_conv_w[j], hy_conv_b[j], hy_f_w1[j], hy_f_b1[j], hy_f_w2[j],
                       hy_f_b2[j], hy_f_w3[j], hy_decay[j], hy_fbias[j], hy_w_out[j])
            y_lat = hyena_sequence(a_lat, *hy_args)
            y_ctx = None
            if ctx_update:
                a_ctx = modulate(h_ctx, norm_mix_g[i], csh1, csc1)
                y_ctx = hyena_sequence(a_ctx, *hy_args)

        peer_args = (peer_w_q[i], peer_keys1[i], peer_keys2[i], peer_u[i], peer_v[i])
        h_lat = h_lat + g1 * y_lat
        h_lat = h_lat + g2 * peer_ffn(modulate(h_lat, norm_ffn_g[i], sh2, sc2), *peer_args)
        if ctx_update:
            h_ctx = h_ctx + cg1 * y_ctx
            h_ctx = h_ctx + cg2 * peer_ffn(modulate(h_ctx, norm_ffn_g[i], csh2, csc2), *peer_args)
    return rms_norm(h_lat, final_g)
```

```cpp
#include <hip/hip_runtime.h>
#include <stdint.h>
#include <stdio.h>

typedef unsigned short bf16_t;
typedef short bf16x8 __attribute__((ext_vector_type(8)));
typedef float f32x4 __attribute__((ext_vector_type(4)));
typedef unsigned u32x4 __attribute__((ext_vector_type(4)));
typedef unsigned u32x2 __attribute__((ext_vector_type(2)));

#define DI __device__ __forceinline__

constexpr int DM = 2048;
constexpr int NB = 8;
constexpr int SEQ = 2048;
constexpr int CTX = 256;
constexpr int T_LAT = NB * SEQ;
constexpr int T_CTX = NB * CTX;
constexpr int T_ALL = T_LAT + T_CTX;
constexpr int NMOD = 6;
constexpr int HD = 128, NQH = 16, NKVH = 4;
constexpr int QKVW = 3072;
constexpr int PH = 8, PNK = 128, PTOPK = 16;
constexpr int NEXP = 16384;

DI bf16_t f2bf(float f) { unsigned u = __float_as_uint(f); u += 0x7fffu + ((u >> 16) & 1u); return (bf16_t)(u >> 16); }
DI float bf2f(bf16_t b) { return __uint_as_float(((unsigned)b) << 16); }
DI float wave_sum(float v) { for (int o = 32; o >= 1; o >>= 1) v += __shfl_xor(v, o); return v; }
DI float wave_max(float v) { for (int o = 32; o >= 1; o >>= 1) v = fmaxf(v, __shfl_xor(v, o)); return v; }

__host__ __device__ inline int head_perm(int p) { const int G = p >> 5, half = (p >> 4) & 1, j = p & 15; const int base = (G & 1) * 16 + (G >> 1) * 64; return base + j + 32 * half; }

struct WS {
    size_t bar, cond, ada, rope, h, a, q, k, vt, o, ut, yt, idx, gate, wqkv, wo, win, wout, wq, filt, filtc, h3, pu, pv, end;
};
static WS make_ws() {
    WS w; size_t p = 0;
    auto take = [&](size_t bytes) { size_t r = p; p += (bytes + 255) & ~(size_t)255; return r; };
    w.bar = take(64 * 1024);
    w.cond = take((size_t)9 * DM * 4);
    w.ada = take((size_t)4 * 9 * NMOD * DM * 4);
    w.rope = take((size_t)64 * 32 * 8);
    w.h = take((size_t)T_ALL * DM * 4);
    w.a = take((size_t)T_ALL * DM * 2);
    w.q = take((size_t)T_ALL * DM * 2);
    w.k = take((size_t)T_ALL * 512 * 2);
    w.vt = take((size_t)512 * T_ALL * 2);
    w.o = take((size_t)T_ALL * DM * 2);
    w.ut = take((size_t)3 * DM * T_ALL * 2);
    w.yt = take((size_t)DM * T_ALL * 2);
    w.idx = take((size_t)T_ALL * 128 * 4);
    w.gate = take((size_t)T_ALL * 128 * 4);
    w.wqkv = take((size_t)2 * QKVW * DM * 2);
    w.wo = take((size_t)2 * DM * DM * 2);
    w.win = take((size_t)2 * 3 * DM * DM * 2);
    w.wout = take((size_t)2 * DM * DM * 2);
    w.wq = take((size_t)4 * DM * DM * 2);
    w.filt = take((size_t)2 * 2 * DM * 4096 * 2);
    w.filtc = take((size_t)2 * DM * 512 * 2);
    w.h3 = take((size_t)2 * (SEQ + CTX) * 64 * 4);
    w.pu = take((size_t)NEXP * DM * 2);
    w.pv = take((size_t)NEXP * DM * 2);
    w.end = p;
    return w;
}

__global__ void k_cond(const float* __restrict__ c, const float* __restrict__ c_ctx, float* __restrict__ cond) {
    const int i = blockIdx.x * 256 + threadIdx.x;
    if (i < 9 * DM) { const float v = i < 8 * DM ? c[i] : c_ctx[i - 8 * DM]; cond[i] = v / (1.0f + expf(-v)); }
}
__global__ void k_ada(const float* __restrict__ cond, const float* __restrict__ ada_w, const float* __restrict__ ada_b, float* __restrict__ ada) {
    const int gid = blockIdx.x * 256 + threadIdx.x;
    const int i = gid / (NMOD * DM), n = gid % (NMOD * DM);
    float acc[9];
#pragma unroll
    for (int b = 0; b < 9; ++b) acc[b] = 0.f;
    const float* w = ada_w + (size_t)i * DM * NMOD * DM + n;
    for (int k = 0; k < DM; ++k) {
        const float wv = w[(size_t)k * NMOD * DM];
#pragma unroll
        for (int b = 0; b < 9; ++b) acc[b] += cond[b * DM + k] * wv;
    }
    const float bb = ada_b[i * NMOD * DM + n];
#pragma unroll
    for (int b = 0; b < 9; ++b) ada[((size_t)i * 9 + b) * NMOD * DM + n] = acc[b] + bb;
}
__global__ void k_wt(const float* __restrict__ W, bf16_t* __restrict__ Wt, int K, int N, int nperm) {
    __shared__ float tile[64][65];
    const int n0 = blockIdx.x * 64, k0 = blockIdx.y * 64, tx = threadIdx.x & 63, ty = threadIdx.x >> 6;
    const int n = n0 + tx; const int src = n < nperm ? (n & ~127) + head_perm(n & 127) : n;
    for (int kk = ty; kk < 64; kk += 4) tile[kk][tx] = W[(size_t)(k0 + kk) * N + src];
    __syncthreads();
    for (int nn = ty; nn < 64; nn += 4) Wt[(size_t)(n0 + nn) * K + k0 + tx] = f2bf(tile[tx][nn]);
}
__global__ void k_rope(float2* __restrict__ rope) {
    const int i = blockIdx.x * 256 + threadIdx.x; if (i >= 64 * 32) return;
    const int pos = i >> 5, f = i & 31; const float inv = powf(10000.0f, -(float)f / 32.0f); const float ang = (float)pos * inv;
    rope[i] = make_float2(cosf(ang), sinf(ang));
}
__global__ void k_cvt(const float* __restrict__ src, bf16_t* __restrict__ dst, size_t n8) {
    for (size_t i = (size_t)blockIdx.x * blockDim.x + threadIdx.x; i < n8; i += (size_t)gridDim.x * blockDim.x) {
        const float4 a = ((const float4*)src)[2 * i], b = ((const float4*)src)[2 * i + 1];
        u32x4 o; o.x = f2bf(a.x) | ((unsigned)f2bf(a.y) << 16); o.y = f2bf(a.z) | ((unsigned)f2bf(a.w) << 16); o.z = f2bf(b.x) | ((unsigned)f2bf(b.y) << 16); o.w = f2bf(b.z) | ((unsigned)f2bf(b.w) << 16);
        ((u32x4*)dst)[i] = o;
    }
}
__global__ void k_hy_h3(const float* __restrict__ w1, const float* __restrict__ b1, const float* __restrict__ w2, const float* __restrict__ b2, float* __restrict__ h3, int L) {
    __shared__ float z[33]; __shared__ float ha[64]; __shared__ float hb[64];
    const int t = blockIdx.x, j = threadIdx.x;
    if (j == 0) z[0] = (float)t / (float)L;
    if (j >= 1 && j <= 16) { const float ang = 2.0f * 3.14159265358979323846f * (float)t * (float)j / (float)L; z[j] = cosf(ang); z[16 + j] = sinf(ang); }
    __syncthreads();
    float s = b1[j];
    for (int k = 0; k < 33; ++k) s += z[k] * w1[k * 64 + j];
    ha[j] = sinf(s); __syncthreads();
    s = b2[j];
    for (int k = 0; k < 64; ++k) s += ha[k] * w2[k * 64 + j];
    hb[j] = sinf(s); __syncthreads();
    s = b2[64 + j];
    for (int k = 0; k < 64; ++k) s += hb[k] * w2[64 * 64 + k * 64 + j];
    h3[(size_t)t * 64 + j] = sinf(s);
}
__global__ void k_hy_filt(const float* __restrict__ h3, const float* __restrict__ w3, const float* __restrict__ decay, const float* __restrict__ fbias, bf16_t* __restrict__ G, int L) {
    __shared__ float tile[64][65];
    const int m0 = blockIdx.x * 64, d0 = blockIdx.y * 64, o = blockIdx.z, tx = threadIdx.x & 63, ty = threadIdx.x >> 6;
    const int d = d0 + tx; const float dec = fabsf(decay[o * DM + d]); const float fb = fbias[o * DM + d];
    for (int mm = ty; mm < 64; mm += 4) {
        const int m = m0 + mm, lag = L - m; float val = 0.f;
        if (m != 0) {
            const int t = lag >= 0 ? lag : -lag, dir = lag >= 0 ? 0 : 1; const int col = o * 2 * DM + dir * DM + d;
            float s = 0.f;
            for (int k = 0; k < 64; ++k) s += h3[(size_t)t * 64 + k] * w3[(size_t)k * 4 * DM + col];
            val = s * (expf(-((float)t / (float)L) * dec) + 0.05f);
            if (lag == 0) val += fb;
        }
        tile[mm][tx] = val;
    }
    __syncthreads();
    for (int dd = ty; dd < 64; dd += 4) G[((size_t)o * DM + d0 + dd) * (2 * L) + m0 + tx] = f2bf(tile[tx][dd]);
}

__global__ void k_normmod(const float* __restrict__ h, const float* __restrict__ g, const float* __restrict__ adaL, int sh_off, int sc_off, bf16_t* __restrict__ a, int row0, int nrows) {
    const int wid = (blockIdx.x * blockDim.x + threadIdx.x) >> 6, lane = threadIdx.x & 63;
    if (wid >= nrows) return;
    const int r = row0 + wid; const int bi = r < T_LAT ? r / SEQ : 8;
    const float* x = h + (size_t)r * DM; const float* sh = adaL + (size_t)bi * NMOD * DM + sh_off; const float* sc = adaL + (size_t)bi * NMOD * DM + sc_off;
    float4 v[8]; float ss = 0.f;
#pragma unroll
    for (int i = 0; i < 8; ++i) { v[i] = *(const float4*)(x + i * 256 + lane * 4); ss += v[i].x * v[i].x + v[i].y * v[i].y + v[i].z * v[i].z + v[i].w * v[i].w; }
    ss = wave_sum(ss); const float inv = rsqrtf(ss / (float)DM + 1e-6f);
#pragma unroll
    for (int i = 0; i < 8; ++i) { const int c = i * 256 + lane * 4; const float4 gg = *(const float4*)(g + c), s1 = *(const float4*)(sc + c), s0 = *(const float4*)(sh + c);
        u32x2 o; o.x = f2bf(v[i].x * inv * gg.x * (1.f + s1.x) + s0.x) | ((unsigned)f2bf(v[i].y * inv * gg.y * (1.f + s1.y) + s0.y) << 16);
        o.y = f2bf(v[i].z * inv * gg.z * (1.f + s1.z) + s0.z) | ((unsigned)f2bf(v[i].w * inv * gg.w * (1.f + s1.w) + s0.w) << 16);
        *(u32x2*)(a + (size_t)r * DM + c) = o; }
}
__global__ void k_final(const float* __restrict__ h, const float* __restrict__ g, float* __restrict__ out) {
    const int r = (blockIdx.x * blockDim.x + threadIdx.x) >> 6, lane = threadIdx.x & 63;
    if (r >= T_LAT) return;
    const float* x = h + (size_t)r * DM; float4 v[8]; float ss = 0.f;
#pragma unroll
    for (int i = 0; i < 8; ++i) { v[i] = *(const float4*)(x + i * 256 + lane * 4); ss += v[i].x * v[i].x + v[i].y * v[i].y + v[i].z * v[i].z + v[i].w * v[i].w; }
    ss = wave_sum(ss); const float inv = rsqrtf(ss / (float)DM + 1e-6f);
#pragma unroll
    for (int i = 0; i < 8; ++i) { const int c = i * 256 + lane * 4; const float4 gg = *(const float4*)(g + c);
        *(float4*)(out + (size_t)r * DM + c) = make_float4(v[i].x * inv * gg.x, v[i].y * inv * gg.y, v[i].z * inv * gg.z, v[i].w * inv * gg.w); }
}

template <class Epi> __global__ __launch_bounds__(256) void k_gemm_simple(const bf16_t* __restrict__ A, const bf16_t* __restrict__ Bt, int M, int N, int K, Epi E) {
    const int lane = threadIdx.x & 63, w = threadIdx.x >> 6, fr = lane & 15, fq = lane >> 4;
    const int row0 = blockIdx.y * 64 + w * 16, col0 = blockIdx.x * 64;
    f32x4 acc[4];
#pragma unroll
    for (int i = 0; i < 4; ++i) acc[i] = (f32x4){0.f, 0.f, 0.f, 0.f};
    const bf16_t* ap = A + (size_t)(row0 + fr) * K + fq * 8;
    const bf16_t* bp = Bt + (size_t)(col0 + fr) * K + fq * 8;
    for (int k = 0; k < K; k += 32) {
        const bf16x8 a = *(const bf16x8*)(ap + k);
#pragma unroll
        for (int i = 0; i < 4; ++i) { const bf16x8 b = *(const bf16x8*)(bp + (size_t)i * 16 * K + k); acc[i] = __builtin_amdgcn_mfma_f32_16x16x32_bf16(a, b, acc[i], 0, 0, 0); }
    }
#pragma unroll
    for (int j = 0; j < 4; ++j) E(row0 + fq * 4 + j, col0 + fr, acc[0][j], acc[1][j], acc[2][j], acc[3][j]);
}
struct EpiQKV {
    bf16_t* Q; bf16_t* Kb; bf16_t* Vt; const float2* rope;
    DI void operator()(int r, int c, float v0, float v1, float v2, float v3) const {
        if (c < 2560) {
            if (r < T_LAT) {
                const int t = r % SEQ, ri = t >> 6, ci = t & 63;
                const int G = (c & 127) >> 5;
                const int j = c & 15;
                {   const int f = (G & 1) * 16 + j; const float2 cs = rope[((G >> 1) ? ci : ri) * 32 + f];
                    const float lo = v0, hi = v1; v0 = lo * cs.x - hi * cs.y; v1 = hi * cs.x + lo * cs.y; }
                {   const int G2 = G + 1; const int f = (G2 & 1) * 16 + j; const float2 cs = rope[((G2 >> 1) ? ci : ri) * 32 + f];
                    const float lo = v2, hi = v3; v2 = lo * cs.x - hi * cs.y; v3 = hi * cs.x + lo * cs.y; }
            }
            bf16_t* dst = c < 2048 ? Q + (size_t)r * DM + c : Kb + (size_t)r * 512 + (c - 2048);
            dst[0] = f2bf(v0); dst[16] = f2bf(v1); dst[32] = f2bf(v2); dst[48] = f2bf(v3);
        } else {
            const int cv = c - 2560;
            Vt[(size_t)(cv) * T_ALL + r] = f2bf(v0); Vt[(size_t)(cv + 16) * T_ALL + r] = f2bf(v1); Vt[(size_t)(cv + 32) * T_ALL + r] = f2bf(v2); Vt[(size_t)(cv + 48) * T_ALL + r] = f2bf(v3);
        }
    }
};
struct EpiRes {
    const float* base; float* hout; const float* adaL; int g_off; int pad_;
    DI void operator()(int r, int c, float v0, float v1, float v2, float v3) const {
        const int bi = r < T_LAT ? r / SEQ : 8; const float* g = adaL + (size_t)bi * NMOD * DM + g_off + c; const size_t o = (size_t)r * DM + c;
        hout[o] = base[o] + g[0] * v0; hout[o + 16] = base[o + 16] + g[16] * v1; hout[o + 32] = base[o + 32] + g[32] * v2; hout[o + 48] = base[o + 48] + g[48] * v3;
    }
};
struct EpiBf {
    bf16_t* O; int ldc; int pad_;
    DI void operator()(int r, int c, float v0, float v1, float v2, float v3) const { bf16_t* d = O + (size_t)r * ldc + c; d[0] = f2bf(v0); d[16] = f2bf(v1); d[32] = f2bf(v2); d[48] = f2bf(v3); }
};
struct EpiBfT {
    bf16_t* O; int ldr; int pad_;
    DI void operator()(int r, int c, float v0, float v1, float v2, float v3) const { O[(size_t)c * ldr + r] = f2bf(v0); O[(size_t)(c + 16) * ldr + r] = f2bf(v1); O[(size_t)(c + 32) * ldr + r] = f2bf(v2); O[(size_t)(c + 48) * ldr + r] = f2bf(v3); }
};

__global__ __launch_bounds__(256) void k_attn_naive(const bf16_t* __restrict__ Q, const bf16_t* __restrict__ Kb, const bf16_t* __restrict__ Vt, const float* __restrict__ sink, bf16_t* __restrict__ O, int row0) {
    __shared__ float qs[4][128]; __shared__ float ps[4][520];
    const int r = row0 + blockIdx.x, kvh = blockIdx.y, w = threadIdx.x >> 6, lane = threadIdx.x & 63, hq = kvh * 4 + w;
    int lo, nwin, cbase;
    if (r < T_LAT) { const int b = r / SEQ, t = r % SEQ; const int tlo = t - 128 < 0 ? 0 : t - 128, thi = t + 128 > SEQ - 1 ? SEQ - 1 : t + 128; lo = b * SEQ + tlo; nwin = thi - tlo + 1; cbase = T_LAT + b * CTX; }
    else { const int b = (r - T_LAT) / CTX; lo = 0; nwin = 0; cbase = T_LAT + b * CTX; }
    const int nk = nwin + CTX;
    qs[w][lane] = bf2f(Q[(size_t)r * DM + hq * 128 + lane]); qs[w][lane + 64] = bf2f(Q[(size_t)r * DM + hq * 128 + 64 + lane]);
    __syncthreads();
    const float scale = 0.08838834764831845f;
    float mx = -3.0e38f;
    for (int kk = lane; kk < nk; kk += 64) {
        const int kr = kk < nwin ? lo + kk : cbase + (kk - nwin);
        const bf16_t* kp = Kb + (size_t)kr * 512 + kvh * 128; float s = 0.f;
        for (int d8 = 0; d8 < 16; ++d8) { const bf16x8 kv = *(const bf16x8*)(kp + d8 * 8);
#pragma unroll
            for (int j = 0; j < 8; ++j) s += qs[w][d8 * 8 + j] * bf2f((bf16_t)kv[j]); }
        s *= scale; ps[w][kk] = s; mx = fmaxf(mx, s);
    }
    const float sk = sink[hq];
    mx = fmaxf(wave_max(mx), sk);
    float sum = 0.f;
    for (int kk = lane; kk < nk; kk += 64) { const float p = expf(ps[w][kk] - mx); ps[w][kk] = p; sum += p; }
    sum = wave_sum(sum) + expf(sk - mx);
    __syncthreads();
    const float inv = 1.0f / sum;
#pragma unroll
    for (int dd = 0; dd < 2; ++dd) {
        const int d = lane + 64 * dd; const bf16_t* vp = Vt + (size_t)(kvh * 128 + d) * T_ALL; float acc = 0.f;
        for (int kk = 0; kk < nwin; ++kk) acc += ps[w][kk] * bf2f(vp[lo + kk]);
        for (int kk = 0; kk < CTX; ++kk) acc += ps[w][nwin + kk] * bf2f(vp[cbase + kk]);
        O[(size_t)r * DM + hq * 128 + d] = f2bf(acc * inv);
    }
}

template <int L> __global__ __launch_bounds__(256) void k_hyena_naive(const bf16_t* __restrict__ Ut, const float* __restrict__ cw, const float* __restrict__ cb, const bf16_t* __restrict__ G, bf16_t* __restrict__ Y, int tok0) {
    __shared__ float sv[L], sx1[L], sx2[L]; __shared__ float g0[2 * L], g1[2 * L];
    const int d = blockIdx.x, b = blockIdx.y, tid = threadIdx.x; const int base = tok0 + b * L;
    for (int part = 0; part < 3; ++part) {
        const int ch = part * DM + d; const bf16_t* u = Ut + (size_t)ch * T_ALL + base; const float w0 = cw[ch], w1 = cw[3 * DM + ch], w2 = cw[6 * DM + ch], bb = cb[ch];
        float* dst = part == 0 ? sv : (part == 1 ? sx1 : sx2);
        for (int t = tid; t < L; t += 256) { const float xm = t > 0 ? bf2f(u[t - 1]) : 0.f, x0 = bf2f(u[t]), xp = t < L - 1 ? bf2f(u[t + 1]) : 0.f; dst[t] = bb + w0 * xm + w1 * x0 + w2 * xp; }
    }
    for (int m = tid; m < 2 * L; m += 256) { g0[m] = bf2f(G[((size_t)0 * DM + d) * (2 * L) + m]); g1[m] = bf2f(G[((size_t)1 * DM + d) * (2 * L) + m]); }
    __syncthreads();
    constexpr int NO = L / 256;
    float acc[NO];
#pragma unroll
    for (int i = 0; i < NO; ++i) acc[i] = 0.f;
    for (int s = 0; s < L; ++s) { const float zv = sv[s];
#pragma unroll
        for (int i = 0; i < NO; ++i) acc[i] += g0[L - (tid + 256 * i) + s] * zv; }
    __syncthreads();
#pragma unroll
    for (int i = 0; i < NO; ++i) { const int t = tid + 256 * i; sv[t] = bf2f(f2bf(sx1[t] * acc[i])); acc[i] = 0.f; }
    __syncthreads();
    for (int s = 0; s < L; ++s) { const float zv = sv[s];
#pragma unroll
        for (int i = 0; i < NO; ++i) acc[i] += g1[L - (tid + 256 * i) + s] * zv; }
#pragma unroll
    for (int i = 0; i < NO; ++i) { const int t = tid + 256 * i; Y[(size_t)(base + t) * DM + d] = f2bf(sx2[t] * acc[i]); }
}

__global__ __launch_bounds__(256) void k_peer_topk_naive(const bf16_t* __restrict__ qb, const float* __restrict__ keys1, const float* __restrict__ keys2, int* __restrict__ idx, float* __restrict__ gate, int row0) {
    __shared__ float qs[2048]; __shared__ float sc[16][128]; __shared__ float tv[16][16]; __shared__ int ti[16][16]; __shared__ float cand[8][256];
    const int r = row0 + blockIdx.x, tid = threadIdx.x;
    for (int i = tid; i < 2048; i += 256) qs[i] = bf2f(qb[(size_t)r * DM + i]);
    __syncthreads();
    for (int e = tid; e < 2048; e += 256) {
        const int list = e >> 7, key = e & 127, h = list >> 1, half = list & 1;
        const float* kp = (half ? keys2 : keys1) + ((size_t)h * 128 + key) * 128; const float* qp = qs + h * 256 + half * 128; float s = 0.f;
        for (int d = 0; d < 128; ++d) s += qp[d] * kp[d];
        sc[list][key] = s;
    }
    __syncthreads();
    if (tid < 16) {
        for (int k = 0; k < 16; ++k) { float best = -3.0e38f; int bi = 0;
            for (int j = 0; j < 128; ++j) { const float v = sc[tid][j]; if (v > best) { best = v; bi = j; } }
            tv[tid][k] = best; ti[tid][k] = bi; sc[tid][bi] = -3.0e38f; }
    }
    __syncthreads();
    for (int e = tid; e < 2048; e += 256) { const int h = e >> 8, p = e & 255; cand[h][p] = tv[2 * h][p >> 4] + tv[2 * h + 1][p & 15]; }
    __syncthreads();
    if (tid < 8) {
        float ts[16]; int tp[16];
        float mx = 0.f, sum = 0.f;
#pragma unroll
        for (int k = 0; k < 16; ++k) { float best = -3.0e38f; int bp = 0;
            for (int j = 0; j < 256; ++j) { const float v = cand[tid][j]; if (v > best) { best = v; bp = j; } }
            ts[k] = best; tp[k] = bp; cand[tid][bp] = -3.0e38f; if (k == 0) mx = best; }
#pragma unroll
        for (int k = 0; k < 16; ++k) { ts[k] = expf(ts[k] - mx); sum += ts[k]; }
#pragma unroll
        for (int k = 0; k < 16; ++k) { const int p = tp[k]; idx[(size_t)r * 128 + tid * 16 + k] = ti[2 * tid][p >> 4] * 128 + ti[2 * tid + 1][p & 15]; gate[(size_t)r * 128 + tid * 16 + k] = ts[k] / sum; }
    }
}
__global__ __launch_bounds__(256) void k_peer_gather_naive(const bf16_t* __restrict__ a, const int* __restrict__ idx, const float* __restrict__ gate, const float* __restrict__ ut, const float* __restrict__ vt,
                                                           const float* __restrict__ adaL, int g_off, float* __restrict__ hio, int row0, int nrows) {
    const int wid = (blockIdx.x * blockDim.x + threadIdx.x) >> 6, lane = threadIdx.x & 63;
    if (wid >= nrows) return;
    const int r = row0 + wid; const int bi = r < T_LAT ? r / SEQ : 8;
    float x[32], acc[32];
#pragma unroll
    for (int c = 0; c < 4; ++c) { const bf16x8 v = *(const bf16x8*)(a + (size_t)r * DM + c * 512 + lane * 8);
#pragma unroll
        for (int j = 0; j < 8; ++j) { x[c * 8 + j] = bf2f((bf16_t)v[j]); acc[c * 8 + j] = 0.f; } }
    for (int e = 0; e < 128; ++e) {
        const int id = idx[(size_t)r * 128 + e]; const float gt = gate[(size_t)r * 128 + e];
        const float* up = ut + (size_t)id * DM; const float* vp = vt + (size_t)id * DM; float s = 0.f;
#pragma unroll
        for (int c = 0; c < 4; ++c) { const float4 u0 = *(const float4*)(up + c * 512 + lane * 8), u1 = *(const float4*)(up + c * 512 + lane * 8 + 4);
            s += x[c * 8 + 0] * u0.x + x[c * 8 + 1] * u0.y + x[c * 8 + 2] * u0.z + x[c * 8 + 3] * u0.w + x[c * 8 + 4] * u1.x + x[c * 8 + 5] * u1.y + x[c * 8 + 6] * u1.z + x[c * 8 + 7] * u1.w; }
        s = wave_sum(s);
        const float wgt = gt * (0.5f * s * (1.0f + erff(s * 0.70710678118654752f)));
#pragma unroll
        for (int c = 0; c < 4; ++c) { const float4 v0 = *(const float4*)(vp + c * 512 + lane * 8), v1 = *(const float4*)(vp + c * 512 + lane * 8 + 4);
            acc[c * 8 + 0] += wgt * v0.x; acc[c * 8 + 1] += wgt * v0.y; acc[c * 8 + 2] += wgt * v0.z; acc[c * 8 + 3] += wgt * v0.w; acc[c * 8 + 4] += wgt * v1.x; acc[c * 8 + 5] += wgt * v1.y; acc[c * 8 + 6] += wgt * v1.z; acc[c * 8 + 7] += wgt * v1.w; }
    }
    const float* g2 = adaL + (size_t)bi * NMOD * DM + g_off; float* hp = hio + (size_t)r * DM;
#pragma unroll
    for (int c = 0; c < 4; ++c)
#pragma unroll
        for (int j = 0; j < 8; ++j) { const int col = c * 512 + lane * 8 + j; hp[col] += g2[col] * acc[c * 8 + j]; }
}

extern "C" void kernel_launch(void* const* d_in, const int* in_sizes, int n_in, void* d_out, int out_size, void* d_ws, size_t ws_size, hipStream_t stream) {
    static WS w = make_ws();
    if (ws_size < w.end) { fprintf(stderr, "kernel_launch: workspace too small: %zu < %zu\n", ws_size, w.end); return; }
    unsigned char* ws = (unsigned char*)d_ws;
    const float* x = (const float*)d_in[0]; const float* c = (const float*)d_in[1]; const float* ctx = (const float*)d_in[2]; const float* c_ctx = (const float*)d_in[3];
    const float* ada_w = (const float*)d_in[4]; const float* ada_b = (const float*)d_in[5]; const float* norm_mix_g = (const float*)d_in[6]; const float* norm_ffn_g = (const float*)d_in[7];
    const float* final_g = (const float*)d_in[8]; const float* attn_w_qkv = (const float*)d_in[9]; const float* attn_w_o = (const float*)d_in[10]; const float* attn_sink = (const float*)d_in[11];
    const float* hy_w_in = (const float*)d_in[12]; const float* hy_conv_w = (const float*)d_in[13]; const float* hy_conv_b = (const float*)d_in[14]; const float* hy_f_w1 = (const float*)d_in[15];
    const float* hy_f_b1 = (const float*)d_in[16]; const float* hy_f_w2 = (const float*)d_in[17]; const float* hy_f_b2 = (const float*)d_in[18]; const float* hy_f_w3 = (const float*)d_in[19];
    const float* hy_decay = (const float*)d_in[20]; const float* hy_fbias = (const float*)d_in[21]; const float* hy_w_out = (const float*)d_in[22]; const float* peer_w_q = (const float*)d_in[23];
    const float* peer_keys1 = (const float*)d_in[24]; const float* peer_keys2 = (const float*)d_in[25]; const float* peer_u = (const float*)d_in[26]; const float* peer_v = (const float*)d_in[27];
    float* out = (float*)d_out;
    float* cond = (float*)(ws + w.cond); float* ada = (float*)(ws + w.ada); float2* rope = (float2*)(ws + w.rope); float* h = (float*)(ws + w.h);
    bf16_t* a = (bf16_t*)(ws + w.a); bf16_t* q = (bf16_t*)(ws + w.q); bf16_t* kb = (bf16_t*)(ws + w.k); bf16_t* vt = (bf16_t*)(ws + w.vt); bf16_t* o = (bf16_t*)(ws + w.o);
    bf16_t* ut = (bf16_t*)(ws + w.ut); int* idx = (int*)(ws + w.idx); float* gate = (float*)(ws + w.gate);
    bf16_t* wqkv = (bf16_t*)(ws + w.wqkv); bf16_t* wo = (bf16_t*)(ws + w.wo); bf16_t* win = (bf16_t*)(ws + w.win); bf16_t* wout = (bf16_t*)(ws + w.wout); bf16_t* wq = (bf16_t*)(ws + w.wq);
    bf16_t* filt = (bf16_t*)(ws + w.filt); bf16_t* filtc = (bf16_t*)(ws + w.filtc); float* h3 = (float*)(ws + w.h3);

    k_cond<<<(9 * DM + 255) / 256, 256, 0, stream>>>(c, c_ctx, cond);
    k_ada<<<4 * NMOD * DM / 256, 256, 0, stream>>>(cond, ada_w, ada_b, ada);
    k_rope<<<8, 256, 0, stream>>>(rope);
    for (int j = 0; j < 2; ++j) {
        k_wt<<<dim3(QKVW / 64, DM / 64), 256, 0, stream>>>(attn_w_qkv + (size_t)j * DM * QKVW, wqkv + (size_t)j * QKVW * DM, DM, QKVW, 2560);
        k_wt<<<dim3(DM / 64, DM / 64), 256, 0, stream>>>(attn_w_o + (size_t)j * DM * DM, wo + (size_t)j * DM * DM, DM, DM, 0);
        k_wt<<<dim3(3 * DM / 64, DM / 64), 256, 0, stream>>>(hy_w_in + (size_t)j * DM * 3 * DM, win + (size_t)j * 3 * DM * DM, DM, 3 * DM, 0);
        k_wt<<<dim3(DM / 64, DM / 64), 256, 0, stream>>>(hy_w_out + (size_t)j * DM * DM, wout + (size_t)j * DM * DM, DM, DM, 0);
        float* h3l = h3 + (size_t)j * (SEQ + CTX) * 64;
        k_hy_h3<<<SEQ, 64, 0, stream>>>(hy_f_w1 + j * 33 * 64, hy_f_b1 + j * 64, hy_f_w2 + j * 2 * 64 * 64, hy_f_b2 + j * 2 * 64, h3l, SEQ);
        k_hy_filt<<<dim3(2 * SEQ / 64, DM / 64, 2), 256, 0, stream>>>(h3l, hy_f_w3 + (size_t)j * 64 * 4 * DM, hy_decay + j * 2 * DM, hy_fbias + j * 2 * DM, filt + (size_t)j * 2 * DM * 4096, SEQ);
        if (j == 0) {
            k_hy_h3<<<CTX, 64, 0, stream>>>(hy_f_w1, hy_f_b1, hy_f_w2, hy_f_b2, h3l + SEQ * 64, CTX);
            k_hy_filt<<<dim3(2 * CTX / 64, DM / 64, 2), 256, 0, stream>>>(h3l + SEQ * 64, hy_f_w3, hy_decay, hy_fbias, filtc, CTX);
        }
    }
    for (int i = 0; i < 4; ++i) k_wt<<<dim3(DM / 64, DM / 64), 256, 0, stream>>>(peer_w_q + (size_t)i * DM * DM, wq + (size_t)i * DM * DM, DM, DM, 0);
    (void)hipMemcpyAsync(h, x, (size_t)T_LAT * DM * 4, hipMemcpyDeviceToDevice, stream);
    (void)hipMemcpyAsync(h + (size_t)T_LAT * DM, ctx, (size_t)T_CTX * DM * 4, hipMemcpyDeviceToDevice, stream);

    for (int i = 0; i < 4; ++i) {
        const bool is_attn = (i % 2) == 0, ctx_upd = i < 2; const int j = i / 2;
        const float* adaL = ada + (size_t)i * 9 * NMOD * DM;
        const int rows_a = i <= 2 ? T_ALL : T_LAT;
        const int rows_u = ctx_upd ? T_ALL : T_LAT;
        k_normmod<<<rows_a / 4, 256, 0, stream>>>(h, norm_mix_g + i * DM, adaL, 0, DM, a, 0, rows_a);
        if (is_attn) {
            EpiQKV e1{q, kb, vt, rope};
            k_gemm_simple<EpiQKV><<<dim3(QKVW / 64, T_ALL / 64), 256, 0, stream>>>(a, wqkv + (size_t)j * QKVW * DM, T_ALL, QKVW, DM, e1);
            k_attn_naive<<<dim3(rows_u, NKVH), 256, 0, stream>>>(q, kb, vt, attn_sink + j * NQH, o, 0);
            EpiRes e2{h, h, adaL, 2 * DM, 0};
            k_gemm_simple<EpiRes><<<dim3(DM / 64, rows_u / 64), 256, 0, stream>>>(o, wo + (size_t)j * DM * DM, rows_u, DM, DM, e2);
        } else {
            EpiBfT e1{ut, T_ALL, 0};
            k_gemm_simple<EpiBfT><<<dim3(3 * DM / 64, rows_u / 64), 256, 0, stream>>>(a, win + (size_t)j * 3 * DM * DM, rows_u, 3 * DM, DM, e1);
            k_hyena_naive<SEQ><<<dim3(DM, NB), 256, 0, stream>>>(ut, hy_conv_w + (size_t)j * 9 * DM, hy_conv_b + (size_t)j * 3 * DM, filt + (size_t)j * 2 * DM * 4096, o, 0);
            if (ctx_upd) k_hyena_naive<CTX><<<dim3(DM, NB), 256, 0, stream>>>(ut, hy_conv_w + (size_t)j * 9 * DM, hy_conv_b + (size_t)j * 3 * DM, filtc, o, T_LAT);
            EpiRes e2{h, h, adaL, 2 * DM, 0};
            k_gemm_simple<EpiRes><<<dim3(DM / 64, rows_u / 64), 256, 0, stream>>>(o, wout + (size_t)j * DM * DM, rows_u, DM, DM, e2);
        }
        k_normmod<<<rows_u / 4, 256, 0, stream>>>(h, norm_ffn_g + i * DM, adaL, 3 * DM, 4 * DM, a, 0, rows_u);
        EpiBf e3{q, DM, 0};
        k_gemm_simple<EpiBf><<<dim3(DM / 64, rows_u / 64), 256, 0, stream>>>(a, wq + (size_t)i * DM * DM, rows_u, DM, DM, e3);
        k_peer_topk_naive<<<rows_u, 256, 0, stream>>>(q, peer_keys1 + (size_t)i * 8 * 128 * 128, peer_keys2 + (size_t)i * 8 * 128 * 128, idx, gate, 0);
        k_peer_gather_naive<<<rows_u / 4, 256, 0, stream>>>(a, idx, gate, peer_u + (size_t)i * NEXP * DM, peer_v + (size_t)i * NEXP * DM, adaL, 5 * DM, h, 0, rows_u);
    }
    k_final<<<T_LAT / 4, 256, 0, stream>>>(h, final_g, out);
}
```

```cpp
#include <hip/hip_runtime.h>
#include <stdint.h>
#include <stdio.h>

typedef unsigned short bf16_t;
typedef short bf16x8 __attribute__((ext_vector_type(8)));
typedef float f32x4 __attribute__((ext_vector_type(4)));
typedef unsigned u32x4 __attribute__((ext_vector_type(4)));
typedef unsigned u32x2 __attribute__((ext_vector_type(2)));

#define DI __device__ __forceinline__

constexpr int DM = 2048;
constexpr int NB = 8;
constexpr int SEQ = 2048;
constexpr int CTX = 256;
constexpr int T_LAT = NB * SEQ;
constexpr int T_CTX = NB * CTX;
constexpr int T_ALL = T_LAT + T_CTX;
constexpr int NMOD = 6;
constexpr int HD = 128, NQH = 16, NKVH = 4;
constexpr int QKVW = 3072;
constexpr int PH = 8, PNK = 128, PTOPK = 16;
constexpr int NEXP = 16384;

DI bf16_t f2bf(float f) { unsigned u = __float_as_uint(f); u += 0x7fffu + ((u >> 16) & 1u); return (bf16_t)(u >> 16); }
DI float bf2f(bf16_t b) { return __uint_as_float(((unsigned)b) << 16); }
DI float wave_sum(float v) { for (int o = 32; o >= 1; o >>= 1) v += __shfl_xor(v, o); return v; }
DI float wave_max(float v) { for (int o = 32; o >= 1; o >>= 1) v = fmaxf(v, __shfl_xor(v, o)); return v; }

__host__ __device__ inline int head_perm(int p) { const int G = p >> 5, half = (p >> 4) & 1, j = p & 15; const int base = (G & 1) * 16 + (G >> 1) * 64; return base + j + 32 * half; }

struct WS {
    size_t bar, cond, ada, rope, h, a, q, k, vt, o, ut, yt, idx, gate, wqkv, wo, win, wout, wq, filt, filtc, h3, pu, pv, end;
};
constexpr size_t ws_take(size_t& p, size_t bytes) { size_t r = p; p += (bytes + 255) & ~(size_t)255; return r; }
constexpr WS make_ws() {
    WS w{}; size_t p = 0;
    w.bar = ws_take(p, 64 * 1024);
    w.cond = ws_take(p, (size_t)9 * DM * 4);
    w.ada = ws_take(p, (size_t)4 * 9 * NMOD * DM * 4);
    w.rope = ws_take(p, (size_t)64 * 32 * 8);
    w.h = ws_take(p, (size_t)T_ALL * DM * 4);
    w.a = ws_take(p, (size_t)T_ALL * DM * 2);
    w.q = ws_take(p, (size_t)T_ALL * DM * 2);
    w.k = ws_take(p, (size_t)T_ALL * 512 * 2);
    w.vt = ws_take(p, (size_t)512 * T_ALL * 2);
    w.o = ws_take(p, (size_t)T_ALL * DM * 2);
    w.ut = ws_take(p, (size_t)3 * DM * T_ALL * 2);
    w.yt = ws_take(p, (size_t)DM * T_ALL * 2);
    w.idx = ws_take(p, (size_t)T_ALL * 128 * 4);
    w.gate = ws_take(p, (size_t)T_ALL * 128 * 4);
    w.wqkv = ws_take(p, (size_t)2 * QKVW * DM * 2);
    w.wo = ws_take(p, (size_t)2 * DM * DM * 2);
    w.win = ws_take(p, (size_t)2 * 3 * DM * DM * 2);
    w.wout = ws_take(p, (size_t)2 * DM * DM * 2);
    w.wq = ws_take(p, (size_t)4 * DM * DM * 2);
    w.filt = ws_take(p, (size_t)2 * 2 * DM * 4096 * 2);
    w.filtc = ws_take(p, (size_t)2 * DM * 512 * 2);
    w.h3 = ws_take(p, (size_t)2 * (SEQ + CTX) * 64 * 4);
    w.pu = ws_take(p, (size_t)NEXP * DM * 2);
    w.pv = ws_take(p, (size_t)NEXP * DM * 2);
    w.end = p;
    return w;
}
constexpr WS W = make_ws();

#define XB_TMO      128
#define XB_XCNT(j)  (256  + 64 * (j))
#define XB_XSUB(j)  (1280 + 64 * (j))
#define XB_XGEN(j)  (2304 + 64 * (j))
#define XB_TOP      3328
#define XB_TOPGEN   3392
#define XCD_BAR_WORDS 3456
#define XB_SPIN_CAP (1u << 21)
#define LAS __attribute__((address_space(3)))
__device__ __forceinline__ unsigned xb_ld(unsigned* p)              { return __hip_atomic_load(p, __ATOMIC_RELAXED, __HIP_MEMORY_SCOPE_AGENT); }
__device__ __forceinline__ unsigned xb_add(unsigned* p, unsigned v) { return __hip_atomic_fetch_add(p, v, __ATOMIC_RELAXED, __HIP_MEMORY_SCOPE_AGENT); }
__device__ __forceinline__ unsigned xb_xcc_id() { return (unsigned)__builtin_amdgcn_s_getreg((3 << 11) | 20) & 0xFu; }
#define XB_SPIN(cond, bar) do { unsigned _sp = 0; while (cond) { __builtin_amdgcn_s_sleep(1); \
    if ((++_sp & 255u) == 0u) { if (xb_ld(&(bar)[XB_TMO])) break; if (_sp > XB_SPIN_CAP) { atomicAdd(&(bar)[XB_TMO], 1u); break; } } } } while (0)
struct XcdBarrier { unsigned* bar; unsigned x; volatile LAS unsigned* st; };
__device__ __forceinline__ XcdBarrier xcd_barrier_post(unsigned* bar, volatile LAS unsigned* st) {
    XcdBarrier b; b.bar = bar; b.x = xb_xcc_id(); b.st = st;
    if (threadIdx.x == 0) (void)xb_add(&bar[XB_XCNT(b.x)], 1u);
    return b;
}
__device__ __forceinline__ void xcd_barrier_complete(unsigned* bar, unsigned x, unsigned& nloc, unsigned& nx) {
    const unsigned G = gridDim.x * gridDim.y * gridDim.z;
    unsigned sum, cnt, mine, sp = 0u;
    for (;;) {
        sum = 0u; cnt = 0u; mine = 0u;
#pragma unroll
        for (unsigned j = 0; j < 16; ++j) { const unsigned c = xb_ld(&bar[XB_XCNT(j)]); sum += c; cnt += (c > 0u) ? 1u : 0u; mine = (j == x) ? c : mine; }
        if (sum == G) break;
        __builtin_amdgcn_s_sleep(1);
        if ((++sp & 255u) == 0u) { if (xb_ld(&bar[XB_TMO])) break; if (sp > XB_SPIN_CAP) { atomicAdd(&bar[XB_TMO], 1u); break; } }
    }
    nloc = mine > 0u ? mine : 1u; nx = cnt > 0u ? cnt : 1u;
}
__device__ __forceinline__ void xcd_barrier(const XcdBarrier& b) {
    asm volatile("s_waitcnt vmcnt(0)" ::: "memory");
    __syncthreads();
    if (threadIdx.x == 0) {
        unsigned* bar = b.bar;
        __builtin_amdgcn_s_waitcnt(0);
        unsigned nloc = b.st[0], nx = b.st[1];
        if (nloc == 0u) { xcd_barrier_complete(bar, b.x, nloc, nx); b.st[0] = nloc; b.st[1] = nx; }
        const unsigned old = xb_add(&bar[XB_XSUB(b.x)], 1u);
        const unsigned gen = old / nloc;
        if (old + 1u == (gen + 1u) * nloc) {
            __builtin_amdgcn_fence(__ATOMIC_RELEASE, "agent");
            asm volatile("s_waitcnt vmcnt(0)" ::: "memory");
            const unsigned og = xb_add(&bar[XB_TOP], 1u);
            const unsigned tg = og / nx;
            if (og + 1u == (tg + 1u) * nx) xb_add(&bar[XB_TOPGEN], 1u);
            else XB_SPIN(xb_ld(&bar[XB_TOPGEN]) == tg, bar);
            __builtin_amdgcn_fence(__ATOMIC_ACQUIRE, "agent");
            xb_add(&bar[XB_XGEN(b.x)], 1u);
            asm volatile("s_waitcnt vmcnt(0)" ::: "memory");
        } else {
            XB_SPIN(xb_ld(&bar[XB_XGEN(b.x)]) == gen, bar);
            __builtin_amdgcn_fence(__ATOMIC_ACQUIRE, "agent");
            asm volatile("s_waitcnt vmcnt(0)" ::: "memory");
        }
    }
    __syncthreads();
}

struct VB { int vb, nvb, vtid; unsigned char* lds; };
#define VB_LOOP(u, n) for (int _it = 0, u = V.vb; _it < ((n) + V.nvb - 1) / V.nvb; ++_it, u += V.nvb)

DI void p_cond(const VB& V, const float* __restrict__ c, const float* __restrict__ c_ctx, float* __restrict__ cond) {
    for (int i = V.vb * 256 + V.vtid; i < 9 * DM; i += V.nvb * 256) { const float v = i < 8 * DM ? c[i] : c_ctx[i - 8 * DM]; cond[i] = v / (1.0f + expf(-v)); }
}
DI void p_ada(const VB& V, const float* __restrict__ cond, const float* __restrict__ ada_w, const float* __restrict__ ada_b, float* __restrict__ ada) {
    for (int gid = V.vb * 256 + V.vtid; gid < 4 * NMOD * DM; gid += V.nvb * 256) {
        const int i = gid / (NMOD * DM), n = gid % (NMOD * DM);
        float acc[9];
#pragma unroll
        for (int b = 0; b < 9; ++b) acc[b] = 0.f;
        const float* w = ada_w + (size_t)i * DM * NMOD * DM + n;
        for (int k = 0; k < DM; ++k) {
            const float wv = w[(size_t)k * NMOD * DM];
#pragma unroll
            for (int b = 0; b < 9; ++b) acc[b] += cond[b * DM + k] * wv;
        }
        const float bb = ada_b[i * NMOD * DM + n];
#pragma unroll
        for (int b = 0; b < 9; ++b) ada[((size_t)i * 9 + b) * NMOD * DM + n] = acc[b] + bb;
    }
}
DI void p_wt(const VB& V, const float* __restrict__ W, bf16_t* __restrict__ Wt, int K, int N, int nperm) {
    float (*tile)[65] = (float (*)[65])V.lds;
    const int ntn = N / 64, ntk = K / 64, tx = V.vtid & 63, ty = V.vtid >> 6;
    VB_LOOP(u, ntn * ntk) {
        const bool act = u < ntn * ntk; const int n0 = (u % ntn) * 64, k0 = (u / ntn) * 64;
        if (act) { const int n = n0 + tx; const int src = n < nperm ? (n & ~127) + head_perm(n & 127) : n;
            for (int kk = ty; kk < 64; kk += 4) tile[kk][tx] = W[(size_t)(k0 + kk) * N + src]; }
        __syncthreads();
        if (act) for (int nn = ty; nn < 64; nn += 4) Wt[(size_t)(n0 + nn) * K + k0 + tx] = f2bf(tile[tx][nn]);
        __syncthreads();
    }
}
DI void p_rope(const VB& V, float2* __restrict__ rope) {
    for (int i = V.vb * 256 + V.vtid; i < 64 * 32; i += V.nvb * 256) {
        const int pos = i >> 5, f = i & 31; const float inv = powf(10000.0f, -(float)f / 32.0f); const float ang = (float)pos * inv;
        rope[i] = make_float2(cosf(ang), sinf(ang)); }
}
DI void p_hy_h3(const VB& V, const float* __restrict__ w1, const float* __restrict__ b1, const float* __restrict__ w2, const float* __restrict__ b2, float* __restrict__ h3, int L) {
    const int wv = V.vtid >> 6, j = V.vtid & 63;
    float* z = (float*)V.lds + wv * 256; float* ha = z + 64; float* hb = z + 128;
    const int nw = V.nvb * 4, w0 = V.vb * 4 + wv;
    for (int it = 0; it < (L + nw - 1) / nw; ++it) {
        const int t = it * nw + w0; const bool act = t < L;
        if (act) { if (j == 0) z[0] = (float)t / (float)L;
            if (j >= 1 && j <= 16) { const float ang = 2.0f * 3.14159265358979323846f * (float)t * (float)j / (float)L; z[j] = cosf(ang); z[16 + j] = sinf(ang); } }
        __syncthreads();
        float s = 0.f;
        if (act) { s = b1[j];
_Pragma("unroll 3") for (int k = 0; k < 33; ++k) s += z[k] * w1[k * 64 + j]; ha[j] = sinf(s); }
        __syncthreads();
        if (act) { s = b2[j];
_Pragma("unroll 4") for (int k = 0; k < 64; ++k) s += ha[k] * w2[k * 64 + j]; hb[j] = sinf(s); }
        __syncthreads();
        if (act) { s = b2[64 + j];
_Pragma("unroll 4") for (int k = 0; k < 64; ++k) s += hb[k] * w2[64 * 64 + k * 64 + j]; h3[(size_t)t * 64 + j] = sinf(s); }
        __syncthreads();
    }
}
DI void p_hy_filt(const VB& V, const float* __restrict__ h3, const float* __restrict__ w3, const float* __restrict__ decay, const float* __restrict__ fbias, bf16_t* __restrict__ G, int L) {
    float (*tile)[65] = (float (*)[65])V.lds;
    const int ntm = 2 * L / 64, ntd = DM / 64, tx = V.vtid & 63, ty = V.vtid >> 6, nun = ntm * ntd * 2;
    VB_LOOP(u, nun) {
        const bool act = u < nun; const int m0 = (u % ntm) * 64, d0 = ((u / ntm) % ntd) * 64, o = u / (ntm * ntd);
        if (act) {
            const int d = d0 + tx; const float dec = fabsf(decay[o * DM + d]); const float fb = fbias[o * DM + d];
            for (int mm = ty; mm < 64; mm += 4) {
                const int m = m0 + mm, lag = L - m; float val = 0.f;
                if (m != 0) {
                    const int t = lag >= 0 ? lag : -lag, dir = lag >= 0 ? 0 : 1; const int col = o * 2 * DM + dir * DM + d;
                    float s = 0.f;
                    for (int k = 0; k < 64; ++k) s += h3[(size_t)t * 64 + k] * w3[(size_t)k * 4 * DM + col];
                    val = s * (expf(-((float)t / (float)L) * dec) + 0.05f);
                    if (lag == 0) val += fb;
                }
                tile[mm][tx] = val;
            }
        }
        __syncthreads();
        if (act) for (int dd = ty; dd < 64; dd += 4) G[((size_t)o * DM + d0 + dd) * (2 * L) + m0 + tx] = f2bf(tile[tx][dd]);
        __syncthreads();
    }
}
DI const float* row_ptr(const float* h, const float* x, const float* ctx, int r) { return x ? (r < T_LAT ? x + (size_t)r * DM : ctx + (size_t)(r - T_LAT) * DM) : h + (size_t)r * DM; }
DI void p_normmod(const VB& V, const float* __restrict__ h, const float* __restrict__ x0, const float* __restrict__ ctx0, const float* __restrict__ g, const float* __restrict__ adaL, int sh_off, int sc_off, bf16_t* __restrict__ a, int nrows) {
    const int lane = V.vtid & 63;
    for (int r = V.vb * 4 + (V.vtid >> 6); r < nrows; r += V.nvb * 4) {
        const int bi = r < T_LAT ? r / SEQ : 8;
        const float* x = row_ptr(h, x0, ctx0, r); const float* sh = adaL + (size_t)bi * NMOD * DM + sh_off; const float* sc = adaL + (size_t)bi * NMOD * DM + sc_off;
        float4 v[8]; float ss = 0.f;
#pragma unroll
        for (int i = 0; i < 8; ++i) { v[i] = *(const float4*)(x + i * 256 + lane * 4); ss += v[i].x * v[i].x + v[i].y * v[i].y + v[i].z * v[i].z + v[i].w * v[i].w; }
        ss = wave_sum(ss); const float inv = rsqrtf(ss / (float)DM + 1e-6f);
#pragma unroll
        for (int i = 0; i < 8; ++i) { const int c = i * 256 + lane * 4; const float4 gg = *(const float4*)(g + c), s1 = *(const float4*)(sc + c), s0 = *(const float4*)(sh + c);
            u32x2 o; o.x = f2bf(v[i].x * inv * gg.x * (1.f + s1.x) + s0.x) | ((unsigned)f2bf(v[i].y * inv * gg.y * (1.f + s1.y) + s0.y) << 16);
            o.y = f2bf(v[i].z * inv * gg.z * (1.f + s1.z) + s0.z) | ((unsigned)f2bf(v[i].w * inv * gg.w * (1.f + s1.w) + s0.w) << 16);
            *(u32x2*)(a + (size_t)r * DM + c) = o; }
    }
}
DI void p_final(const VB& V, const float* __restrict__ h, const float* __restrict__ g, float* __restrict__ out) {
    const int lane = V.vtid & 63;
    for (int r = V.vb * 4 + (V.vtid >> 6); r < T_LAT; r += V.nvb * 4) {
        const float* x = h + (size_t)r * DM; float4 v[8]; float ss = 0.f;
#pragma unroll
        for (int i = 0; i < 8; ++i) { v[i] = *(const float4*)(x + i * 256 + lane * 4); ss += v[i].x * v[i].x + v[i].y * v[i].y + v[i].z * v[i].z + v[i].w * v[i].w; }
        ss = wave_sum(ss); const float inv = rsqrtf(ss / (float)DM + 1e-6f);
#pragma unroll
        for (int i = 0; i < 8; ++i) { const int c = i * 256 + lane * 4; const float4 gg = *(const float4*)(g + c);
            *(float4*)(out + (size_t)r * DM + c) = make_float4(v[i].x * inv * gg.x, v[i].y * inv * gg.y, v[i].z * inv * gg.z, v[i].w * inv * gg.w); }
    }
}

template <class Epi> DI void p_gemm_simple(const VB& V, const bf16_t* __restrict__ A, const bf16_t* __restrict__ Bt, int M, int N, int K, const Epi& E) {
    const int lane = V.vtid & 63, w = V.vtid >> 6, fr = lane & 15, fq = lane >> 4; const int ntn = N / 64, nun = ntn * (M / 64);
    for (int u = V.vb; u < nun; u += V.nvb) {
        const int row0 = (u / ntn) * 64 + w * 16, col0 = (u % ntn) * 64;
        f32x4 acc[4];
#pragma unroll
        for (int i = 0; i < 4; ++i) acc[i] = (f32x4){0.f, 0.f, 0.f, 0.f};
        const bf16_t* ap = A + (size_t)(row0 + fr) * K + fq * 8;
        const bf16_t* bp = Bt + (size_t)(col0 + fr) * K + fq * 8;
        for (int k = 0; k < K; k += 32) {
            const bf16x8 a = *(const bf16x8*)(ap + k);
#pragma unroll
            for (int i = 0; i < 4; ++i) { const bf16x8 b = *(const bf16x8*)(bp + (size_t)i * 16 * K + k); acc[i] = __builtin_amdgcn_mfma_f32_16x16x32_bf16(a, b, acc[i], 0, 0, 0); }
        }
#pragma unroll
        for (int j = 0; j < 4; ++j) E(row0 + fq * 4 + j, col0 + fr, acc[0][j], acc[1][j], acc[2][j], acc[3][j]);
    }
}
struct EpiQKV {
    bf16_t* Q; bf16_t* Kb; bf16_t* Vt; const float2* rope;
    DI void operator()(int r, int c, float v0, float v1, float v2, float v3) const {
        if (c < 2560) {
            if (r < T_LAT) {
                const int t = r % SEQ, ri = t >> 6, ci = t & 63;
                const int G = (c & 127) >> 5; const int j = c & 15;
                {   const int f = (G & 1) * 16 + j; const float2 cs = rope[((G >> 1) ? ci : ri) * 32 + f];
                    const float lo = v0, hi = v1; v0 = lo * cs.x - hi * cs.y; v1 = hi * cs.x + lo * cs.y; }
                {   const int G2 = G + 1; const int f = (G2 & 1) * 16 + j; const float2 cs = rope[((G2 >> 1) ? ci : ri) * 32 + f];
                    const float lo = v2, hi = v3; v2 = lo * cs.x - hi * cs.y; v3 = hi * cs.x + lo * cs.y; }
            }
            bf16_t* dst = c < 2048 ? Q + (size_t)r * DM + c : Kb + (size_t)r * 512 + (c - 2048);
            dst[0] = f2bf(v0); dst[16] = f2bf(v1); dst[32] = f2bf(v2); dst[48] = f2bf(v3);
        } else {
            const int cv = c - 2560;
            Vt[(size_t)(cv) * T_ALL + r] = f2bf(v0); Vt[(size_t)(cv + 16) * T_ALL + r] = f2bf(v1); Vt[(size_t)(cv + 32) * T_ALL + r] = f2bf(v2); Vt[(size_t)(cv + 48) * T_ALL + r] = f2bf(v3);
        }
    }
};
struct EpiRes {
    const float* h; const float* x0; const float* ctx0; float* hout; const float* adaL; int g_off;
    DI void operator()(int r, int c, float v0, float v1, float v2, float v3) const {
        const int bi = r < T_LAT ? r / SEQ : 8; const float* g = adaL + (size_t)bi * NMOD * DM + g_off + c; const float* b = row_ptr(h, x0, ctx0, r) + c; float* o = hout + (size_t)r * DM + c;
        o[0] = b[0] + g[0] * v0; o[16] = b[16] + g[16] * v1; o[32] = b[32] + g[32] * v2; o[48] = b[48] + g[48] * v3;
    }
};
struct EpiBf { bf16_t* O; int ldc;
    DI void operator()(int r, int c, float v0, float v1, float v2, float v3) const { bf16_t* d = O + (size_t)r * ldc + c; d[0] = f2bf(v0); d[16] = f2bf(v1); d[32] = f2bf(v2); d[48] = f2bf(v3); } };
struct EpiBfT { bf16_t* O; int ldr;
    DI void operator()(int r, int c, float v0, float v1, float v2, float v3) const { O[(size_t)c * ldr + r] = f2bf(v0); O[(size_t)(c + 16) * ldr + r] = f2bf(v1); O[(size_t)(c + 32) * ldr + r] = f2bf(v2); O[(size_t)(c + 48) * ldr + r] = f2bf(v3); } };

DI void p_attn_naive(const VB& V, const bf16_t* __restrict__ Q, const bf16_t* __restrict__ Kb, const bf16_t* __restrict__ Vt, const float* __restrict__ sink, bf16_t* __restrict__ O, int nrows) {
    float (*qs)[128] = (float (*)[128])V.lds; float (*ps)[520] = (float (*)[520])(V.lds + 4 * 128 * 4);
    const int w = V.vtid >> 6, lane = V.vtid & 63; const int nun = nrows * NKVH;
    VB_LOOP(u, nun) {
        const bool act = u < nun; const int r = act ? u / NKVH : 0, kvh = u % NKVH, hq = kvh * 4 + w;
        int lo, nwin, cbase;
        if (r < T_LAT) { const int b = r / SEQ, t = r % SEQ; const int tlo = t - 128 < 0 ? 0 : t - 128, thi = t + 128 > SEQ - 1 ? SEQ - 1 : t + 128; lo = b * SEQ + tlo; nwin = thi - tlo + 1; cbase = T_LAT + b * CTX; }
        else { const int b = (r - T_LAT) / CTX; lo = 0; nwin = 0; cbase = T_LAT + b * CTX; }
        const int nk = nwin + CTX;
        qs[w][lane] = bf2f(Q[(size_t)r * DM + hq * 128 + lane]); qs[w][lane + 64] = bf2f(Q[(size_t)r * DM + hq * 128 + 64 + lane]);
        __syncthreads();
        const float scale = 0.08838834764831845f;
        float mx = -3.0e38f;
        for (int kk = lane; kk < nk; kk += 64) {
            const int kr = kk < nwin ? lo + kk : cbase + (kk - nwin);
            const bf16_t* kp = Kb + (size_t)kr * 512 + kvh * 128; float s = 0.f;
            for (int d8 = 0; d8 < 16; ++d8) { const bf16x8 kv = *(const bf16x8*)(kp + d8 * 8);
#pragma unroll
                for (int j = 0; j < 8; ++j) s += qs[w][d8 * 8 + j] * bf2f((bf16_t)kv[j]); }
            s *= scale; ps[w][kk] = s; mx = fmaxf(mx, s);
        }
        const float sk = sink[hq];
        mx = fmaxf(wave_max(mx), sk);
        float sum = 0.f;
        for (int kk = lane; kk < nk; kk += 64) { const float p = expf(ps[w][kk] - mx); ps[w][kk] = p; sum += p; }
        sum = wave_sum(sum) + expf(sk - mx);
        __syncthreads();
        const float inv = 1.0f / sum;
        if (act) {
#pragma unroll
            for (int dd = 0; dd < 2; ++dd) {
                const int d = lane + 64 * dd; const bf16_t* vp = Vt + (size_t)(kvh * 128 + d) * T_ALL; float acc = 0.f;
                for (int kk = 0; kk < nwin; ++kk) acc += ps[w][kk] * bf2f(vp[lo + kk]);
                for (int kk = 0; kk < CTX; ++kk) acc += ps[w][nwin + kk] * bf2f(vp[cbase + kk]);
                O[(size_t)r * DM + hq * 128 + d] = f2bf(acc * inv);
            }
        }
        __syncthreads();
    }
}

template <int L> DI void p_hyena_naive(const VB& V, const bf16_t* __restrict__ Ut, const float* __restrict__ cw, const float* __restrict__ cb, const bf16_t* __restrict__ G, bf16_t* __restrict__ Y, int tok0) {
    float* sv = (float*)V.lds; float* sx1 = sv + L; float* sx2 = sx1 + L; float* g0 = sx2 + L; float* g1 = g0 + 2 * L;
    const int tid = V.vtid; constexpr int NO = L / 256; const int nun = DM * NB;
    VB_LOOP(u, nun) {
        const bool act = u < nun; const int d = act ? u % DM : 0, b = act ? u / DM : 0; const int base = tok0 + b * L;
        for (int part = 0; part < 3; ++part) {
            const int ch = part * DM + d; const bf16_t* uu = Ut + (size_t)ch * T_ALL + base; const float w0 = cw[ch], w1 = cw[3 * DM + ch], w2 = cw[6 * DM + ch], bb = cb[ch];
            float* dst = part == 0 ? sv : (part == 1 ? sx1 : sx2);
            for (int t = tid; t < L; t += 256) { const float xm = t > 0 ? bf2f(uu[t - 1]) : 0.f, x0 = bf2f(uu[t]), xp = t < L - 1 ? bf2f(uu[t + 1]) : 0.f; dst[t] = bb + w0 * xm + w1 * x0 + w2 * xp; }
        }
        for (int m = tid; m < 2 * L; m += 256) { g0[m] = bf2f(G[((size_t)0 * DM + d) * (2 * L) + m]); g1[m] = bf2f(G[((size_t)1 * DM + d) * (2 * L) + m]); }
        __syncthreads();
        float acc[NO];
#pragma unroll
        for (int i = 0; i < NO; ++i) acc[i] = 0.f;
        for (int s = 0; s < L; ++s) { const float zv = sv[s];
#pragma unroll
            for (int i = 0; i < NO; ++i) acc[i] += g0[L - (tid + 256 * i) + s] * zv; }
        __syncthreads();
#pragma unroll
        for (int i = 0; i < NO; ++i) { const int t = tid + 256 * i; sv[t] = bf2f(f2bf(sx1[t] * acc[i])); acc[i] = 0.f; }
        __syncthreads();
        for (int s = 0; s < L; ++s) { const float zv = sv[s];
#pragma unroll
            for (int i = 0; i < NO; ++i) acc[i] += g1[L - (tid + 256 * i) + s] * zv; }
        if (act) {
#pragma unroll
            for (int i = 0; i < NO; ++i) { const int t = tid + 256 * i; Y[(size_t)(base + t) * DM + d] = f2bf(sx2[t] * acc[i]); }
        }
        __syncthreads();
    }
}

DI void p_peer_topk_naive(const VB& V, const bf16_t* __restrict__ qb, const float* __restrict__ keys1, const float* __restrict__ keys2, int* __restrict__ idx, float* __restrict__ gate, int nrows) {
    float* qs = (float*)V.lds; float (*sc)[128] = (float (*)[128])(qs + 2048); float (*tv)[16] = (float (*)[16])(qs + 4096); int (*ti)[16] = (int (*)[16])(qs + 4096 + 256); float (*cand)[256] = (float (*)[256])(qs + 4096 + 512);
    const int tid = V.vtid;
    VB_LOOP(r, nrows) {
        const bool act = r < nrows; const int rr = act ? r : 0;
        for (int i = tid; i < 2048; i += 256) qs[i] = bf2f(qb[(size_t)rr * DM + i]);
        __syncthreads();
        for (int e = tid; e < 2048; e += 256) {
            const int list = e >> 7, key = e & 127, h = list >> 1, half = list & 1;
            const float* kp = (half ? keys2 : keys1) + ((size_t)h * 128 + key) * 128; const float* qp = qs + h * 256 + half * 128; float s = 0.f;
            for (int d = 0; d < 128; ++d) s += qp[d] * kp[d];
            sc[list][key] = s;
        }
        __syncthreads();
        if (tid < 16) {
            for (int k = 0; k < 16; ++k) { float best = -3.0e38f; int bi = 0;
                for (int j = 0; j < 128; ++j) { const float v = sc[tid][j]; if (v > best) { best = v; bi = j; } }
                tv[tid][k] = best; ti[tid][k] = bi; sc[tid][bi] = -3.0e38f; }
        }
        __syncthreads();
        for (int e = tid; e < 2048; e += 256) { const int h = e >> 8, p = e & 255; cand[h][p] = tv[2 * h][p >> 4] + tv[2 * h + 1][p & 15]; }
        __syncthreads();
        if (tid < 8 && act) {
            float ts[16]; int tp[16];
            float mx = 0.f, sum = 0.f;
#pragma unroll
            for (int k = 0; k < 16; ++k) { float best = -3.0e38f; int bp = 0;
                for (int j = 0; j < 256; ++j) { const float v = cand[tid][j]; if (v > best) { best = v; bp = j; } }
                ts[k] = best; tp[k] = bp; cand[tid][bp] = -3.0e38f; if (k == 0) mx = best; }
#pragma unroll
            for (int k = 0; k < 16; ++k) { ts[k] = expf(ts[k] - mx); sum += ts[k]; }
#pragma unroll
            for (int k = 0; k < 16; ++k) { const int p = tp[k]; idx[(size_t)r * 128 + tid * 16 + k] = ti[2 * tid][p >> 4] * 128 + ti[2 * tid + 1][p & 15]; gate[(size_t)r * 128 + tid * 16 + k] = ts[k] / sum; }
        }
        __syncthreads();
    }
}
DI void p_peer_gather_naive(const VB& V, const bf16_t* __restrict__ a, const int* __restrict__ idx, const float* __restrict__ gate, const float* __restrict__ ut, const float* __restrict__ vt,
                            const float* __restrict__ adaL, int g_off, float* __restrict__ hio, int nrows) {
    const int lane = V.vtid & 63;
    for (int r = V.vb * 4 + (V.vtid >> 6); r < nrows; r += V.nvb * 4) {
        const int bi = r < T_LAT ? r / SEQ : 8;
        float x[32], acc[32];
#pragma unroll
        for (int c = 0; c < 4; ++c) { const bf16x8 v = *(const bf16x8*)(a + (size_t)r * DM + c * 512 + lane * 8);
#pragma unroll
            for (int j = 0; j < 8; ++j) { x[c * 8 + j] = bf2f((bf16_t)v[j]); acc[c * 8 + j] = 0.f; } }
        for (int e = 0; e < 128; ++e) {
            const int id = idx[(size_t)r * 128 + e]; const float gt = gate[(size_t)r * 128 + e];
            const float* up = ut + (size_t)id * DM; const float* vp = vt + (size_t)id * DM; float s = 0.f;
#pragma unroll
            for (int c = 0; c < 4; ++c) { const float4 u0 = *(const float4*)(up + c * 512 + lane * 8), u1 = *(const float4*)(up + c * 512 + lane * 8 + 4);
                s += x[c * 8 + 0] * u0.x + x[c * 8 + 1] * u0.y + x[c * 8 + 2] * u0.z + x[c * 8 + 3] * u0.w + x[c * 8 + 4] * u1.x + x[c * 8 + 5] * u1.y + x[c * 8 + 6] * u1.z + x[c * 8 + 7] * u1.w; }
            s = wave_sum(s);
            const float wgt = gt * (0.5f * s * (1.0f + erff(s * 0.70710678118654752f)));
#pragma unroll
            for (int c = 0; c < 4; ++c) { const float4 v0 = *(const float4*)(vp + c * 512 + lane * 8), v1 = *(const float4*)(vp + c * 512 + lane * 8 + 4);
                acc[c * 8 + 0] += wgt * v0.x; acc[c * 8 + 1] += wgt * v0.y; acc[c * 8 + 2] += wgt * v0.z; acc[c * 8 + 3] += wgt * v0.w; acc[c * 8 + 4] += wgt * v1.x; acc[c * 8 + 5] += wgt * v1.y; acc[c * 8 + 6] += wgt * v1.z; acc[c * 8 + 7] += wgt * v1.w; }
        }
        const float* g2 = adaL + (size_t)bi * NMOD * DM + g_off; float* hp = hio + (size_t)r * DM;
#pragma unroll
        for (int c = 0; c < 4; ++c)
#pragma unroll
            for (int j = 0; j < 8; ++j) { const int col = c * 512 + lane * 8 + j; hp[col] += g2[col] * acc[c * 8 + j]; }
    }
}

struct Params {
    const float* in[28]; float* out; unsigned char* ws;
};
constexpr int LDS_BYTES = 147456;
constexpr int LDS_HALF = 65536;

struct Ctx {
    const float* x; const float* ctx; const float* norm_mix_g; const float* norm_ffn_g; const float* attn_sink; const float* hy_conv_w; const float* hy_conv_b;
    const float* peer_keys1; const float* peer_keys2; const float* peer_u; const float* peer_v;
    float* ada; float2* rope; float* h; bf16_t* a; bf16_t* q; bf16_t* kb; bf16_t* vt; bf16_t* o; bf16_t* ut; int* idx; float* gate;
    bf16_t* wqkv; bf16_t* wo; bf16_t* win; bf16_t* wout; bf16_t* wq; bf16_t* filt; bf16_t* filtc;
};
template <int I> DI void run_layer(const VB& V, const XcdBarrier& bar, const Ctx& C) {
    constexpr bool is_attn = (I % 2) == 0, ctx_upd = I < 2; constexpr int j = I / 2;
    const float* adaL = C.ada + (size_t)I * 9 * NMOD * DM;
    constexpr int rows_a = I <= 2 ? T_ALL : T_LAT;
    constexpr int rows_u = ctx_upd ? T_ALL : T_LAT;
    const float* x0 = I == 0 ? C.x : nullptr; const float* ctx0 = I == 0 ? C.ctx : nullptr;
    p_normmod(V, C.h, x0, ctx0, C.norm_mix_g + I * DM, adaL, 0, DM, C.a, rows_a);
    xcd_barrier(bar);
    if constexpr (is_attn) {
        EpiQKV e1{C.q, C.kb, C.vt, C.rope};
        p_gemm_simple(V, C.a, C.wqkv + (size_t)j * QKVW * DM, T_ALL, QKVW, DM, e1);
        xcd_barrier(bar);
        p_attn_naive(V, C.q, C.kb, C.vt, C.attn_sink + j * NQH, C.o, rows_u);
        xcd_barrier(bar);
        EpiRes e2{C.h, x0, ctx0, C.h, adaL, 2 * DM};
        p_gemm_simple(V, C.o, C.wo + (size_t)j * DM * DM, rows_u, DM, DM, e2);
    } else {
        EpiBfT e1{C.ut, T_ALL};
        p_gemm_simple(V, C.a, C.win + (size_t)j * 3 * DM * DM, rows_u, 3 * DM, DM, e1);
        xcd_barrier(bar);
        p_hyena_naive<SEQ>(V, C.ut, C.hy_conv_w + (size_t)j * 9 * DM, C.hy_conv_b + (size_t)j * 3 * DM, C.filt + (size_t)j * 2 * DM * 4096, C.o, 0);
        if constexpr (ctx_upd) p_hyena_naive<CTX>(V, C.ut, C.hy_conv_w + (size_t)j * 9 * DM, C.hy_conv_b + (size_t)j * 3 * DM, C.filtc, C.o, T_LAT);
        xcd_barrier(bar);
        EpiRes e2{C.h, nullptr, nullptr, C.h, adaL, 2 * DM};
        p_gemm_simple(V, C.o, C.wout + (size_t)j * DM * DM, rows_u, DM, DM, e2);
    }
    xcd_barrier(bar);
    p_normmod(V, C.h, nullptr, nullptr, C.norm_ffn_g + I * DM, adaL, 3 * DM, 4 * DM, C.a, rows_u);
    xcd_barrier(bar);
    EpiBf e3{C.q, DM};
    p_gemm_simple(V, C.a, C.wq + (size_t)I * DM * DM, rows_u, DM, DM, e3);
    xcd_barrier(bar);
    p_peer_topk_naive(V, C.q, C.peer_keys1 + (size_t)I * 8 * 128 * 128, C.peer_keys2 + (size_t)I * 8 * 128 * 128, C.idx, C.gate, rows_u);
    xcd_barrier(bar);
    p_peer_gather_naive(V, C.a, C.idx, C.gate, C.peer_u + (size_t)I * NEXP * DM, C.peer_v + (size_t)I * NEXP * DM, adaL, 5 * DM, C.h, rows_u);
    xcd_barrier(bar);
}

__global__ void __launch_bounds__(512, 2) mega_fwd(Params P) {
    extern __shared__ __attribute__((aligned(16))) unsigned char lds[];
    volatile LAS unsigned* xbw = (volatile LAS unsigned*)(LAS unsigned char*)(lds + 2 * LDS_HALF);
    if (threadIdx.x < 4) xbw[threadIdx.x] = 0u;
    __syncthreads();
    unsigned char* ws = P.ws;
    XcdBarrier bar = xcd_barrier_post((unsigned*)(ws + W.bar), xbw);
    VB V; V.vb = blockIdx.x * 2 + (threadIdx.x >> 8); V.nvb = gridDim.x * 2; V.vtid = threadIdx.x & 255; V.lds = lds + (threadIdx.x >> 8) * LDS_HALF;

    const float* c = P.in[1]; const float* c_ctx = P.in[3];
    const float* ada_w = P.in[4]; const float* ada_b = P.in[5];
    const float* final_g = P.in[8]; const float* attn_w_qkv = P.in[9]; const float* attn_w_o = P.in[10];
    const float* hy_w_in = P.in[12]; const float* hy_f_w1 = P.in[15];
    const float* hy_f_b1 = P.in[16]; const float* hy_f_w2 = P.in[17]; const float* hy_f_b2 = P.in[18]; const float* hy_f_w3 = P.in[19];
    const float* hy_decay = P.in[20]; const float* hy_fbias = P.in[21]; const float* hy_w_out = P.in[22]; const float* peer_w_q = P.in[23];
    float* cond = (float*)(ws + W.cond); float* h3 = (float*)(ws + W.h3);
    Ctx C;
    C.x = P.in[0]; C.ctx = P.in[2]; C.norm_mix_g = P.in[6]; C.norm_ffn_g = P.in[7]; C.attn_sink = P.in[11]; C.hy_conv_w = P.in[13]; C.hy_conv_b = P.in[14];
    C.peer_keys1 = P.in[24]; C.peer_keys2 = P.in[25]; C.peer_u = P.in[26]; C.peer_v = P.in[27];
    C.ada = (float*)(ws + W.ada); C.rope = (float2*)(ws + W.rope); C.h = (float*)(ws + W.h);
    C.a = (bf16_t*)(ws + W.a); C.q = (bf16_t*)(ws + W.q); C.kb = (bf16_t*)(ws + W.k); C.vt = (bf16_t*)(ws + W.vt); C.o = (bf16_t*)(ws + W.o);
    C.ut = (bf16_t*)(ws + W.ut); C.idx = (int*)(ws + W.idx); C.gate = (float*)(ws + W.gate);
    C.wqkv = (bf16_t*)(ws + W.wqkv); C.wo = (bf16_t*)(ws + W.wo); C.win = (bf16_t*)(ws + W.win); C.wout = (bf16_t*)(ws + W.wout); C.wq = (bf16_t*)(ws + W.wq);
    C.filt = (bf16_t*)(ws + W.filt); C.filtc = (bf16_t*)(ws + W.filtc);

    p_cond(V, c, c_ctx, cond);
    p_rope(V, C.rope);
    for (int j = 0; j < 2; ++j) {
        p_wt(V, attn_w_qkv + (size_t)j * DM * QKVW, C.wqkv + (size_t)j * QKVW * DM, DM, QKVW, 2560);
        p_wt(V, attn_w_o + (size_t)j * DM * DM, C.wo + (size_t)j * DM * DM, DM, DM, 0);
        p_wt(V, hy_w_in + (size_t)j * DM * 3 * DM, C.win + (size_t)j * 3 * DM * DM, DM, 3 * DM, 0);
        p_wt(V, hy_w_out + (size_t)j * DM * DM, C.wout + (size_t)j * DM * DM, DM, DM, 0);
        float* h3l = h3 + (size_t)j * (SEQ + CTX) * 64;
        p_hy_h3(V, hy_f_w1 + j * 33 * 64, hy_f_b1 + j * 64, hy_f_w2 + j * 2 * 64 * 64, hy_f_b2 + j * 2 * 64, h3l, SEQ);
        if (j == 0) p_hy_h3(V, hy_f_w1, hy_f_b1, hy_f_w2, hy_f_b2, h3l + SEQ * 64, CTX);
    }
    for (int i = 0; i < 4; ++i) p_wt(V, peer_w_q + (size_t)i * DM * DM, C.wq + (size_t)i * DM * DM, DM, DM, 0);
    xcd_barrier(bar);
    p_ada(V, cond, ada_w, ada_b, C.ada);
    for (int j = 0; j < 2; ++j) {
        float* h3l = h3 + (size_t)j * (SEQ + CTX) * 64;
        p_hy_filt(V, h3l, hy_f_w3 + (size_t)j * 64 * 4 * DM, hy_decay + j * 2 * DM, hy_fbias + j * 2 * DM, C.filt + (size_t)j * 2 * DM * 4096, SEQ);
        if (j == 0) p_hy_filt(V, h3l + SEQ * 64, hy_f_w3, hy_decay, hy_fbias, C.filtc, CTX);
    }
    xcd_barrier(bar);
    run_layer<0>(V, bar, C);
    run_layer<1>(V, bar, C);
    run_layer<2>(V, bar, C);
    run_layer<3>(V, bar, C);
    p_final(V, C.h, final_g, P.out);
}

extern "C" void kernel_launch(void* const* d_in, const int* in_sizes, int n_in, void* d_out, int out_size, void* d_ws, size_t ws_size, hipStream_t stream) {
    static int grid = 0;
    if (grid == 0) {
        if (n_in != 28 || ws_size < W.end) { fprintf(stderr, "kernel_launch: bad inputs / workspace too small: %zu < %zu\n", ws_size, W.end); grid = -1; return; }
        int dev = 0, cus = 0, per_cu = 0;
        if (hipGetDevice(&dev) != hipSuccess || hipDeviceGetAttribute(&cus, hipDeviceAttributeMultiprocessorCount, dev) != hipSuccess) { grid = -1; return; }
        if (hipFuncSetAttribute((const void*)mega_fwd, hipFuncAttributeMaxDynamicSharedMemorySize, LDS_BYTES) != hipSuccess) { fprintf(stderr, "kernel_launch: hipFuncSetAttribute failed\n"); grid = -1; return; }
        if (hipOccupancyMaxActiveBlocksPerMultiprocessor(&per_cu, (const void*)mega_fwd, 512, LDS_BYTES) != hipSuccess || per_cu < 1) fprintf(stderr, "kernel_launch: occupancy query says %d\n", per_cu);
        (void)hipGetLastError();
        grid = cus;
    }
    if (grid < 0) return;
    (void)hipMemsetAsync((unsigned char*)d_ws + W.bar, 0, 64 * 1024, stream);
    Params P{};
    for (int i = 0; i < 28; ++i) P.in[i] = (const float*)d_in[i];
    P.out = (float*)d_out; P.ws = (unsigned char*)d_ws;
    hipLaunchKernelGGL(mega_fwd, dim3(grid), dim3(512), LDS_BYTES, stream, P);
}
```

```cpp
#include <hip/hip_runtime.h>
#include <stdint.h>
#include <stdio.h>

typedef unsigned short bf16_t;
typedef short bf16x8 __attribute__((ext_vector_type(8)));
typedef float f32x4 __attribute__((ext_vector_type(4)));
typedef unsigned u32x4 __attribute__((ext_vector_type(4)));
typedef unsigned u32x2 __attribute__((ext_vector_type(2)));

#define DI __device__ __forceinline__

constexpr int DM = 2048;
constexpr int NB = 8;
constexpr int SEQ = 2048;
constexpr int CTX = 256;
constexpr int T_LAT = NB * SEQ;
constexpr int T_CTX = NB * CTX;
constexpr int T_ALL = T_LAT + T_CTX;
constexpr int NMOD = 6;
constexpr int HD = 128, NQH = 16, NKVH = 4;
constexpr int QKVW = 3072;
constexpr int PH = 8, PNK = 128, PTOPK = 16;
constexpr int NEXP = 16384;

DI bf16_t f2bf(float f) { unsigned u = __float_as_uint(f); u += 0x7fffu + ((u >> 16) & 1u); return (bf16_t)(u >> 16); }
DI float bf2f(bf16_t b) { return __uint_as_float(((unsigned)b) << 16); }
DI float wave_sum(float v) { for (int o = 32; o >= 1; o >>= 1) v += __shfl_xor(v, o); return v; }
DI float wave_max(float v) { for (int o = 32; o >= 1; o >>= 1) v = fmaxf(v, __shfl_xor(v, o)); return v; }

__host__ __device__ inline int head_perm(int p) { const int G = p >> 5, half = (p >> 4) & 1, j = p & 15; const int base = (G & 1) * 16 + (G >> 1) * 64; return base + j + 32 * half; }

struct WS {
    size_t bar, cond, ada, rope, h, a, q, k, vt, o, ut, yt, idx, gate, wqkv, wo, win, wout, wq, filt, filtc, h3, pu, pv, psc, part, xd, xsc, wh, dl, h16, end;
};
constexpr size_t ws_take(size_t& p, size_t bytes) { size_t r = p; p += (bytes + 255) & ~(size_t)255; return r; }
constexpr WS make_ws() {
    WS w{}; size_t p = 0;
    w.bar = ws_take(p, 128 * 1024);
    w.cond = ws_take(p, (size_t)9 * DM * 4);
    w.ada = ws_take(p, (size_t)4 * 9 * NMOD * DM * 4);
    w.rope = ws_take(p, (size_t)64 * 32 * 8);
    w.h = ws_take(p, (size_t)T_ALL * DM * 4);
    w.a = ws_take(p, (size_t)T_ALL * DM * 2);
    w.q = ws_take(p, (size_t)T_ALL * DM * 2);
    w.k = ws_take(p, (size_t)T_ALL * 512 * 2);
    w.vt = ws_take(p, (size_t)512 * T_ALL * 2);
    w.o = ws_take(p, (size_t)T_ALL * DM * 2);
    w.ut = ws_take(p, (size_t)3 * DM * T_ALL * 2);
    w.yt = ws_take(p, (size_t)DM * T_ALL * 2);
    w.idx = ws_take(p, (size_t)T_ALL * 128 * 4);
    w.gate = ws_take(p, (size_t)T_ALL * 128 * 4);
    w.wqkv = ws_take(p, (size_t)2 * QKVW * DM * 2);
    w.wo = ws_take(p, (size_t)2 * DM * DM * 2);
    w.win = ws_take(p, (size_t)2 * 3 * DM * DM * 2);
    w.wout = ws_take(p, (size_t)2 * DM * DM * 2);
    w.wq = ws_take(p, (size_t)4 * DM * DM * 2);
    w.filt = ws_take(p, (size_t)2 * 2 * DM * 4096 * 2);
    w.filtc = ws_take(p, (size_t)2 * DM * 512 * 2);
    w.h3 = ws_take(p, (size_t)2 * (SEQ + CTX) * 64 * 4);
    w.pu = ws_take(p, (size_t)4 * NEXP * DM / 2);
    w.pv = ws_take(p, (size_t)4 * NEXP * DM / 2);
    w.psc = ws_take(p, (size_t)4 * 2 * NEXP * 4);
    w.part = ws_take(p, (size_t)16 * T_ALL * 128 * 4);
    w.xd = ws_take(p, (size_t)T_ALL * 512 * 4);
    w.xsc = ws_take(p, (size_t)T_ALL * 4);
    w.wh = ws_take(p, (size_t)T_ALL * 64 * 4);
    w.dl = ws_take(p, (size_t)T_ALL * DM * 2);
    w.h16 = ws_take(p, (size_t)T_ALL * DM * 2);
    w.end = p;
    return w;
}
#ifndef PROBE_DUP
#define DELTA_LAYERS 3
#define PROBE_DUP 0
#endif
constexpr WS W = make_ws();
constexpr int PQ_OFF_WORDS = 4096;

namespace pg8 {
#define PG8_LAS __attribute__((address_space(3)))
typedef unsigned short bf16_t;
typedef short bf16x8 __attribute__((ext_vector_type(8)));
typedef float f32x4 __attribute__((ext_vector_type(4)));
typedef unsigned u32x4 __attribute__((ext_vector_type(4)));
constexpr int BM = 256, BK = 64, HALF = 128, HTB = HALF * BK * 2  , STAGE_BYTES = 8 * HTB, NXCD = 8, WGM = 8;

__host__ __device__ __forceinline__ int lds_byte(int r, int c) { const int st = (r >> 4) * 2 + (c >> 5), rr = r & 15, cc = c & 31, ob = rr * 64 + cc * 2; return st * 1024 + (ob ^ (((ob >> 9) & 1) << 5)); }
__host__ __device__ __forceinline__ void stage_rc(int b, int& R, int& C) { const int st = b / 1024, sb = b % 1024, swz = sb ^ (((sb >> 9) & 1) << 5); R = (st >> 1) * 16 + swz / 64; C = (st & 1) * 32 + (swz % 64) / 2; }
__host__ __device__ __forceinline__ int perm32(int rho) { const int n = rho >> 4, i = rho & 15; return 8 * (i >> 2) + 4 * n + (i & 3); }

struct Unit { int pm, pn; };
struct Gemm { const bf16_t* A; const bf16_t* Bt; int M, N, K; int sc; };
typedef int i32x4 __attribute__((ext_vector_type(4)));
typedef int i32x8 __attribute__((ext_vector_type(8)));

struct StaticOrder {
    int nM, nN, nwg, G, c;
    __host__ __device__ void init(int M, int N, int G_, int c_) { nM = M / BM; nN = N / BM; nwg = nM * nN; G = G_; c = c_; }
    __host__ __device__ bool next(int i, Unit& u) const {
        const long L = (long)i * G + c; if (L >= nwg) return false;
        int wgid = (int)L; { const int q = nwg / NXCD, r = nwg % NXCD, xcd = wgid % NXCD, off = wgid / NXCD; wgid = (xcd < r ? xcd * (q + 1) : r * (q + 1) + (xcd - r) * q) + off; }
        const int nig = WGM * nN, gid = wgid / nig, fm = gid * WGM, gsz = (nM - fm) < WGM ? (nM - fm) : WGM;
        u.pm = fm + ((wgid % nig) % gsz); u.pn = (wgid % nig) / gsz; return true;
    }
    __device__ __forceinline__ void a_ready(const Unit&) const {}
    __device__ __forceinline__ void done(const Unit&) const {}
};
struct CountedOrder : StaticOrder {
    const unsigned* ready; unsigned need; unsigned* tmo;
    __device__ __forceinline__ void a_ready(const Unit& u) const {
        if (threadIdx.x < 64) {
            const unsigned long long t0 = __builtin_amdgcn_s_memrealtime(); unsigned polls = 0;
            while ((unsigned)__builtin_amdgcn_readfirstlane(__hip_atomic_load(ready + 64 * u.pm, __ATOMIC_RELAXED, __HIP_MEMORY_SCOPE_AGENT)) < need) {
                if ((++polls & 255u) == 0u && __builtin_amdgcn_readfirstlane(__hip_atomic_load(tmo, __ATOMIC_RELAXED, __HIP_MEMORY_SCOPE_AGENT)) != 0u) break;
                if (__builtin_amdgcn_s_memrealtime() - t0 > 2000000ull) {
                    if (threadIdx.x == 0) { unsigned expect = 0u; __hip_atomic_compare_exchange_strong(tmo + 1, &expect, 0x600u | (unsigned)(u.pm & 0xff), __ATOMIC_RELAXED, __ATOMIC_RELAXED, __HIP_MEMORY_SCOPE_AGENT); __hip_atomic_store(tmo, 1u, __ATOMIC_RELAXED, __HIP_MEMORY_SCOPE_AGENT); }
                    break; }
                __builtin_amdgcn_s_sleep(2); }
            __builtin_amdgcn_fence(__ATOMIC_ACQUIRE, "agent");
            asm volatile("s_waitcnt vmcnt(0)" ::: "memory");
        }
#if !defined(BROKEN_HOOK_NO_BARRIER)
        asm volatile("" ::: "memory"); __builtin_amdgcn_s_barrier(); asm volatile("" ::: "memory");
#endif
    }
};

__device__ __forceinline__ unsigned cvt_pk_bf16(float lo, float hi) { unsigned r; asm volatile("v_cvt_pk_bf16_f32 %0, %1, %2" : "=v"(r) : "v"(lo), "v"(hi)); return r; }
template <class Epi, class Sched, bool STAMP = false, bool F8 = false>
__device__ __forceinline__ void gemm_phase(PG8_LAS unsigned char* lds, const Gemm g, const Sched& S, const Epi& E, unsigned long long* stamps) {
    int tid_ = threadIdx.x; asm volatile("" : "+v"(tid_));
    const int tid = tid_, wid = __builtin_amdgcn_readfirstlane(tid >> 6), lane = tid & 63, wr = wid >> 2, wc = wid & 3, fr = lane & 15, fq = lane >> 4;
    const int K = g.K, nt = K / BK;
    int ts_lo = 0, ts_hi = 0, nts = 0; const unsigned long long rt_entry = STAMP ? (unsigned long long)wall_clock64() : 0ull;
#define PG8_STAMP() do { if (STAMP && wid == 0 && nts < 64) { const unsigned long long _c = (unsigned long long)clock64(); \
        ts_lo = (lane == nts) ? (int)(unsigned)_c : ts_lo; ts_hi = (lane == nts) ? (int)(unsigned)(_c >> 32) : ts_hi; ++nts; } } while (0)
    PG8_STAMP();
    unsigned voffA[2], voffB[2];
#pragma unroll
    for (int i = 0; i < 2; ++i) { int R, C; stage_rc(tid * 16 + i * 8192, R, C); const int Rb = Epi::PERM ? ((R & ~31) + perm32(R & 31)) : R;
        voffA[i] = (unsigned)(R * K + C) * 2u; voffB[i] = (unsigned)(Rb * K + C) * 2u; }
    const size_t kstep = (size_t)(BK * 2);
    const size_t hstep = (size_t)HALF * K * 2;
    const size_t tstep = 2 * hstep;
    const unsigned ldsw = (unsigned)wid * 1024u;
    const int aoff = lds_byte(wr * 64 + fr, fq * 8), boff = lds_byte(wc * 32 + fr, fq * 8);
#define PG8_SA(b, h) (((b) * 2 + (h)) * HTB)
#define PG8_SB(b, h) ((4 + (b) * 2 + (h)) * HTB)
#define PG8_STAGE(bufoff, gbase, voff) do { _Pragma("unroll") for (int _i = 0; _i < 2; ++_i) \
        __builtin_amdgcn_global_load_lds((const unsigned*)((const char*)(gbase) + (voff)[_i]), (PG8_LAS unsigned*)(lds + (bufoff) + ldsw + _i * 8192), 16, 0, 0); } while (0)
#define PG8_RD(off) (*(const PG8_LAS i32x4*)(lds + (off)))
#define PG8_LDA(dst, b, h) do { _Pragma("unroll") for (int m = 0; m < 4; ++m) { if constexpr (F8) { dst##8[m].lo = PG8_RD(PG8_SA(b, h) + aoff + m * 2048); dst##8[m].hi = PG8_RD(PG8_SA(b, h) + aoff + m * 2048 + 1024); } \
        else { _Pragma("unroll") for (int k = 0; k < 2; ++k) dst[m][k] = *(const PG8_LAS bf16x8*)(lds + PG8_SA(b, h) + aoff + m * 2048 + k * 1024); } } } while (0)
#define PG8_LDB(dst, b, h) do { _Pragma("unroll") for (int n = 0; n < 2; ++n) { if constexpr (F8) { dst##8[n].lo = PG8_RD(PG8_SB(b, h) + boff + n * 2048); dst##8[n].hi = PG8_RD(PG8_SB(b, h) + boff + n * 2048 + 1024); } \
        else { _Pragma("unroll") for (int k = 0; k < 2; ++k) dst[n][k] = *(const PG8_LAS bf16x8*)(lds + PG8_SB(b, h) + boff + n * 2048 + k * 1024); } } } while (0)
#define PG8_MMA(ai, bj, At, Bt) do { __builtin_amdgcn_s_setprio(1); _Pragma("unroll") for (int m = 0; m < 4; ++m) _Pragma("unroll") for (int n = 0; n < 2; ++n) { \
        if constexpr (F8) asm volatile("v_mfma_scale_f32_16x16x128_f8f6f4 %0, %1, %2, %0, %3, %3 op_sel_hi:[0,0,0]" : "+v"(acc[ai][bj][m][n]) : "v"(Bt##8[n]), "v"(At##8[m]), "v"(scv));   \
        else { _Pragma("unroll") for (int k = 0; k < 2; ++k) acc[ai][bj][m][n] = __builtin_amdgcn_mfma_f32_16x16x32_bf16(Bt[n][k], At[m][k], acc[ai][bj][m][n], 0, 0, 0); } } \
        __builtin_amdgcn_s_setprio(0); } while (0)
#define PG8_WAIT_V(n) asm volatile("s_waitcnt vmcnt(" #n ")" ::: "memory")
#define PG8_WAIT_L(n) asm volatile("s_waitcnt lgkmcnt(" #n ")" ::: "memory")
#define PG8_BAR __builtin_amdgcn_s_barrier()
#define PG8_SCHED __builtin_amdgcn_sched_barrier(0)
    Unit cur, nxt; int ui = 0;
    if (!S.next(0, cur)) return;
    f32x4 acc[2][2][4][2];
#pragma unroll
    for (int a = 0; a < 2; ++a)
#pragma unroll
        for (int b = 0; b < 2; ++b)
#pragma unroll
            for (int m = 0; m < 4; ++m)
#pragma unroll
                for (int n = 0; n < 2; ++n) acc[a][b][m][n] = (f32x4){0.f, 0.f, 0.f, 0.f};
    bf16x8 At[4][2], B0[2][2], B1[2][2];
    const int scv = g.sc; i32x8 At8[4], B08[2], B18[2];
    const char* cA = (const char*)g.A + (size_t)cur.pm * tstep; const char* cB = (const char*)g.Bt + (size_t)cur.pn * tstep;
    S.a_ready(cur);
    PG8_STAGE(PG8_SB(0, 0), cB, voffB); PG8_STAGE(PG8_SA(0, 0), cA, voffA); PG8_STAGE(PG8_SB(0, 1), cB + hstep, voffB); PG8_STAGE(PG8_SA(0, 1), cA + hstep, voffA);
    if (wr == 1) PG8_BAR;
    PG8_WAIT_V(4); PG8_BAR;
    PG8_STAGE(PG8_SB(1, 0), cB + kstep, voffB); PG8_STAGE(PG8_SA(1, 0), cA + kstep, voffA); PG8_STAGE(PG8_SB(1, 1), cB + hstep + kstep, voffB);
    PG8_WAIT_V(6); PG8_BAR;
    PG8_STAMP();
    for (;;) {
        const bool has_next = S.next(ui + 1, nxt);
        const char* nA = has_next ? (const char*)g.A + (size_t)nxt.pm * tstep : cA; const char* nB = has_next ? (const char*)g.Bt + (size_t)nxt.pn * tstep : cB;
        for (int t = 0; t < nt; t += 2) {
            const bool last = (t == nt - 2);
            const char* a1 = cA + (size_t)(t + 1) * kstep;
            const char* a2 = last ? nA : cA + (size_t)(t + 2) * kstep; const char* b2 = last ? nB : cB + (size_t)(t + 2) * kstep;
            const char* a3 = a2 + kstep; const char* b3 = b2 + kstep;
            if (last && has_next) S.a_ready(nxt);
            PG8_LDB(B0, 0, 0); PG8_SCHED; PG8_LDA(At, 0, 0); PG8_STAGE(PG8_SA(1, 1), a1 + hstep, voffA);
            PG8_WAIT_L(8); PG8_BAR; PG8_WAIT_L(0); PG8_MMA(0, 0, At, B0); PG8_BAR; PG8_SCHED;
            PG8_LDB(B1, 0, 1); PG8_STAGE(PG8_SB(0, 0), b2, voffB);
            PG8_BAR; PG8_WAIT_L(0); PG8_MMA(0, 1, At, B1); PG8_BAR;
            PG8_LDA(At, 0, 1); PG8_STAGE(PG8_SA(0, 0), a2, voffA);
            PG8_BAR; PG8_WAIT_L(0); PG8_MMA(1, 0, At, B0); PG8_BAR; PG8_SCHED;
            PG8_STAGE(PG8_SB(0, 1), b2 + hstep, voffB);
            PG8_WAIT_V(6); PG8_BAR; PG8_MMA(1, 1, At, B1); PG8_BAR;
            PG8_LDB(B0, 1, 0); PG8_SCHED; PG8_LDA(At, 1, 0); PG8_STAGE(PG8_SA(0, 1), a2 + hstep, voffA);
            PG8_WAIT_L(8); PG8_BAR; PG8_WAIT_L(0); PG8_MMA(0, 0, At, B0); PG8_BAR; PG8_SCHED;
            PG8_LDB(B1, 1, 1); PG8_STAGE(PG8_SB(1, 0), b3, voffB);
            PG8_BAR; PG8_WAIT_L(0); PG8_MMA(0, 1, At, B1); PG8_BAR;
            PG8_LDA(At, 1, 1); PG8_STAGE(PG8_SA(1, 0), a3, voffA);
            PG8_BAR; PG8_WAIT_L(0); PG8_MMA(1, 0, At, B0); PG8_BAR; PG8_SCHED;
            PG8_STAGE(PG8_SB(1, 1), b3 + hstep, voffB);
            PG8_WAIT_V(6); PG8_BAR; PG8_MMA(1, 1, At, B1); PG8_BAR;
        }
        PG8_STAMP();
        if constexpr (F8) asm volatile("s_nop 15\n\ts_nop 15" ::: "memory");
        if constexpr (!Epi::AFTER_DRAIN) { E(acc, cur, wr, wc, fr, fq); S.done(cur); }
        PG8_STAMP();
        if (!has_next) break;
#pragma unroll
        for (int a = 0; a < 2; ++a)
#pragma unroll
            for (int b = 0; b < 2; ++b)
#pragma unroll
                for (int m = 0; m < 4; ++m)
#pragma unroll
                    for (int n = 0; n < 2; ++n) acc[a][b][m][n] = (f32x4){0.f, 0.f, 0.f, 0.f};
        cur = nxt; cA = nA; cB = nB; ++ui;
    }
    PG8_WAIT_V(0);
    if (wr == 0) PG8_BAR;
    PG8_BAR;
    if constexpr (Epi::AFTER_DRAIN) { E.fused(acc, cur, wr, wc, fr, fq, lds, wid, lane); S.done(cur); }
    PG8_STAMP();
    if (STAMP && wid == 0) { stamps[lane] = lane < nts ? (((unsigned long long)(unsigned)ts_hi << 32) | (unsigned)ts_lo) : 0ull;
        if (lane == 62) stamps[62] = rt_entry; if (lane == 63) stamps[63] = (unsigned long long)wall_clock64(); }
#undef PG8_STAMP
#undef PG8_SA
#undef PG8_SB
#undef PG8_STAGE
#undef PG8_LDA
#undef PG8_LDB
#undef PG8_MMA
#undef PG8_RD
#undef PG8_WAIT_V
#undef PG8_WAIT_L
#undef PG8_BAR
#undef PG8_SCHED
}
}

#define XB_TMO      128
#define XB_XCNT(j)  (256  + 64 * (j))
#define XB_XSUB(j)  (1280 + 64 * (j))
#define XB_XGEN(j)  (2304 + 64 * (j))
#define XB_TOP      3328
#define XB_TOPGEN   3392
#define XCD_BAR_WORDS 3456
#define XB_SPIN_CAP (1u << 21)
#define LAS __attribute__((address_space(3)))
__device__ __forceinline__ unsigned xb_ld(unsigned* p)              { return __hip_atomic_load(p, __ATOMIC_RELAXED, __HIP_MEMORY_SCOPE_AGENT); }
__device__ __forceinline__ unsigned xb_add(unsigned* p, unsigned v) { return __hip_atomic_fetch_add(p, v, __ATOMIC_RELAXED, __HIP_MEMORY_SCOPE_AGENT); }
__device__ __forceinline__ unsigned xb_xcc_id() { return (unsigned)__builtin_amdgcn_s_getreg((3 << 11) | 20) & 0xFu; }
#define XB_SPIN(cond, bar) do { unsigned _sp = 0; while (cond) { __builtin_amdgcn_s_sleep(1); \
    if ((++_sp & 255u) == 0u) { if (xb_ld(&(bar)[XB_TMO])) break; if (_sp > XB_SPIN_CAP) { atomicAdd(&(bar)[XB_TMO], 1u); break; } } } } while (0)
struct XcdBarrier { unsigned* bar; unsigned x; volatile LAS unsigned* st; };
__device__ __forceinline__ XcdBarrier xcd_barrier_post(unsigned* bar, volatile LAS unsigned* st) {
    XcdBarrier b; b.bar = bar; b.x = xb_xcc_id(); b.st = st;
    if (threadIdx.x == 0) (void)xb_add(&bar[XB_XCNT(b.x)], 1u);
    return b;
}
__device__ __forceinline__ void xcd_barrier_complete(unsigned* bar, unsigned x, unsigned& nloc, unsigned& nx) {
    const unsigned G = gridDim.x * gridDim.y * gridDim.z;
    unsigned sum, cnt, mine, sp = 0u;
    for (;;) {
        sum = 0u; cnt = 0u; mine = 0u;
#pragma unroll
        for (unsigned j = 0; j < 16; ++j) { const unsigned c = xb_ld(&bar[XB_XCNT(j)]); sum += c; cnt += (c > 0u) ? 1u : 0u; mine = (j == x) ? c : mine; }
        if (sum == G) break;
        __builtin_amdgcn_s_sleep(1);
        if ((++sp & 255u) == 0u) { if (xb_ld(&bar[XB_TMO])) break; if (sp > XB_SPIN_CAP) { atomicAdd(&bar[XB_TMO], 1u); break; } }
    }
    nloc = mine > 0u ? mine : 1u; nx = cnt > 0u ? cnt : 1u;
}
__device__ __forceinline__ void xcd_barrier(const XcdBarrier& b) {
    asm volatile("s_waitcnt vmcnt(0)" ::: "memory");
    __syncthreads();
    if (threadIdx.x == 0) {
        unsigned* bar = b.bar;
        __builtin_amdgcn_s_waitcnt(0);
        unsigned nloc = b.st[0], nx = b.st[1];
        if (nloc == 0u) { xcd_barrier_complete(bar, b.x, nloc, nx); b.st[0] = nloc; b.st[1] = nx; }
        const unsigned old = xb_add(&bar[XB_XSUB(b.x)], 1u);
        const unsigned gen = old / nloc;
        if (old + 1u == (gen + 1u) * nloc) {
            __builtin_amdgcn_fence(__ATOMIC_RELEASE, "agent");
            asm volatile("s_waitcnt vmcnt(0)" ::: "memory");
            const unsigned og = xb_add(&bar[XB_TOP], 1u);
            const unsigned tg = og / nx;
            if (og + 1u == (tg + 1u) * nx) xb_add(&bar[XB_TOPGEN], 1u);
            else XB_SPIN(xb_ld(&bar[XB_TOPGEN]) == tg, bar);
            __builtin_amdgcn_fence(__ATOMIC_ACQUIRE, "agent");
            xb_add(&bar[XB_XGEN(b.x)], 1u);
            asm volatile("s_waitcnt vmcnt(0)" ::: "memory");
        } else {
            XB_SPIN(xb_ld(&bar[XB_XGEN(b.x)]) == gen, bar);
            __builtin_amdgcn_fence(__ATOMIC_ACQUIRE, "agent");
            asm volatile("s_waitcnt vmcnt(0)" ::: "memory");
        }
    }
    __syncthreads();
}

constexpr int LDS_BYTES = 147456;
constexpr int LDS_HALF = 65536;
struct VB { int vb, nvb, vtid; unsigned char* lds; };
DI int tid_opaque() { int t = threadIdx.x; asm volatile("" : "+v"(t)); return t; }
DI VB make_vb(unsigned char* lds) { int t = threadIdx.x; asm volatile("" : "+v"(t)); VB V; V.vb = blockIdx.x * 2 + (t >> 8); V.nvb = gridDim.x * 2; V.vtid = t & 255; V.lds = lds + (t >> 8) * LDS_HALF; return V; }
DI unsigned pk_bf16(float lo, float hi) { return pg8::cvt_pk_bf16(lo, hi); }
DI unsigned pk_fp8x4(float x0, float x1, float x2, float x3, float sc) {
    x0 = __builtin_amdgcn_fmed3f(x0 * sc, -448.f, 448.f); x1 = __builtin_amdgcn_fmed3f(x1 * sc, -448.f, 448.f); x2 = __builtin_amdgcn_fmed3f(x2 * sc, -448.f, 448.f); x3 = __builtin_amdgcn_fmed3f(x3 * sc, -448.f, 448.f);
    int p = 0; p = __builtin_amdgcn_cvt_pk_fp8_f32(x0, x1, p, false); p = __builtin_amdgcn_cvt_pk_fp8_f32(x2, x3, p, true); return (unsigned)p; }
constexpr float F8_ACT = 16.f, F8_WT = 256.f, F8_O = 64.f;
constexpr int F8_SC_AW = 0x01010101 * (127 - 6), F8_SC_OW = 0x01010101 * (127 - 7);
typedef LAS unsigned char* lptr;
typedef _Float16 f16x2_t __attribute__((ext_vector_type(2)));
DI f16x2_t u2h(unsigned x) { return __builtin_bit_cast(f16x2_t, x); }
#define VB_LOOP(u, n) for (int _it = 0, u = V.vb; _it < ((n) + V.nvb - 1) / V.nvb; ++_it, u += V.nvb)

DI void p_cond(const VB& V, const float* __restrict__ c, const float* __restrict__ c_ctx, float* __restrict__ cond) {
    for (int i = V.vb * 256 + V.vtid; i < 9 * DM; i += V.nvb * 256) { const float v = i < 8 * DM ? c[i] : c_ctx[i - 8 * DM]; cond[i] = v / (1.0f + expf(-v)); }
}
template <bool F8 = false> DI void p_wt(const VB& V, const float* __restrict__ W, bf16_t* __restrict__ Wt, int K, int N, int nperm) {
    lptr tile = (lptr)V.lds;
    const int ntn = N / 64, ntk = K / 64, vt = V.vtid;
    const int lk = vt >> 4, lc = (vt & 15) * 4;
    const int sn = vt >> 2, sk = (vt & 3) * 16;
    VB_LOOP(u, ntn * ntk) {
        const bool act = u < ntn * ntk; const int n0 = (u % ntn) * 64, k0 = (u / ntn) * 64;
        if (act) { const int n = n0 + lc; const int src = n < nperm ? (n & ~127) + head_perm(n & 127) : n;
#pragma unroll
            for (int p = 0; p < 4; ++p) { const f32x4 v = *(const f32x4*)(W + (size_t)(k0 + lk + 16 * p) * N + src); *(LAS f32x4*)(tile + ((lk + 16 * p) * 68 + lc) * 4) = v; } }
        __syncthreads();
        if (act) { float e[16];
#pragma unroll
            for (int j = 0; j < 16; ++j) e[j] = *(const LAS float*)(tile + ((sk + j) * 68 + sn) * 4);
            if constexpr (F8) { u32x4 w; w.x = pk_fp8x4(e[0], e[1], e[2], e[3], F8_WT); w.y = pk_fp8x4(e[4], e[5], e[6], e[7], F8_WT); w.z = pk_fp8x4(e[8], e[9], e[10], e[11], F8_WT); w.w = pk_fp8x4(e[12], e[13], e[14], e[15], F8_WT);
                *(u32x4*)((unsigned char*)Wt + (size_t)(n0 + sn) * K + k0 + sk) = w; }
            else { u32x4 w0, w1; w0.x = pk_bf16(e[0], e[1]); w0.y = pk_bf16(e[2], e[3]); w0.z = pk_bf16(e[4], e[5]); w0.w = pk_bf16(e[6], e[7]);
                w1.x = pk_bf16(e[8], e[9]); w1.y = pk_bf16(e[10], e[11]); w1.z = pk_bf16(e[12], e[13]); w1.w = pk_bf16(e[14], e[15]);
                bf16_t* dst = Wt + (size_t)(n0 + sn) * K + k0 + sk; *(u32x4*)dst = w0; *(u32x4*)(dst + 8) = w1; } }
        __syncthreads();
    }
}
DI void p_rope(const VB& V, float2* __restrict__ rope) {
    for (int i = V.vb * 256 + V.vtid; i < 64 * 32; i += V.nvb * 256) {
        const int pos = i >> 5, f = i & 31; const float inv = powf(10000.0f, -(float)f / 32.0f); const float ang = (float)pos * inv;
        rope[i] = make_float2(cosf(ang), sinf(ang)); }
}
DI void p_hy_h3(const VB& V, const float* __restrict__ w1, const float* __restrict__ b1, const float* __restrict__ w2, const float* __restrict__ b2, float* __restrict__ h3, int L) {
    const int wv = V.vtid >> 6, j = V.vtid & 63;
    float* z = (float*)V.lds + wv * 256; float* ha = z + 64; float* hb = z + 128;
    const int nw = V.nvb * 4, w0 = V.vb * 4 + wv;
    for (int it = 0; it < (L + nw - 1) / nw; ++it) {
        const int t = it * nw + w0; const bool act = t < L;
        if (act) { if (j == 0) z[0] = (float)t / (float)L;
            if (j >= 1 && j <= 16) { const float ang = 2.0f * 3.14159265358979323846f * (float)t * (float)j / (float)L; z[j] = cosf(ang); z[16 + j] = sinf(ang); } }
        __syncthreads();
        float s = 0.f;
        if (act) { s = b1[j];
_Pragma("unroll 3") for (int k = 0; k < 33; ++k) s += z[k] * w1[k * 64 + j]; ha[j] = sinf(s); }
        __syncthreads();
        if (act) { s = b2[j];
_Pragma("unroll 4") for (int k = 0; k < 64; ++k) s += ha[k] * w2[k * 64 + j]; hb[j] = sinf(s); }
        __syncthreads();
        if (act) { s = b2[64 + j];
_Pragma("unroll 4") for (int k = 0; k < 64; ++k) s += hb[k] * w2[64 * 64 + k * 64 + j]; h3[(size_t)t * 64 + j] = sinf(s); }
        __syncthreads();
    }
}
DI const float* row_ptr(const float* h, const float* x, const float* ctx, int r) { return x ? (r < T_LAT ? x + (size_t)r * DM : ctx + (size_t)(r - T_LAT) * DM) : h + (size_t)r * DM; }
template <bool QX, bool F8 = false> DI void p_normmod(const VB& V, const float* __restrict__ h, const float* __restrict__ x0, const float* __restrict__ ctx0, const float* __restrict__ g, const float* __restrict__ adaL, int sh_off, int sc_off, bf16_t* __restrict__ a, int nrows,
                                     unsigned* __restrict__ xd = nullptr, float* __restrict__ xsc = nullptr, const unsigned short* __restrict__ dl = nullptr, const unsigned short* __restrict__ x16 = nullptr) {
    const int lane = V.vtid & 63;
    for (int r = V.vb * 4 + (V.vtid >> 6); r < nrows; r += V.nvb * 4) {
        const int bi = r < T_LAT ? r / SEQ : 8;
        const float* x = row_ptr(h, x0, ctx0, r); const float* sh = adaL + (size_t)bi * NMOD * DM + sh_off; const float* sc = adaL + (size_t)bi * NMOD * DM + sc_off;
        float4 v[8]; float ss = 0.f;
#pragma unroll
        for (int i = 0; i < 8; ++i) v[i] = make_float4(0.f, 0.f, 0.f, 0.f);
        if (x16) {
            u32x2 hw[8];
#pragma unroll
            for (int i = 0; i < 8; ++i) hw[i] = *(const u32x2*)(x16 + (size_t)r * DM + i * 256 + lane * 4);
#pragma unroll
            for (int i = 0; i < 8; ++i) { const f16x2_t h01 = u2h(hw[i].x), h23 = u2h(hw[i].y); v[i] = make_float4((float)h01.x, (float)h01.y, (float)h23.x, (float)h23.y); }
        } else {
#pragma unroll
            for (int i = 0; i < 8; ++i) v[i] = *(const float4*)(x + i * 256 + lane * 4);
        }
        if (dl) {
#pragma unroll
            for (int i = 0; i < 8; ++i) { const u32x2 dw = *(const u32x2*)(dl + (size_t)r * DM + i * 256 + lane * 4); const f16x2_t d01 = u2h(dw.x), d23 = u2h(dw.y);
                v[i].x += (float)d01.x; v[i].y += (float)d01.y; v[i].z += (float)d23.x; v[i].w += (float)d23.y; } }
#pragma unroll
        for (int i = 0; i < 8; ++i) ss += v[i].x * v[i].x + v[i].y * v[i].y + v[i].z * v[i].z + v[i].w * v[i].w;
        ss = wave_sum(ss); const float inv = rsqrtf(ss / (float)DM + 1e-6f);
        float amax = 0.f;
#pragma unroll
        for (int i = 0; i < 8; ++i) { const int c = i * 256 + lane * 4; const float4 gg = *(const float4*)(g + c), s1 = *(const float4*)(sc + c), s0 = *(const float4*)(sh + c);
            v[i].x = v[i].x * inv * gg.x * (1.f + s1.x) + s0.x; v[i].y = v[i].y * inv * gg.y * (1.f + s1.y) + s0.y; v[i].z = v[i].z * inv * gg.z * (1.f + s1.z) + s0.z; v[i].w = v[i].w * inv * gg.w * (1.f + s1.w) + s0.w;
            if constexpr (F8) *(unsigned*)((unsigned char*)a + (size_t)r * DM + c) = pk_fp8x4(v[i].x, v[i].y, v[i].z, v[i].w, F8_ACT);
            else { u32x2 o; o.x = f2bf(v[i].x) | ((unsigned)f2bf(v[i].y) << 16); o.y = f2bf(v[i].z) | ((unsigned)f2bf(v[i].w) << 16);
                *(u32x2*)(a + (size_t)r * DM + c) = o; }
            if constexpr (QX) amax = fmaxf(amax, fmaxf(fmaxf(fabsf(v[i].x), fabsf(v[i].y)), fmaxf(fabsf(v[i].z), fabsf(v[i].w)))); }
        if constexpr (QX) {
            amax = wave_max(amax); const float qs = amax > 0.f ? 119.0f / amax : 0.f;
            if (lane == 0) xsc[r] = amax * (1.0f / 119.0f);
#pragma unroll
            for (int i = 0; i < 8; ++i) { const int q0 = (int)rintf(v[i].x * qs), q1 = (int)rintf(v[i].y * qs), q2 = (int)rintf(v[i].z * qs), q3 = (int)rintf(v[i].w * qs);
                const unsigned hi = (unsigned)(((q0 + 8) >> 4) & 15) | ((unsigned)(((q1 + 8) >> 4) & 15) << 4) | ((unsigned)(((q2 + 8) >> 4) & 15) << 8) | ((unsigned)(((q3 + 8) >> 4) & 15) << 12);
                const unsigned lo = (unsigned)(q0 & 15) | ((unsigned)(q1 & 15) << 4) | ((unsigned)(q2 & 15) << 8) | ((unsigned)(q3 & 15) << 12);
                xd[(size_t)r * 512 + 64 * i + lane] = hi | (lo << 16); }
        }
    }
}
DI void p_final(const VB& V, const unsigned short* __restrict__ h16, const float* __restrict__ g, float* __restrict__ out) {
    const int lane = V.vtid & 63;
    for (int r = V.vb * 4 + (V.vtid >> 6); r < T_LAT; r += V.nvb * 4) {
        u32x2 hw[8]; float4 v[8]; float ss = 0.f;
#pragma unroll
        for (int i = 0; i < 8; ++i) hw[i] = *(const u32x2*)(h16 + (size_t)r * DM + i * 256 + lane * 4);
#pragma unroll
        for (int i = 0; i < 8; ++i) { const f16x2_t h01 = u2h(hw[i].x), h23 = u2h(hw[i].y); v[i] = make_float4((float)h01.x, (float)h01.y, (float)h23.x, (float)h23.y); ss += v[i].x * v[i].x + v[i].y * v[i].y + v[i].z * v[i].z + v[i].w * v[i].w; }
        ss = wave_sum(ss); const float inv = rsqrtf(ss / (float)DM + 1e-6f);
#pragma unroll
        for (int i = 0; i < 8; ++i) { const int c = i * 256 + lane * 4; const float4 gg = *(const float4*)(g + c);
            *(float4*)(out + (size_t)r * DM + c) = make_float4(v[i].x * inv * gg.x, v[i].y * inv * gg.y, v[i].z * inv * gg.z, v[i].w * inv * gg.w); }
    }
}

struct EpiQK {
    static constexpr bool PERM = false, AFTER_DRAIN = false;
    bf16_t* Q; bf16_t* Kb; const float2* rope;
    DI void operator()(const pg8::f32x4 (&acc)[2][2][4][2], const pg8::Unit& u, int wr, int wc, int fr, int fq) const {
        const int f0 = (wc & 1) * 16 + 4 * fq;
#pragma unroll
        for (int ai = 0; ai < 2; ++ai)
#pragma unroll
            for (int m = 0; m < 4; ++m) {
                const int row = u.pm * 256 + ai * 128 + wr * 64 + m * 16 + fr;
                const int t = row & (SEQ - 1); const int pos = (wc >> 1) ? (t & 63) : (t >> 6);
                float4 c01 = make_float4(1.f, 0.f, 1.f, 0.f), c23 = c01;
                if (row < T_LAT) { const float4* rp = (const float4*)(rope + pos * 32 + f0); c01 = rp[0]; c23 = rp[1]; }
#pragma unroll
                for (int bj = 0; bj < 2; ++bj) {
                    const pg8::f32x4 v0 = acc[ai][bj][m][0], v1 = acc[ai][bj][m][1];
                    const float a0 = v0[0] * c01.x - v1[0] * c01.y, b0 = v1[0] * c01.x + v0[0] * c01.y;
                    const float a1 = v0[1] * c01.z - v1[1] * c01.w, b1 = v1[1] * c01.z + v0[1] * c01.w;
                    const float a2 = v0[2] * c23.x - v1[2] * c23.y, b2 = v1[2] * c23.x + v0[2] * c23.y;
                    const float a3 = v0[3] * c23.z - v1[3] * c23.w, b3 = v1[3] * c23.z + v0[3] * c23.w;
                    const int colh = u.pn * 256 + bj * 128, c0 = colh + 32 * wc + 4 * fq;
                    bf16_t* dst = colh < 2048 ? Q + (size_t)row * DM + c0 : Kb + (size_t)row * 512 + (c0 - 2048);
                    u32x2 lo, hi; lo.x = pk_bf16(a0, a1); lo.y = pk_bf16(a2, a3); hi.x = pk_bf16(b0, b1); hi.y = pk_bf16(b2, b3);
                    *(u32x2*)dst = lo; *(u32x2*)(dst + 16) = hi;
                }
                asm volatile("" ::: "memory");
            }
    }
};
struct EpiResid {
    static constexpr bool PERM = false, AFTER_DRAIN = false;
    const float* h; const float* x0; const float* ctx0; float* hout; const float* adaL; int g_off;
    DI void operator()(const pg8::f32x4 (&acc)[2][2][4][2], const pg8::Unit& u, int wr, int wc, int fr, int fq) const {
#pragma unroll
        for (int ai = 0; ai < 2; ++ai)
#pragma unroll
            for (int m = 0; m < 4; ++m) {
                const int row = u.pm * 256 + ai * 128 + wr * 64 + m * 16 + fr; const int bi = row < T_LAT ? row >> 11 : 8;
                const float* base = row_ptr(h, x0, ctx0, row); const float* g = adaL + (size_t)bi * NMOD * DM + g_off; float* op = hout + (size_t)row * DM;
#pragma unroll
                for (int bj = 0; bj < 2; ++bj)
#pragma unroll
                    for (int n = 0; n < 2; ++n) { const int col = u.pn * 256 + bj * 128 + wc * 32 + n * 16 + 4 * fq;
                        const pg8::f32x4 b = *(const pg8::f32x4*)(base + col), gg = *(const pg8::f32x4*)(g + col);
                        *(pg8::f32x4*)(op + col) = b + gg * acc[ai][bj][m][n]; }
                asm volatile("" ::: "memory");
            }
    }
};
DI unsigned pk_f16(float lo, float hi) { return __builtin_bit_cast(unsigned, (f16x2_t){(_Float16)lo, (_Float16)hi}); }
struct EpiDelta {
    static constexpr bool PERM = true, AFTER_DRAIN = false;
    unsigned short* D; const float* adaL; int g_off;
    DI void operator()(const pg8::f32x4 (&acc)[2][2][4][2], const pg8::Unit& u, int wr, int wc, int fr, int fq) const {
        const int row0 = u.pm * 256 + wr * 64 + fr, col0 = u.pn * 256 + wc * 32 + 8 * fq; const int bi = u.pm * 256 < T_LAT ? (u.pm * 256) >> 11 : 8;
        const float* gp = adaL + (size_t)bi * NMOD * DM + g_off + col0;
        pg8::f32x4 g0[2], g1[2];
#pragma unroll
        for (int bj = 0; bj < 2; ++bj) { g0[bj] = *(const pg8::f32x4*)(gp + bj * 128); g1[bj] = *(const pg8::f32x4*)(gp + bj * 128 + 4); }
#pragma unroll
        for (int ai = 0; ai < 2; ++ai)
#pragma unroll
            for (int m = 0; m < 4; ++m) { unsigned short* rowp = D + (size_t)(row0 + ai * 128 + m * 16) * DM + col0;
#pragma unroll
                for (int bj = 0; bj < 2; ++bj) { const pg8::f32x4 v0 = acc[ai][bj][m][0] * g0[bj], v1 = acc[ai][bj][m][1] * g1[bj];
                    u32x4 w; w.x = pk_f16(v0[0], v0[1]); w.y = pk_f16(v0[2], v0[3]); w.z = pk_f16(v1[0], v1[1]); w.w = pk_f16(v1[2], v1[3]);
                    *(u32x4*)(rowp + bj * 128) = w; } }
    }
};
struct EpiResidP {
    static constexpr bool PERM = true, AFTER_DRAIN = false;
    float* H; const float* adaL; int g_off;
    DI void operator()(const pg8::f32x4 (&acc)[2][2][4][2], const pg8::Unit& u, int wr, int wc, int fr, int fq) const {
        const int row0 = u.pm * 256 + wr * 64 + fr, col0 = u.pn * 256 + wc * 32 + 8 * fq; const int bi = u.pm * 256 < T_LAT ? (u.pm * 256) >> 11 : 8;
        const float* gp = adaL + (size_t)bi * NMOD * DM + g_off + col0;
        pg8::f32x4 g0[2], g1[2];
#pragma unroll
        for (int bj = 0; bj < 2; ++bj) { g0[bj] = *(const pg8::f32x4*)(gp + bj * 128); g1[bj] = *(const pg8::f32x4*)(gp + bj * 128 + 4); }
#pragma unroll
        for (int ai = 0; ai < 2; ++ai)
#pragma unroll
            for (int m = 0; m < 4; ++m) { float* rowp = H + (size_t)(row0 + ai * 128 + m * 16) * DM + col0;
#pragma unroll
                for (int bj = 0; bj < 2; ++bj) { const pg8::f32x4 b0 = *(const pg8::f32x4*)(rowp + bj * 128), b1 = *(const pg8::f32x4*)(rowp + bj * 128 + 4);
                    *(pg8::f32x4*)(rowp + bj * 128) = b0 + acc[ai][bj][m][0] * g0[bj]; *(pg8::f32x4*)(rowp + bj * 128 + 4) = b1 + acc[ai][bj][m][1] * g1[bj]; }
                asm volatile("" ::: "memory"); }
    }
};
struct EpiBfP {
    static constexpr bool PERM = true, AFTER_DRAIN = false;
    bf16_t* O; int ldc;
    DI void operator()(const pg8::f32x4 (&acc)[2][2][4][2], const pg8::Unit& u, int wr, int wc, int fr, int fq) const {
        const int row0 = u.pm * 256 + wr * 64 + fr, col0 = u.pn * 256 + wc * 32 + 8 * fq;
#pragma unroll
        for (int ai = 0; ai < 2; ++ai)
#pragma unroll
            for (int m = 0; m < 4; ++m) { bf16_t* rowp = O + (size_t)(row0 + ai * 128 + m * 16) * ldc + col0;
#pragma unroll
                for (int bj = 0; bj < 2; ++bj) { const pg8::f32x4 v0 = acc[ai][bj][m][0], v1 = acc[ai][bj][m][1];
                    u32x4 w; w.x = pk_bf16(v0[0], v0[1]); w.y = pk_bf16(v0[2], v0[3]); w.z = pk_bf16(v1[0], v1[1]); w.w = pk_bf16(v1[2], v1[3]);
                    *(u32x4*)(rowp + bj * 128) = w; } }
    }
};
template <class Epi> DI void p_gemm(unsigned char* lds, const bf16_t* A, const bf16_t* Bt, int M, int N, int K, int c, const Epi& E) {
    pg8::Gemm g{A, Bt, M, N, K, 0}; pg8::StaticOrder S; S.init(M, N, (int)gridDim.x, c);
    pg8::gemm_phase<Epi, pg8::StaticOrder, false>((PG8_LAS unsigned char*)lds, g, S, E, nullptr);
}
template <class Epi> DI void p_gemm8(unsigned char* lds, const void* A, const void* Bt, int M, int N, int K, int c, const Epi& E, int sc) {
    pg8::Gemm g{(const bf16_t*)A, (const bf16_t*)Bt, M, N, K / 2, sc}; pg8::StaticOrder S; S.init(M, N, (int)gridDim.x, c);
    pg8::gemm_phase<Epi, pg8::StaticOrder, false, true>((PG8_LAS unsigned char*)lds, g, S, E, nullptr);
}

DI float gelu_erf(float s) { return 0.5f * s * (1.0f + erff(s * 0.70710678118654752f)); }
DI void p_ada2(unsigned char* lds_, const float* __restrict__ cond, const float* __restrict__ ada_w, const float* __restrict__ ada_b, float* __restrict__ ada) {
    lptr lds = (lptr)lds_; LAS float* cs = (LAS float*)lds; LAS float* part = (LAS float*)(lds + 9 * DM * 4);
    const int tid = tid_opaque(), w = tid >> 6, lane = tid & 63, kq = lane >> 4, cq = lane & 15;
    for (int e = tid; e < 9 * DM; e += 512) cs[e] = cond[e];
    __syncthreads();
    constexpr int NUN = 4 * NMOD * DM / 64;
    for (int u = blockIdx.x; u < NUN; u += gridDim.x) {
        const int i = u / (NMOD * DM / 64), n0 = (u % (NMOD * DM / 64)) * 64;
        const float* wp = ada_w + ((size_t)i * DM + w * 256 + kq) * (NMOD * DM) + n0 + cq * 4;
        float acc[9][4];
#pragma unroll
        for (int b = 0; b < 9; ++b) { acc[b][0] = 0.f; acc[b][1] = 0.f; acc[b][2] = 0.f; acc[b][3] = 0.f; }
        for (int kk = 0; kk < 64; kk += 8) {
            float4 wv[8];
#pragma unroll
            for (int j = 0; j < 8; ++j) wv[j] = *(const float4*)(wp + (size_t)(kk + j) * 4 * (NMOD * DM));
#pragma unroll
            for (int j = 0; j < 8; ++j) { const int k = w * 256 + (kk + j) * 4 + kq;
#pragma unroll
                for (int b = 0; b < 9; ++b) { const float c = cs[b * DM + k]; acc[b][0] += c * wv[j].x; acc[b][1] += c * wv[j].y; acc[b][2] += c * wv[j].z; acc[b][3] += c * wv[j].w; } }
        }
#pragma unroll
        for (int b = 0; b < 9; ++b)
#pragma unroll
            for (int q = 0; q < 4; ++q) { float v = acc[b][q]; v += __shfl_xor(v, 16); v += __shfl_xor(v, 32); acc[b][q] = v; }
        if (kq == 0) {
#pragma unroll
            for (int b = 0; b < 9; ++b) *(LAS f32x4*)(part + (w * 9 + b) * 64 + cq * 4) = (f32x4){acc[b][0], acc[b][1], acc[b][2], acc[b][3]};
        }
        __syncthreads();
        for (int e = tid; e < 9 * 64; e += 512) { const int b = e >> 6, c = e & 63; float sum = ada_b[i * NMOD * DM + n0 + c];
#pragma unroll
            for (int ww = 0; ww < 8; ++ww) sum += part[(ww * 9 + b) * 64 + c];
            ada[((size_t)i * 9 + b) * NMOD * DM + n0 + c] = sum; }
        __syncthreads();
    }
}
typedef float f32x16 __attribute__((ext_vector_type(16)));
template <int L> DI void p_hy_filt3(const float* __restrict__ h3, const float* __restrict__ w3, const float* __restrict__ decay, const float* __restrict__ fbias, bf16_t* __restrict__ G) {
    const int tid = tid_opaque(), lane = tid & 63, n = lane & 31, hh = lane >> 5;
    constexpr int NTT = L / 32, TPW = NTT >= 8 ? 8 : NTT, NPART = NTT / TPW, NWU = 256 * NPART;
    const float invL = 1.0f / (float)L;
    for (int wu = blockIdx.x * 8 + (tid >> 6); wu < NWU; wu += gridDim.x * 8) {
        const int part = wu >> 8, combo = wu & 255, dtile = combo & 63, od = combo >> 6, o = od >> 1, dir = od & 1;
        const int d = 32 * dtile + n, col = o * 2 * DM + dir * DM + d;
        bf16x8 bfr[4];
#pragma unroll
        for (int s = 0; s < 4; ++s) { float wv[8];
#pragma unroll
            for (int i = 0; i < 8; ++i) wv[i] = w3[(size_t)(16 * s + 8 * hh + i) * 4 * DM + col];
            u32x4 bv; bv.x = pk_bf16(wv[0], wv[1]); bv.y = pk_bf16(wv[2], wv[3]); bv.z = pk_bf16(wv[4], wv[5]); bv.w = pk_bf16(wv[6], wv[7]); bfr[s] = __builtin_bit_cast(bf16x8, bv); }
        const float dec = fabsf(decay[o * DM + d]) * invL, fb = fbias[o * DM + d];
        bf16_t* gp = G + ((size_t)o * DM + d) * (2 * L);
        if (dir == 0 && part == NPART - 1 && hh == 0) gp[0] = 0;
#pragma unroll 2
        for (int tt = 0; tt < TPW; ++tt) {
            const int t0 = 32 * (part * TPW + tt);
            f32x16 acc;
#pragma unroll
            for (int r = 0; r < 16; ++r) acc[r] = 0.f;
#pragma unroll
            for (int s = 0; s < 4; ++s) { const float* ap = h3 + (size_t)(t0 + n) * 64 + 16 * s + 8 * hh; const f32x4 a0 = *(const f32x4*)ap, a1 = *(const f32x4*)(ap + 4);
                u32x4 av; av.x = pk_bf16(a0[0], a0[1]); av.y = pk_bf16(a0[2], a0[3]); av.z = pk_bf16(a1[0], a1[1]); av.w = pk_bf16(a1[2], a1[3]);
                acc = __builtin_amdgcn_mfma_f32_32x32x16_bf16(__builtin_bit_cast(bf16x8, av), bfr[s], acc, 0, 0, 0); }
#pragma unroll
            for (int q = 0; q < 4; ++q) { const int tq = t0 + 8 * q + 4 * hh; float v[4];
#pragma unroll
                for (int i = 0; i < 4; ++i) { v[i] = acc[4 * q + i] * (__expf(-(float)(tq + i) * dec) + 0.05f); if (dir == 0 && tq + i == 0) v[i] += fb; }
                if (dir == 0) {
#pragma unroll
                    for (int i = 0; i < 4; ++i) gp[L - tq - i] = f2bf(v[i]);
                } else if (tq == 0) {
#pragma unroll
                    for (int i = 1; i < 4; ++i) gp[L + i] = f2bf(v[i]);
                } else { u32x2 w; w.x = pk_bf16(v[0], v[1]); w.y = pk_bf16(v[2], v[3]); *(u32x2*)(gp + L + tq) = w; }
            }
        }
    }
}

constexpr int HY_CS = 8224;
constexpr int HY_ZPAD = 512;
constexpr int HY_ZS = 3080;
constexpr int HY_XS = 2056;
constexpr int HY_F_OFF = 0, HY_Z_OFF = 4 * HY_CS, HY_X_OFF = HY_Z_OFF + 8 * HY_ZS * 2, HY_END = HY_X_OFF + 8 * HY_XS * 2;
static_assert(HY_END <= 2 * LDS_HALF, "hyena LDS");
template <int L> struct HyFilt { u32x4 lo[(2 * L / 8 + 2 + 511) / 512], hi[(2 * L / 8 + 2 + 511) / 512]; };
template <int L> DI void hy_issue_filter(HyFilt<L>& R, const bf16_t* __restrict__ g, int tid) {
#pragma unroll
    for (int it = 0; it < (2 * L / 8 + 2 + 511) / 512; ++it) { const int idx = tid + 512 * it, z0 = (idx - 1) * 8;
        R.lo[it] = (u32x4){0u, 0u, 0u, 0u}; R.hi[it] = (u32x4){0u, 0u, 0u, 0u};
        if (idx < 2 * L / 8 + 2) { if (z0 >= 0 && z0 < 2 * L) R.lo[it] = *(const u32x4*)(g + z0); if (z0 + 8 >= 0 && z0 + 8 < 2 * L) R.hi[it] = *(const u32x4*)(g + z0 + 8); } }
}
template <int L> DI void hy_commit_filter(const HyFilt<L>& R, lptr F, int tid) {
#pragma unroll
    for (int it = 0; it < (2 * L / 8 + 2 + 511) / 512; ++it) { const int idx = tid + 512 * it, z0 = (idx - 1) * 8;
        if (idx < 2 * L / 8 + 2) {
            const u32x4 lo = R.lo[it], hi = R.hi[it]; u32x4 c1, c2, c3;
            c1.x = __builtin_amdgcn_alignbit(lo.y, lo.x, 16); c1.y = __builtin_amdgcn_alignbit(lo.z, lo.y, 16); c1.z = __builtin_amdgcn_alignbit(lo.w, lo.z, 16); c1.w = __builtin_amdgcn_alignbit(hi.x, lo.w, 16);
            c2.x = lo.y; c2.y = lo.z; c2.z = lo.w; c2.w = hi.x;
            c3.x = __builtin_amdgcn_alignbit(lo.z, lo.y, 16); c3.y = __builtin_amdgcn_alignbit(lo.w, lo.z, 16); c3.z = __builtin_amdgcn_alignbit(hi.x, lo.w, 16); c3.w = __builtin_amdgcn_alignbit(hi.y, hi.x, 16);
            const int off = (z0 + 8) * 2;
            *(LAS u32x4*)(F + off) = lo; *(LAS u32x4*)(F + HY_CS + off) = c1; *(LAS u32x4*)(F + 2 * HY_CS + off) = c2; *(LAS u32x4*)(F + 3 * HY_CS + off) = c3; } }
}
template <int L> struct HyPart { u32x4 raw[(L + 511) / 512]; unsigned short pv[(L + 511) / 512], nx[(L + 511) / 512]; };
template <int L> DI void hy_issue_part(HyPart<L>& R, const bf16_t* __restrict__ urow, int tid) {
#pragma unroll
    for (int it = 0; it < (L + 511) / 512; ++it) { const int e8 = tid + 512 * it, e = e8 * 8, t0 = e % L;
        R.raw[it] = (u32x4){0u, 0u, 0u, 0u}; R.pv[it] = 0; R.nx[it] = 0;
        if (e8 < L) { R.raw[it] = *(const u32x4*)(urow + e); if (t0 > 0) R.pv[it] = urow[e - 1]; if (t0 + 8 < L) R.nx[it] = urow[e + 8]; } }
}
template <int L> DI void hy_commit_part(const HyPart<L>& R, float w0, float w1, float w2, float bb, lptr dst, int dstride, int doff, int tid) {
#pragma unroll
    for (int it = 0; it < (L + 511) / 512; ++it) { const int e8 = tid + 512 * it, e = e8 * 8, b = e / L, t0 = e % L;
        if (e8 < L) {
            const u32x4 raw = R.raw[it]; float x[10];
            x[0] = bf2f(R.pv[it]); x[9] = bf2f(R.nx[it]);
            x[1] = __uint_as_float(raw.x << 16); x[2] = __uint_as_float(raw.x & 0xffff0000u); x[3] = __uint_as_float(raw.y << 16); x[4] = __uint_as_float(raw.y & 0xffff0000u);
            x[5] = __uint_as_float(raw.z << 16); x[6] = __uint_as_float(raw.z & 0xffff0000u); x[7] = __uint_as_float(raw.w << 16); x[8] = __uint_as_float(raw.w & 0xffff0000u);
            float o[8];
#pragma unroll
            for (int j = 0; j < 8; ++j) o[j] = bb + w0 * x[j] + w1 * x[j + 1] + w2 * x[j + 2];
            u32x4 w; w.x = pk_bf16(o[0], o[1]); w.y = pk_bf16(o[2], o[3]); w.z = pk_bf16(o[4], o[5]); w.w = pk_bf16(o[6], o[7]);
            *(LAS u32x4*)(dst + (size_t)(b * dstride + doff + t0) * 2) = w; } }
}
template <int L, int NT, int NSTEP> DI void hy_conv_loop(f32x16 (&acc)[NT], lptr F, lptr Z, int T0w, int lane) {
    static_assert(NSTEP % 2 == 0 && NSTEP >= 4, "step count");
    const int i = lane & 31, h = lane >> 5, r = (4 - (i & 3)) & 3, col = lane & 31, b = col >> 2, di = col & 3;
    const int lb_lo = T0w - (L - 16);
    lptr ap = F + r * HY_CS + (L - lb_lo + 8 * h - i - r + 8) * 2;
    lptr bp = Z + (b * HY_ZS + HY_ZPAD + T0w + 32 * di - lb_lo + 8 * h) * 2;
    u32x2 a0[2], a1[2]; bf16x8 bq[2][NT];
#define HY_LOADF(s_) do { a0[s_] = *(const volatile LAS u32x2*)ap; a1[s_] = *(const volatile LAS u32x2*)(ap + 8); _Pragma("unroll") for (int m = 0; m < NT; ++m) bq[s_][m] = *(const LAS bf16x8*)(bp + m * 256); ap -= 32; bp -= 32; } while (0)
#define HY_MMA(s_, MASK) do { u32x4 av; av.x = a0[s_].x; av.y = a0[s_].y; av.z = a1[s_].x; av.w = a1[s_].y; const bf16x8 af = __builtin_bit_cast(bf16x8, av); \
        _Pragma("unroll") for (int m = 0; m < NT; ++m) if (((MASK) >> m) & 1) acc[m] = __builtin_amdgcn_mfma_f32_32x32x16_bf16(af, bq[s_][m], acc[m], 0, 0, 0); } while (0)
#define HY_REGION(N_, MASK) do { _Pragma("unroll 1") for (int st = 0; st < (N_); st += 2) { HY_LOADF(1); __builtin_amdgcn_sched_barrier(0); HY_MMA(0, MASK); __builtin_amdgcn_sched_barrier(0); \
        HY_LOADF(0); __builtin_amdgcn_sched_barrier(0); HY_MMA(1, MASK); __builtin_amdgcn_sched_barrier(0); } } while (0)
    HY_LOADF(0);
    if constexpr (NT == 4) {
        constexpr int FULL = NSTEP - 8 * 3 - 8 * 3;
        HY_REGION(8, 0x1); HY_REGION(8, 0x3); HY_REGION(8, 0x7); HY_REGION(FULL, 0xF); HY_REGION(8, 0xE); HY_REGION(8, 0xC); HY_REGION(6, 0x8);
        HY_LOADF(1); __builtin_amdgcn_sched_barrier(0); HY_MMA(0, 0x8); HY_MMA(1, 0x8);
    } else {
        HY_REGION(NSTEP - 2, (1 << NT) - 1);
        HY_LOADF(1); __builtin_amdgcn_sched_barrier(0); HY_MMA(0, (1 << NT) - 1); HY_MMA(1, (1 << NT) - 1);
    }
#undef HY_LOADF
#undef HY_MMA
#undef HY_REGION
}
template <int L> DI void p_hyena_unit(unsigned char* lds_, const bf16_t* __restrict__ Ut, const float* __restrict__ cw, const float* __restrict__ cb, const bf16_t* __restrict__ G, bf16_t* __restrict__ Yt, int d, int tok0) {
    constexpr int NT = L >= 2048 ? 4 : 1;
    constexpr int NSTEP = (L - 16 + 96 + 128 * (NT - 1)) / 16 + 1;
    lptr lds = (lptr)lds_; lptr F = lds + HY_F_OFF; lptr Z = lds + HY_Z_OFF; lptr X = lds + HY_X_OFF;
    const int tid = tid_opaque(), wave = tid >> 6, lane = tid & 63;
    const int T0w = wave * NT * 128; const bool active = T0w < L;
    const int col = lane & 31, hh = lane >> 5, b = col >> 2, di = col & 3;
    const bf16_t* u0 = Ut + (size_t)d * T_ALL + tok0; const bf16_t* u1 = Ut + (size_t)(DM + d) * T_ALL + tok0; const bf16_t* u2 = Ut + (size_t)(2 * DM + d) * T_ALL + tok0;
    {
        HyFilt<L> f0; HyPart<L> pv, px1;
        hy_issue_filter<L>(f0, G + (size_t)d * (2 * L), tid); hy_issue_part<L>(pv, u0, tid); hy_issue_part<L>(px1, u1, tid);
        hy_commit_filter<L>(f0, F, tid);
        hy_commit_part<L>(pv, cw[d], cw[3 * DM + d], cw[6 * DM + d], cb[d], Z, HY_ZS, HY_ZPAD, tid);
        hy_commit_part<L>(px1, cw[DM + d], cw[4 * DM + d], cw[7 * DM + d], cb[DM + d], X, HY_XS, 0, tid);
    }
    if (L < 2048) { for (int e = tid; e < 8 * 32; e += 512) *(LAS u32x4*)(Z + ((e >> 5) * HY_ZS + HY_ZPAD + L + (e & 31) * 8) * 2) = (u32x4){0u, 0u, 0u, 0u}; }
    HyFilt<L> f1; HyPart<L> px2;
    hy_issue_filter<L>(f1, G + ((size_t)DM + d) * (2 * L), tid); hy_issue_part<L>(px2, u2, tid);
    __syncthreads();
    f32x16 acc[NT];
#pragma unroll
    for (int m = 0; m < NT; ++m)
#pragma unroll
        for (int q = 0; q < 16; ++q) acc[m][q] = 0.f;
    if (active) hy_conv_loop<L, NT, NSTEP>(acc, F, Z, T0w, lane);
    __syncthreads();
    if (active) {
#pragma unroll
        for (int m = 0; m < NT; ++m)
#pragma unroll
            for (int g = 0; g < 4; ++g) { const int t4 = T0w + 128 * m + 32 * di + 8 * g + 4 * hh;
                const u32x2 xv = *(const LAS u32x2*)(X + (b * HY_XS + t4) * 2);
                const float z0 = __uint_as_float(xv.x << 16) * acc[m][4 * g + 0], z1 = __uint_as_float(xv.x & 0xffff0000u) * acc[m][4 * g + 1];
                const float z2 = __uint_as_float(xv.y << 16) * acc[m][4 * g + 2], z3 = __uint_as_float(xv.y & 0xffff0000u) * acc[m][4 * g + 3];
                u32x2 zw; zw.x = pk_bf16(z0, z1); zw.y = pk_bf16(z2, z3);
                *(LAS u32x2*)(Z + (b * HY_ZS + HY_ZPAD + t4) * 2) = zw; }
    }
    hy_commit_filter<L>(f1, F, tid);
    __syncthreads();
    hy_commit_part<L>(px2, cw[2 * DM + d], cw[5 * DM + d], cw[8 * DM + d], cb[2 * DM + d], X, HY_XS, 0, tid);
    __syncthreads();
#pragma unroll
    for (int m = 0; m < NT; ++m)
#pragma unroll
        for (int q = 0; q < 16; ++q) acc[m][q] = 0.f;
    if (active) hy_conv_loop<L, NT, NSTEP>(acc, F, Z, T0w, lane);
    if (active) {
#pragma unroll
        for (int m = 0; m < NT; ++m)
#pragma unroll
            for (int g = 0; g < 4; ++g) { const int t4 = T0w + 128 * m + 32 * di + 8 * g + 4 * hh;
                lptr xp = X + (b * HY_XS + t4) * 2; const u32x2 xv = *(const LAS u32x2*)xp;
                const float y0 = __uint_as_float(xv.x << 16) * acc[m][4 * g + 0], y1 = __uint_as_float(xv.x & 0xffff0000u) * acc[m][4 * g + 1];
                const float y2 = __uint_as_float(xv.y << 16) * acc[m][4 * g + 2], y3 = __uint_as_float(xv.y & 0xffff0000u) * acc[m][4 * g + 3];
                u32x2 yw; yw.x = pk_bf16(y0, y1); yw.y = pk_bf16(y2, y3);
                *(LAS u32x2*)xp = yw; }
    }
    __syncthreads();
    for (int e8 = tid; e8 < L; e8 += 512) { const int e = e8 * 8, bb = e / L, t0 = e % L; *(u32x4*)(Yt + (size_t)d * T_ALL + tok0 + e) = *(const LAS u32x4*)(X + (bb * HY_XS + t0) * 2); }
    __syncthreads();
}
template <bool WITH_CTX> DI void p_hyena(unsigned char* lds, const bf16_t* __restrict__ Ut, const float* __restrict__ cw, const float* __restrict__ cb, const bf16_t* __restrict__ G, const bf16_t* __restrict__ Gc, bf16_t* __restrict__ Yt) {
    for (int e = tid_opaque(); e < 8 * HY_ZS / 8; e += 512) *(LAS u32x4*)((lptr)lds + HY_Z_OFF + e * 16) = (u32x4){0u, 0u, 0u, 0u};
    __syncthreads();
    for (int d = blockIdx.x; d < DM; d += gridDim.x) {
        p_hyena_unit<SEQ>(lds, Ut, cw, cb, G, Yt, d, 0);
        if constexpr (WITH_CTX) p_hyena_unit<CTX>(lds, Ut, cw, cb, Gc, Yt, d, T_LAT);
    }
}
DI void p_transpose_yt(unsigned char* lds_, const bf16_t* __restrict__ Yt, bf16_t* __restrict__ Y, int nrows) {
    const int t = tid_opaque(), half = t >> 8, tt = t & 255; lptr tile = (lptr)lds_ + half * (64 * 66 * 2);
    const int ntok = nrows / 64, nun = ntok * (DM / 64), nvb = gridDim.x * 2;
    for (int it = 0, u = blockIdx.x * 2 + half; it < (nun + nvb - 1) / nvb; ++it, u += nvb) {
        const bool act = u < nun; const int tk0 = (u % ntok) * 64, d0 = (u / ntok) * 64;
        if (act) { for (int k = tt; k < 64 * 8; k += 256) { const int dr = k >> 3, c8 = (k & 7) * 8; const u32x4 v = *(const u32x4*)(Yt + (size_t)(d0 + dr) * T_ALL + tk0 + c8);
                LAS unsigned* p = (LAS unsigned*)(tile + (dr * 66 + c8) * 2); p[0] = v.x; p[1] = v.y; p[2] = v.z; p[3] = v.w; } }
        __syncthreads();
        if (act) { for (int k = tt; k < 64 * 8; k += 256) { const int tr = k >> 3, d8 = (k & 7) * 8; unsigned short e[8];
#pragma unroll
                for (int j = 0; j < 8; ++j) e[j] = *(const LAS unsigned short*)(tile + ((d8 + j) * 66 + tr) * 2);
                u32x4 w; w.x = e[0] | ((unsigned)e[1] << 16); w.y = e[2] | ((unsigned)e[3] << 16); w.z = e[4] | ((unsigned)e[5] << 16); w.w = e[6] | ((unsigned)e[7] << 16);
                *(u32x4*)(Y + (size_t)(tk0 + tr) * DM + d0 + d8) = w; } }
        __syncthreads();
    }
}


constexpr int AT_KS = 288, AT_VS = 272;
constexpr int AT_K_OFF = 0, AT_V_OFF = 128 * AT_KS, AT_END = AT_V_OFF + 128 * AT_VS;
static_assert(AT_END <= 2 * LDS_HALF, "attention LDS");
DI void at_prefetch(u32x4 (&kr)[4], u32x4 (&vr)[4], const bf16_t* __restrict__ Kb, const bf16_t* __restrict__ Vt, int kvh, int krow0, int tid) {
#pragma unroll
    for (int i = 0; i < 4; ++i) { const int c = tid + 512 * i, row = c >> 4, part = c & 15;
        kr[i] = *(const u32x4*)(Kb + (size_t)(krow0 + row) * 512 + kvh * 128 + part * 8);
        vr[i] = *(const u32x4*)(Vt + (size_t)(kvh * 128 + row) * T_ALL + krow0 + part * 8); }
}
DI void at_commit(const u32x4 (&kr)[4], const u32x4 (&vr)[4], lptr lds, int tid) {
#pragma unroll
    for (int i = 0; i < 4; ++i) { const int c = tid + 512 * i, row = c >> 4, part = c & 15;
        *(LAS u32x4*)(lds + AT_K_OFF + row * AT_KS + part * 16) = kr[i];
        *(LAS u32x4*)(lds + AT_V_OFF + row * AT_VS + part * 16) = vr[i]; }
}
DI void p_attn(unsigned char* lds_, const bf16_t* __restrict__ Q, const bf16_t* __restrict__ Kb, const bf16_t* __restrict__ Vt, const float* __restrict__ sink, bf16_t* __restrict__ O, bool with_ctxq) {
    lptr lds = (lptr)lds_;
    const int tid = tid_opaque(), wave = tid >> 6, lane = tid & 63, fr = lane & 15, g = lane >> 4;
    const int nlat = NB * 16 * NQH, nun = nlat + (with_ctxq ? NB * NQH * 2 : 0);
    const float c2 = 0.08838834764831845f * 1.4426950408889634f;
    for (int u = blockIdx.x; u < nun; u += gridDim.x) {
        int b, j, hq, qrow0, nwin, jlo;
        if (u < nlat) { hq = u & 15; j = (u >> 4) & 15; b = u >> 8; qrow0 = b * SEQ + j * 128; jlo = j > 0 ? j - 1 : 0; nwin = (j < 15 ? j + 1 : 15) - jlo + 1; }
        else { const int v = u - nlat; hq = v & 15; const int cb = (v >> 4) & 1; b = v >> 5; j = 0; jlo = 0; nwin = 0; qrow0 = T_LAT + b * CTX + cb * 128; }
        const int nblk = nwin + 2, kvh = hq >> 2;
#define AT_KROW(kb) ((kb) < nwin ? b * SEQ + (jlo + (kb)) * 128 : T_LAT + b * CTX + ((kb) - nwin) * 128)
        const int qw = 16 * wave;
        bf16x8 qf[4];
#pragma unroll
        for (int ks = 0; ks < 4; ++ks) qf[ks] = *(const bf16x8*)(Q + (size_t)(qrow0 + qw + fr) * DM + hq * 128 + 32 * ks + 8 * g);
        const float sk2 = sink[hq] * 1.4426950408889634f;
        float mrun = sk2, lrun = g == 0 ? 1.f : 0.f;
        f32x4 oacc[8];
#pragma unroll
        for (int dt = 0; dt < 8; ++dt) oacc[dt] = (f32x4){0.f, 0.f, 0.f, 0.f};
        u32x4 kr[4], vr[4];
        at_prefetch(kr, vr, Kb, Vt, kvh, AT_KROW(0), tid);
#pragma unroll 1
        for (int kb = 0; kb < nblk; ++kb) {
            const int mask = kb < nwin ? (jlo + kb < j ? 1 : (jlo + kb > j ? 2 : 0)) : 0; const int krow_next = AT_KROW(kb + 1);
            __syncthreads();
            at_commit(kr, vr, lds, tid);
            __syncthreads();
            if (kb + 1 < nblk) at_prefetch(kr, vr, Kb, Vt, kvh, krow_next, tid);
            f32x4 sacc[8];
#pragma unroll
            for (int kt = 0; kt < 8; ++kt) { sacc[kt] = (f32x4){0.f, 0.f, 0.f, 0.f};
#pragma unroll
                for (int ks = 0; ks < 4; ++ks) { const bf16x8 kf = *(const LAS bf16x8*)(lds + AT_K_OFF + (16 * kt + fr) * AT_KS + (32 * ks + 8 * g) * 2);
                    sacc[kt] = __builtin_amdgcn_mfma_f32_16x16x32_bf16(kf, qf[ks], sacc[kt], 0, 0, 0); } }
            bf16x8 pf[4];
            {
                const int a = qw + fr; float mx = mrun;
                const int klo = (mask == 1 ? a : 0) - 4 * g, kspan = (mask == 1 ? 127 - a : (mask == 2 ? a : 127));
                if (mask != 0) {
#pragma unroll
                    for (int kt = 0; kt < 8; ++kt)
#pragma unroll
                        for (int r = 0; r < 4; ++r) { float v = sacc[kt][r] * c2;
                            const bool dead = (unsigned)(16 * kt + r - klo) > (unsigned)kspan; v = dead ? -__builtin_inff() : v; sacc[kt][r] = v; mx = fmaxf(mx, v); }
                } else {
#pragma unroll
                    for (int kt = 0; kt < 8; ++kt)
#pragma unroll
                        for (int r = 0; r < 4; ++r) { const float v = sacc[kt][r] * c2; sacc[kt][r] = v; mx = fmaxf(mx, v); }
                }
                mx = fmaxf(mx, __shfl_xor(mx, 16)); mx = fmaxf(mx, __shfl_xor(mx, 32));
                const float alpha = __builtin_amdgcn_exp2f(mrun - mx); mrun = mx; float ls = 0.f;
#pragma unroll
                for (int kt = 0; kt < 8; ++kt)
#pragma unroll
                    for (int r = 0; r < 4; ++r) { const float p = __builtin_amdgcn_exp2f(sacc[kt][r] - mx); sacc[kt][r] = p; ls += p; }
                lrun = lrun * alpha + ls;
#pragma unroll
                for (int dt = 0; dt < 8; ++dt) oacc[dt] *= alpha;
#pragma unroll
                for (int p4 = 0; p4 < 4; ++p4) { u32x4 w; w.x = pk_bf16(sacc[2 * p4][0], sacc[2 * p4][1]); w.y = pk_bf16(sacc[2 * p4][2], sacc[2 * p4][3]);
                    w.z = pk_bf16(sacc[2 * p4 + 1][0], sacc[2 * p4 + 1][1]); w.w = pk_bf16(sacc[2 * p4 + 1][2], sacc[2 * p4 + 1][3]); pf[p4] = __builtin_bit_cast(bf16x8, w); }
            }
            u32x2 vlo[2][4], vhi[2][4];
#define AT_LOADV(s_, dt_) do { _Pragma("unroll") for (int p4 = 0; p4 < 4; ++p4) { lptr vp = lds + AT_V_OFF + (16 * (dt_) + fr) * AT_VS + (32 * p4 + 4 * g) * 2; vlo[s_][p4] = *(const volatile LAS u32x2*)vp; vhi[s_][p4] = *(const volatile LAS u32x2*)(vp + 32); } } while (0)
            AT_LOADV(0, 0);
#pragma unroll
            for (int dt = 0; dt < 8; ++dt) {
                if (dt + 1 < 8) { if (dt & 1) AT_LOADV(0, dt + 1); else AT_LOADV(1, dt + 1); }
                __builtin_amdgcn_sched_barrier(0);
#pragma unroll
                for (int p4 = 0; p4 < 4; ++p4) { u32x4 vv; vv.x = vlo[dt & 1][p4].x; vv.y = vlo[dt & 1][p4].y; vv.z = vhi[dt & 1][p4].x; vv.w = vhi[dt & 1][p4].y; const bf16x8 vf = __builtin_bit_cast(bf16x8, vv);
                    oacc[dt] = __builtin_amdgcn_mfma_f32_16x16x32_bf16(vf, pf[p4], oacc[dt], 0, 0, 0); }
                __builtin_amdgcn_sched_barrier(0);
            }
#undef AT_LOADV
        }
        {   float l = lrun; l += __shfl_xor(l, 16); l += __shfl_xor(l, 32); const float inv = 1.0f / l;
            unsigned char* op = (unsigned char*)O + (size_t)(qrow0 + qw + fr) * DM + hq * 128 + 4 * g;
#pragma unroll
            for (int dt = 0; dt < 8; ++dt) *(unsigned*)(op + 16 * dt) = pk_fp8x4(oacc[dt][0] * inv, oacc[dt][1] * inv, oacc[dt][2] * inv, oacc[dt][3] * inv, F8_O); }
    }
    __syncthreads();
}


constexpr int TK_KS = 288;
constexpr int TK_K_OFF = 0, TK_W_OFF = 2 * 128 * TK_KS, TK_END = TK_W_OFF + 8 * 768;
static_assert(TK_END <= 2 * LDS_HALF, "topk LDS");
DI unsigned ord_key(float v) { const unsigned b = __float_as_uint(v); return b ^ ((unsigned)((int)b >> 31) | 0x80000000u); }
DI float ord_val(unsigned k) { return __uint_as_float((k & 0x80000000u) ? (k ^ 0x80000000u) : ~k); }
template <int CTRL> DI unsigned dpp_u(unsigned x) { return (unsigned)__builtin_amdgcn_update_dpp(0, (int)x, CTRL, 0xF, 0xF, true); }
DI unsigned umax(unsigned a, unsigned b) { return a > b ? a : b; }
DI unsigned rowmax16(unsigned x) { x = umax(x, dpp_u<0xB1>(x)); x = umax(x, dpp_u<0x4E>(x)); x = umax(x, dpp_u<0x141>(x)); x = umax(x, dpp_u<0x140>(x)); return x; }
DI float rowsum16(float x) { x += __uint_as_float(dpp_u<0xB1>(__float_as_uint(x))); x += __uint_as_float(dpp_u<0x4E>(__float_as_uint(x))); x += __uint_as_float(dpp_u<0x141>(__float_as_uint(x))); x += __uint_as_float(dpp_u<0x140>(__float_as_uint(x))); return x; }
DI unsigned umin(unsigned a, unsigned b) { return a < b ? a : b; }
#define TK_CE(i, j) do { const unsigned _a = umax(key[i], key[j]), _b = umin(key[i], key[j]); key[i] = _a; key[j] = _b; } while (0)
DI unsigned row_top16(unsigned (&key)[8], int fr) {
    TK_CE(0, 1); TK_CE(2, 3); TK_CE(4, 5); TK_CE(6, 7);
    TK_CE(0, 2); TK_CE(1, 3); TK_CE(4, 6); TK_CE(5, 7);
    TK_CE(1, 2); TK_CE(5, 6);
    TK_CE(0, 4); TK_CE(1, 5); TK_CE(2, 6); TK_CE(3, 7);
    TK_CE(2, 4); TK_CE(3, 5);
    TK_CE(1, 2); TK_CE(3, 4); TK_CE(5, 6);
    unsigned sel = 0u;
#pragma unroll 1
    for (int t = 0; t < 16; ++t) {
        const unsigned m = rowmax16(key[0]); sel = (fr == t) ? m : sel;
        const bool own = key[0] == m;
        key[0] = own ? key[1] : key[0]; key[1] = own ? key[2] : key[1]; key[2] = own ? key[3] : key[2]; key[3] = own ? key[4] : key[3];
        key[4] = own ? key[5] : key[4]; key[5] = own ? key[6] : key[5]; key[6] = own ? key[7] : key[6]; key[7] = own ? 0u : key[7];
    }
    return sel;
}
#undef TK_CE
DI void p_peer_topk(unsigned char* lds_, const bf16_t* __restrict__ qb, const float* __restrict__ keys1, const float* __restrict__ keys2, int* __restrict__ idx, float* __restrict__ gate, int nrows) {
    lptr lds = (lptr)lds_;
    const int tid = tid_opaque(), wave = tid >> 6, lane = tid & 63, fr = lane & 15, g = lane >> 4;
    const int ntile = nrows / 16, nchunk = 32, tpc = (ntile + nchunk - 1) / nchunk;
    LAS float* wl = (LAS float*)(lds + TK_W_OFF + wave * 768 + g * 192);
    for (int u = blockIdx.x; u < 8 * nchunk; u += gridDim.x) {
        const int h = u & 7, chunk = u >> 3;
        __syncthreads();
        for (int e = tid; e < 2 * 128 * 16; e += 512) {
            const int half = e >> 11, key = (e >> 4) & 127, part = e & 15; const float* src = (half ? keys2 : keys1) + ((size_t)h * 128 + key) * 128 + part * 8;
            const float4 a = *(const float4*)src, b2 = *(const float4*)(src + 4);
            u32x4 w; w.x = pk_bf16(a.x, a.y); w.y = pk_bf16(a.z, a.w); w.z = pk_bf16(b2.x, b2.y); w.w = pk_bf16(b2.z, b2.w);
            *(LAS u32x4*)(lds + TK_K_OFF + (half * 128 + key) * TK_KS + part * 16) = w; }
        __syncthreads();
        for (int tl = chunk * tpc + wave; tl < (chunk + 1) * tpc && tl < ntile; tl += 8) {
            const int tok0 = tl * 16;
            unsigned W1[4], W2[4];
#pragma unroll
            for (int half = 0; half < 2; ++half) {
                bf16x8 qf[4];
#pragma unroll
                for (int ks = 0; ks < 4; ++ks) qf[ks] = *(const bf16x8*)(qb + (size_t)(tok0 + fr) * DM + h * 256 + half * 128 + 32 * ks + 8 * g);
                f32x4 sc[8];
#pragma unroll
                for (int nt = 0; nt < 8; ++nt) { sc[nt] = (f32x4){0.f, 0.f, 0.f, 0.f};
#pragma unroll
                    for (int ks = 0; ks < 4; ++ks) { const bf16x8 kf = *(const LAS bf16x8*)(lds + TK_K_OFF + (half * 128 + 16 * nt + fr) * TK_KS + (32 * ks + 8 * g) * 2);
                        sc[nt] = __builtin_amdgcn_mfma_f32_16x16x32_bf16(qf[ks], kf, sc[nt], 0, 0, 0); } }
#pragma unroll
                for (int r = 0; r < 4; ++r) { unsigned key[8];
#pragma unroll
                    for (int nt = 0; nt < 8; ++nt) key[nt] = (ord_key(sc[nt][r]) & ~127u) | (unsigned)(127 - (fr + 16 * nt));
                    const unsigned w = row_top16(key, fr); if (half == 0) W1[r] = w; else W2[r] = w; }
            }
#pragma unroll
            for (int r = 0; r < 4; ++r) {
                const float v1 = ord_val(W1[r] & ~127u), v2 = ord_val(W2[r] & ~127u);
                wl[fr] = v2; ((LAS int*)wl)[16 + fr] = 127 - (int)(W1[r] & 127u); ((LAS int*)wl)[32 + fr] = 127 - (int)(W2[r] & 127u);
                int j = 0; float v2c = wl[0]; unsigned sel = 0u;
#pragma unroll 1
                for (int t = 0; t < 16; ++t) {
                    const float cand = v1 + v2c;
                    const unsigned key = j < 16 ? ((ord_key(cand) & ~255u) | (unsigned)(255 - (fr * 16 + j))) : 0u;
                    const unsigned m = rowmax16(key); sel = (fr == t) ? m : sel;
                    j += (key == m) ? 1 : 0; v2c = wl[j < 16 ? j : 15];
                }
                const float sm = ord_val(sel & ~255u); const int flat = 255 - (int)(sel & 255u);
                const int e1 = ((LAS int*)wl)[16 + (flat >> 4)], e2 = ((LAS int*)wl)[32 + (flat & 15)];
                const float mx = ord_val(rowmax16(sel) & ~255u); const float p = __expf(sm - mx); const float tot = rowsum16(p);
                const size_t o = (size_t)(tok0 + 4 * g + r) * 128 + h * 16 + fr;
                idx[o] = e1 * 128 + e2; gate[o] = p / tot;
            }
        }
    }
    __syncthreads();
}


typedef float f32x2_t __attribute__((ext_vector_type(2)));
constexpr int CVT_CHUNK = 16;
constexpr int CVT_Q_WORD = 24576;
DI void p_cvt_pull(unsigned* __restrict__ qw, int max_chunks, int drain_to, const float* __restrict__ su_all, const float* __restrict__ sv_all, unsigned char* __restrict__ du_all, unsigned char* __restrict__ dv_all, float* __restrict__ sc_all) {
    const int tid = tid_opaque(), lane = tid & 63;
    constexpr int CPL = 2 * NEXP / CVT_CHUNK;
    for (int n = 0; max_chunks < 0 || n < max_chunks; ++n) {
        if (max_chunks < 0) { if ((int)__builtin_amdgcn_readfirstlane((int)__hip_atomic_load(qw, __ATOMIC_RELAXED, __HIP_MEMORY_SCOPE_AGENT)) >= drain_to) break; }
        int g0 = 0; if (lane == 0) g0 = (int)__hip_atomic_fetch_add(qw, 1u, __ATOMIC_RELAXED, __HIP_MEMORY_SCOPE_AGENT);
        g0 = __builtin_amdgcn_readfirstlane(g0);
        if (g0 >= 4 * CPL) break;
        const int L = g0 / CPL, c0 = g0 % CPL;
        const float* su = su_all + (size_t)L * NEXP * DM; const float* sv = sv_all + (size_t)L * NEXP * DM;
        unsigned char* du = du_all + (size_t)L * (NEXP * DM / 2); unsigned char* dv = dv_all + (size_t)L * (NEXP * DM / 2); float* sc = sc_all + (size_t)L * 2 * NEXP;
#pragma unroll 2
        for (int rr = 0; rr < CVT_CHUNK; ++rr) {
            const int row = c0 * CVT_CHUNK + rr;
            const bool second = row >= NEXP; const int e = second ? row - NEXP : row; const float* src = (second ? sv : su) + (size_t)e * DM + lane * 4;
            float4 v[8]; float amax = 0.f;
#pragma unroll
            for (int i = 0; i < 8; ++i) { v[i] = *(const float4*)(src + i * 256); amax = fmaxf(amax, fmaxf(fmaxf(fabsf(v[i].x), fabsf(v[i].y)), fmaxf(fabsf(v[i].z), fabsf(v[i].w)))); }
            amax = wave_max(amax);
            const float scale = amax > 0.f ? (second ? 8.0f : 10.0f) / amax : 1.0f, inv = amax > 0.f ? amax * (second ? 0.125f : 0.1f) : 1.0f;
            unsigned char* dst = (second ? dv : du) + (size_t)e * 128 + (second ? 16 * (lane & 7) + 2 * (lane >> 3) : lane * 2);
            if (second) {
#pragma unroll
                for (int i = 0; i < 8; ++i) { unsigned p = 0u; p = __builtin_amdgcn_cvt_scalef32_pk_fp4_f32(p, v[i].x * scale, v[i].y * scale, 1.0f, 0); p = __builtin_amdgcn_cvt_scalef32_pk_fp4_f32(p, v[i].z * scale, v[i].w * scale, 1.0f, 1);
                    *(unsigned short*)(dst + (size_t)i * (NEXP * 128)) = (unsigned short)p; }
            } else {
#pragma unroll
                for (int i = 0; i < 8; ++i) { const int q0 = max(-7, min(7, (int)rintf(v[i].x * scale))), q1 = max(-7, min(7, (int)rintf(v[i].y * scale))), q2 = max(-7, min(7, (int)rintf(v[i].z * scale))), q3 = max(-7, min(7, (int)rintf(v[i].w * scale)));
                    *(unsigned short*)(dst + (size_t)i * (NEXP * 128)) = (unsigned short)((unsigned)(q0 & 15) | ((unsigned)(q1 & 15) << 4) | ((unsigned)(q2 & 15) << 8) | ((unsigned)(q3 & 15) << 12)); }
            }
            if (lane == 0) sc[row] = inv;
        }
    }
}
DI int gemm_units_of(int M, int N, int G, int c) { const int nwg = (M / 256) * (N / 256); return c < nwg ? (nwg - c + G - 1) / G : 0; }
constexpr int PG_GRP = 16;
constexpr int PG_NSL = 8;
#define P4_LOAD4(buf, tab, idq, k0) do { _Pragma("unroll") for (int _kk = 0; _kk < 4; ++_kk) { const unsigned _id = idq[((k0) + _kk) >> 2][((k0) + _kk) & 3]; \
        buf[_kk] = *(const u32x4*)((tab) + (_id * 128u + toff)); } asm volatile("" ::: "memory"); } while (0)
#define P4_LOAD8(buf, tab, idq, k0) do { _Pragma("unroll") for (int _kk = 0; _kk < 8; ++_kk) { const unsigned _id = idq[((k0) + _kk) >> 2][((k0) + _kk) & 3]; \
        buf[_kk] = *(const u32x4*)((tab) + (_id * 128u + toff)); } asm volatile("" ::: "memory"); } while (0)
typedef _Float16 h2v_t __attribute__((ext_vector_type(2)));
DI int rowsum8i(int x) { x += (int)dpp_u<0xB1>((unsigned)x); x += (int)dpp_u<0x4E>((unsigned)x); x += (int)dpp_u<0x141>((unsigned)x); return x; }
DI void peer_u_wave(int t0, int xs, const unsigned* __restrict__ xd, const float* __restrict__ xsc, const int* __restrict__ idx, const unsigned char* __restrict__ pu4, float* __restrict__ part, int lane) {
    const int sub = lane & 7, eg = lane >> 3; const unsigned toff = (unsigned)xs * (NEXP * 128) + 16 * sub; const int xoff = 8 * (8 * xs + sub);
    u32x4 idA[4], idB[4], xwA[2], xwB[2];
    const float sxl = xsc[t0 + (lane & (PG_GRP - 1))];
    u32x4 bA0[8], bA1[8], bB0[8], bB1[8];
    {   u32x4 id0[4];
#pragma unroll
        for (int q = 0; q < 4; ++q) { id0[q] = *(const u32x4*)(idx + (size_t)t0 * 128 + 16 * eg + 4 * q); idA[q] = *(const u32x4*)(idx + (size_t)(t0 + 1) * 128 + 16 * eg + 4 * q); }
        xwA[0] = *(const u32x4*)(xd + (size_t)t0 * 512 + xoff); xwA[1] = *(const u32x4*)(xd + (size_t)t0 * 512 + xoff + 4);
        P4_LOAD8(bA0, pu4, id0, 0); P4_LOAD8(bA1, pu4, id0, 8); }
#define P4_DOT8(buf, k0) do { _Pragma("unroll") for (int _kk = 0; _kk < 8; ++_kk) { int ah, al; \
          \
        { const int r0_ = (int)buf[_kk][0], x0_ = (int)xh8[0]; asm("v_dot8_i32_i4 %0, %1, %2, 0" : "=v"(ah) : "v"(r0_), "v"(x0_)); } \
        _Pragma("unroll") for (int d = 1; d < 4; ++d) ah = __builtin_amdgcn_sdot8((int)buf[_kk][d], (int)xh8[d], ah, false); \
        al = ah << 4; \
        _Pragma("unroll") for (int d = 0; d < 4; ++d) al = __builtin_amdgcn_sdot8((int)buf[_kk][d], (int)xl8[d], al, false); \
        const int sd = rowsum8i(al); const int _k = (k0) + _kk; \
        if ((_k & 1) == 0) d0 = (sub == (_k >> 1)) ? sd : d0; else d1 = (sub == (_k >> 1)) ? sd : d1; } } while (0)
    typedef _Float16 h2_t __attribute__((ext_vector_type(2)));
#define P4_USTEP(C0, C1, N0, N1, IDC, IDN, XWC, XWN, tt_) do { const int t = t0 + (tt_), tn1 = (tt_) < PG_GRP - 1 ? t + 1 : t, tn2 = (tt_) < PG_GRP - 2 ? t + 2 : t; \
        _Pragma("unroll") for (int q = 0; q < 4; ++q) IDN[q] = *(const u32x4*)(idx + (size_t)tn2 * 128 + 16 * eg + 4 * q); \
        XWN[0] = *(const u32x4*)(xd + (size_t)tn1 * 512 + xoff); XWN[1] = *(const u32x4*)(xd + (size_t)tn1 * 512 + xoff + 4); \
        asm volatile("" ::: "memory"); \
        P4_LOAD8(N0, pu4, IDC, 0); P4_LOAD8(N1, pu4, IDC, 8); \
        __builtin_amdgcn_sched_barrier(0); \
        unsigned xh8[4], xl8[4]; \
        _Pragma("unroll") for (int d = 0; d < 4; ++d) { const unsigned w0 = XWC[d >> 1][2 * (d & 1)], w1 = XWC[d >> 1][2 * (d & 1) + 1]; \
            xh8[d] = __builtin_amdgcn_perm(w1, w0, 0x05040100u); xl8[d] = __builtin_amdgcn_perm(w1, w0, 0x07060302u); } \
        int d0 = 0, d1 = 0; P4_DOT8(C0, 0); P4_DOT8(C1, 8); \
        const float sx = __builtin_bit_cast(float, __builtin_amdgcn_readlane(__builtin_bit_cast(int, sxl), (tt_))); \
        *(h2_t*)(part + ((size_t)xs * T_ALL + t) * 64 + 8 * eg + sub) = (h2_t){(_Float16)((float)d0 * sx), (_Float16)((float)d1 * sx)}; \
        __builtin_amdgcn_sched_barrier(0); } while (0)
#pragma unroll 1
    for (int tt = 0; tt < PG_GRP; tt += 2) { P4_USTEP(bA0, bA1, bB0, bB1, idA, idB, xwA, xwB, tt); P4_USTEP(bB0, bB1, bA0, bA1, idB, idA, xwB, xwA, tt + 1); }
}
DI void p_peer_combine(const int* __restrict__ idx, const float* __restrict__ gate, unsigned* __restrict__ wh, const float* __restrict__ part, const float* __restrict__ sc, int nrows) {
    typedef _Float16 h2_t __attribute__((ext_vector_type(2)));
    const int tid = tid_opaque(), lane = tid & 63; const int nw = gridDim.x * 8;
    for (int t = blockIdx.x * 8 + (tid >> 6); t < nrows; t += nw) {
        const int2 id2 = *(const int2*)(idx + (size_t)t * 128 + 2 * lane); float dA = 0.f, dB = 0.f;
#pragma unroll
        for (int s2 = 0; s2 < PG_NSL; ++s2) { const h2_t p = *(const h2_t*)(part + ((size_t)s2 * T_ALL + t) * 64 + lane); dA += (float)p.x; dB += (float)p.y; }
        float2 g = *(const float2*)(gate + (size_t)t * 128 + 2 * lane);
        g.x = g.x * gelu_erf(dA * sc[id2.x]) * sc[NEXP + id2.x]; g.y = g.y * gelu_erf(dB * sc[id2.y]) * sc[NEXP + id2.y];
        const h2_t w = (h2_t){(_Float16)g.x, (_Float16)g.y}; wh[(size_t)t * 64 + lane] = __builtin_bit_cast(unsigned, w);
    }
}
template <bool DLT, bool W16, bool H32> DI void peer_v_wave(int t0, int xs, const int* __restrict__ idx, const unsigned* __restrict__ wh, const unsigned char* __restrict__ pv4, const float* __restrict__ adaL, int g_off, const float* hin, const unsigned short* __restrict__ dl, float* hio, unsigned short* h16, int lane) {
    const int sub = lane & 7, eg = lane >> 3, ccol = 256 * xs + 4 * lane; const unsigned toff = (unsigned)xs * (NEXP * 128) + 16 * sub;
    typedef _Float16 h2_t __attribute__((ext_vector_type(2)));
    auto H2U = [](h2_t x) { return __builtin_bit_cast(unsigned, x); }; auto U2H = [](unsigned x) { return __builtin_bit_cast(h2_t, x); };
    u32x4 idA[4], idB[4], whA[2], whB[2], hA, hB; u32x2 dA, dB;
    const int bi = t0 < T_LAT ? t0 >> 11 : 8;
    const f32x4 gg = *(const f32x4*)(adaL + (size_t)bi * NMOD * DM + g_off + ccol);
    u32x4 bA0[8], bA1[8], bB0[8], bB1[8];
    {   u32x4 id0[4];
#pragma unroll
        for (int q = 0; q < 4; ++q) { id0[q] = *(const u32x4*)(idx + (size_t)t0 * 128 + 16 * eg + 4 * q); idA[q] = *(const u32x4*)(idx + (size_t)(t0 + 1) * 128 + 16 * eg + 4 * q); }
        whA[0] = *(const u32x4*)(wh + (size_t)t0 * 64 + 8 * eg); whA[1] = *(const u32x4*)(wh + (size_t)t0 * 64 + 8 * eg + 4); hA = (u32x4){0u, 0u, 0u, 0u}; hB = hA; if constexpr (H32) hA = *(const u32x4*)(hin + (size_t)t0 * DM + ccol); else { const u32x2 hw_ = *(const u32x2*)(h16 + (size_t)t0 * DM + ccol); hA.x = hw_.x; hA.y = hw_.y; } dA = (u32x2){0u, 0u}; dB = dA; if constexpr (DLT) dA = *(const u32x2*)(dl + (size_t)t0 * DM + ccol);
        P4_LOAD8(bA0, pv4, id0, 0); P4_LOAD8(bA1, pv4, id0, 8); }
#define P4_ACC8(buf, WHC, k0) do { _Pragma("unroll") for (int _kk = 0; _kk < 8; ++_kk) { const h2_t wp = U2H(WHC[((k0) + _kk) >> 3][(((k0) + _kk) >> 1) & 3]); const _Float16 w1 = (((k0) + _kk) & 1) ? wp.y : wp.x; const h2_t w2 = (h2_t){w1, w1}; \
        _Pragma("unroll") for (int d = 0; d < 4; ++d) { acc[4 * d] += w2 * __builtin_amdgcn_cvt_scalef32_pk_f16_fp4(buf[_kk][d], 1.0f, 0); acc[4 * d + 1] += w2 * __builtin_amdgcn_cvt_scalef32_pk_f16_fp4(buf[_kk][d], 1.0f, 1); \
            acc[4 * d + 2] += w2 * __builtin_amdgcn_cvt_scalef32_pk_f16_fp4(buf[_kk][d], 1.0f, 2); acc[4 * d + 3] += w2 * __builtin_amdgcn_cvt_scalef32_pk_f16_fp4(buf[_kk][d], 1.0f, 3); } } } while (0)
#define P4_VSTEP(C0, C1, N0, N1, IDC, IDN, WHC, WHN, HC, HN, DC, DN, tt_) do { const int t = t0 + (tt_), tn1 = (tt_) < PG_GRP - 1 ? t + 1 : t, tn2 = (tt_) < PG_GRP - 2 ? t + 2 : t; \
        _Pragma("unroll") for (int q = 0; q < 4; ++q) IDN[q] = *(const u32x4*)(idx + (size_t)tn2 * 128 + 16 * eg + 4 * q); \
        WHN[0] = *(const u32x4*)(wh + (size_t)tn1 * 64 + 8 * eg); WHN[1] = *(const u32x4*)(wh + (size_t)tn1 * 64 + 8 * eg + 4); if constexpr (H32) HN = *(const u32x4*)(hin + (size_t)tn1 * DM + ccol); else { const u32x2 hw_ = *(const u32x2*)(h16 + (size_t)tn1 * DM + ccol); HN.x = hw_.x; HN.y = hw_.y; } if constexpr (DLT) DN = *(const u32x2*)(dl + (size_t)tn1 * DM + ccol); \
        asm volatile("" ::: "memory"); \
        P4_LOAD8(N0, pv4, IDC, 0); P4_LOAD8(N1, pv4, IDC, 8); \
        __builtin_amdgcn_sched_barrier(0); \
        h2_t acc[16]; \
        _Pragma("unroll") for (int i = 0; i < 16; ++i) acc[i] = (h2_t){(_Float16)0.f, (_Float16)0.f}; \
        P4_ACC8(C0, WHC, 0); P4_ACC8(C1, WHC, 8); \
        h2_t s1[8], s2[4], s3[2]; \
        _Pragma("unroll") for (int i = 0; i < 8; ++i) { const auto r = __builtin_amdgcn_permlane32_swap(H2U(acc[i]), H2U(acc[i + 8]), false, false); s1[i] = U2H(r[0]) + U2H(r[1]); } \
        _Pragma("unroll") for (int i = 0; i < 4; ++i) { const auto r = __builtin_amdgcn_permlane16_swap(H2U(s1[i]), H2U(s1[i + 4]), false, false); s2[i] = U2H(r[0]) + U2H(r[1]); } \
        _Pragma("unroll") for (int i = 0; i < 2; ++i) { const bool up = (lane & 8) != 0; const unsigned keep = up ? H2U(s2[i + 2]) : H2U(s2[i]), send = up ? H2U(s2[i]) : H2U(s2[i + 2]); \
            s3[i] = U2H(keep) + U2H(dpp_u<0x128>(send)); } \
        const h2_t dd0 = U2H(DC.x), dd1 = U2H(DC.y); f32x4 o; if constexpr (H32) o = __builtin_bit_cast(f32x4, HC); else { const h2_t b0 = U2H(HC.x), b1 = U2H(HC.y); o = (f32x4){(float)b0.x, (float)b0.y, (float)b1.x, (float)b1.y}; } o[0] += (float)dd0.x + gg[0] * (float)s3[0].x; o[1] += (float)dd0.y + gg[1] * (float)s3[0].y; o[2] += (float)dd1.x + gg[2] * (float)s3[1].x; o[3] += (float)dd1.y + gg[3] * (float)s3[1].y; \
        if constexpr (W16) { u32x2 ow; ow.x = pk_f16(o[0], o[1]); ow.y = pk_f16(o[2], o[3]); *(u32x2*)(h16 + (size_t)t * DM + ccol) = ow; } else *(f32x4*)(hio + (size_t)t * DM + ccol) = o; \
        __builtin_amdgcn_sched_barrier(0); } while (0)
#pragma unroll 1
    for (int tt = 0; tt < PG_GRP; tt += 2) { P4_VSTEP(bA0, bA1, bB0, bB1, idA, idB, whA, whB, hA, hB, dA, dB, tt); P4_VSTEP(bB0, bB1, bA0, bA1, idB, idA, whB, whA, hB, hA, dB, dA, tt + 1); }
}
template <bool VPHASE, bool DLT = false, bool W16 = false, bool H32 = true> DI void p_peer_sliced(unsigned* __restrict__ qctr, int nrows, const unsigned* __restrict__ xd, const float* __restrict__ xsc, const int* __restrict__ idx, const unsigned* __restrict__ wh, float* __restrict__ part,
                                            const unsigned char* __restrict__ tab4, const float* __restrict__ adaL, int g_off, float* __restrict__ hio, const float* __restrict__ xin = nullptr, const float* __restrict__ cin = nullptr, const unsigned short* __restrict__ dl = nullptr, unsigned short* h16 = nullptr) {
    const int lane = tid_opaque() & 63;
    const int x0 = (int)(xb_xcc_id() & 7u);
    int j = 0, xs = x0;
    int nxt = 0; if (lane == 0) nxt = (int)__hip_atomic_fetch_add(qctr + 64 * xs, (unsigned)PG_GRP, __ATOMIC_RELAXED, __HIP_MEMORY_SCOPE_AGENT);
    while (j < PG_NSL) {
        const int t0 = __builtin_amdgcn_readfirstlane(nxt);
        if (t0 >= nrows) { ++j; if (j >= PG_NSL) break; xs = (x0 + j) & 7;
            nxt = 0; if (lane == 0) nxt = (int)__hip_atomic_fetch_add(qctr + 64 * xs, (unsigned)PG_GRP, __ATOMIC_RELAXED, __HIP_MEMORY_SCOPE_AGENT);
            continue; }
        const int xcur = xs;
        nxt = 0; if (lane == 0) nxt = (int)__hip_atomic_fetch_add(qctr + 64 * xs, (unsigned)PG_GRP, __ATOMIC_RELAXED, __HIP_MEMORY_SCOPE_AGENT);
        if constexpr (VPHASE) { const float* hin = xin ? (t0 < T_LAT ? xin : cin - (size_t)T_LAT * DM) : hio;
            peer_v_wave<DLT, W16, H32>(t0, xcur, idx, wh, tab4, adaL, g_off, hin, dl, hio, h16, lane); }
        else peer_u_wave(t0, xcur, xd, xsc, idx, tab4, part, lane);
    }
}

struct Params {
    const float* in[28]; float* out; unsigned char* ws;
};

struct Ctx {
    const Params* P;
    DI unsigned char* ws() const { size_t z = 0; asm volatile("" : "+s"(z)); return P->ws + z; }
    DI float* ada() const { return (float*)(ws() + W.ada); }
    DI float2* rope() const { return (float2*)(ws() + W.rope); }
    DI float* h() const { return (float*)(ws() + W.h); }
    DI bf16_t* a() const { return (bf16_t*)(ws() + W.a); }
    DI bf16_t* q() const { return (bf16_t*)(ws() + W.q); }
    DI bf16_t* kb() const { return (bf16_t*)(ws() + W.k); }
    DI bf16_t* vt() const { return (bf16_t*)(ws() + W.vt); }
    DI bf16_t* o() const { return (bf16_t*)(ws() + W.o); }
    DI bf16_t* ut() const { return (bf16_t*)(ws() + W.ut); }
    DI int* idx() const { return (int*)(ws() + W.idx); }
    DI float* gate() const { return (float*)(ws() + W.gate); }
    DI bf16_t* wqkv() const { return (bf16_t*)(ws() + W.wqkv); }
    DI bf16_t* wo() const { return (bf16_t*)(ws() + W.wo); }
    DI bf16_t* win() const { return (bf16_t*)(ws() + W.win); }
    DI bf16_t* wout() const { return (bf16_t*)(ws() + W.wout); }
    DI bf16_t* wq() const { return (bf16_t*)(ws() + W.wq); }
    DI bf16_t* filt() const { return (bf16_t*)(ws() + W.filt); }
    DI bf16_t* filtc() const { return (bf16_t*)(ws() + W.filtc); }
    DI unsigned char* pu(int L = 0) const { return ws() + W.pu + (size_t)L * (NEXP * DM / 2); }
    DI unsigned char* pv(int L = 0) const { return ws() + W.pv + (size_t)L * (NEXP * DM / 2); }
    DI bf16_t* yt() const { return (bf16_t*)(ws() + W.yt); }
    DI unsigned short* h16() const { return (unsigned short*)(ws() + W.h16); }
    DI unsigned short* dl() const { return (unsigned short*)(ws() + W.dl); }
    DI float* psc(int L = 0) const { return (float*)(ws() + W.psc) + (size_t)L * 2 * NEXP; }
    DI float* part() const { return (float*)(ws() + W.part); }
    DI unsigned* xd() const { return (unsigned*)(ws() + W.xd); }
    DI float* xsc() const { return (float*)(ws() + W.xsc); }
    DI unsigned* wh() const { return (unsigned*)(ws() + W.wh); }
    DI unsigned* qctr() const { return (unsigned*)(ws() + W.bar) + PQ_OFF_WORDS; }
    DI const float* x() const { return P->in[0]; }
    DI const float* ctx() const { return P->in[2]; }
    DI const float* norm_mix_g() const { return P->in[6]; }
    DI const float* norm_ffn_g() const { return P->in[7]; }
    DI const float* attn_sink() const { return P->in[11]; }
    DI const float* hy_conv_w() const { return P->in[13]; }
    DI const float* hy_conv_b() const { return P->in[14]; }
    DI const float* peer_keys1() const { return P->in[24]; }
    DI const float* peer_keys2() const { return P->in[25]; }
    DI const float* peer_u() const { return P->in[26]; }
    DI const float* peer_v() const { return P->in[27]; }
};
template <int I> DI void run_layer(const XcdBarrier& bar, const Ctx& C, unsigned char* lds) {
    constexpr bool is_attn = (I % 2) == 0, ctx_upd = I < 2; constexpr int j = I / 2;
    constexpr bool H16 = DELTA_LAYERS == 3;
    constexpr bool DLT = DELTA_LAYERS == 3 || (DELTA_LAYERS == 1 && is_attn) || (DELTA_LAYERS == 2 && !is_attn);
    const float* adaL = C.ada() + (size_t)I * 9 * NMOD * DM;
    constexpr int rows_a = I <= 2 ? T_ALL : T_LAT;
    constexpr int rows_u = ctx_upd ? T_ALL : T_LAT;
    const float* x0 = I == 0 ? C.x() : nullptr; const float* ctx0 = I == 0 ? C.ctx() : nullptr;
    const int Gn = (int)gridDim.x, cb_ = (int)blockIdx.x;
#define CVT_PULL(n) p_cvt_pull((unsigned*)(C.ws() + W.bar) + CVT_Q_WORD, (n), (I + 1) * (2 * NEXP / CVT_CHUNK), C.peer_u(), C.peer_v(), C.pu(), C.pv(), C.psc())
#define CVT_TAIL(mine, most) do { if ((mine) < (most)) CVT_PULL((most) - (mine)); } while (0)
    p_normmod<false, is_attn>(make_vb(lds), C.h(), x0, ctx0, C.norm_mix_g() + I * DM, adaL, 0, DM, C.a(), rows_a, nullptr, nullptr, nullptr, H16 && I > 0 ? C.h16() : nullptr);
    xcd_barrier(bar);
    if constexpr (is_attn) {
        const unsigned char* wj = (const unsigned char*)C.wqkv() + (size_t)j * QKVW * DM; const int G = (int)gridDim.x;
        p_gemm8(lds, C.a(), wj, T_ALL, 2560, DM, (int)blockIdx.x, EpiQK{C.q(), C.kb(), C.rope()}, F8_SC_AW);
        p_gemm8(lds, wj + (size_t)2560 * DM, C.a(), 512, T_ALL, DM, (int)((blockIdx.x + G - (720 % G)) % G), EpiBfP{C.vt(), T_ALL}, F8_SC_AW);
        {   const int cv = (cb_ + Gn - (720 % Gn)) % Gn; const int mine = gemm_units_of(T_ALL, 2560, Gn, cb_) + gemm_units_of(512, T_ALL, Gn, cv), most = (864 + Gn - 1) / Gn; CVT_TAIL(mine, most); }
        xcd_barrier(bar);
        p_attn(lds, C.q(), C.kb(), C.vt(), C.attn_sink() + j * NQH, C.o(), ctx_upd);
        if (PROBE_DUP == 3) p_attn(lds, C.q(), C.kb(), C.vt(), C.attn_sink() + j * NQH, C.o(), ctx_upd);
        xcd_barrier(bar);
        if constexpr (DLT) p_gemm8(lds, C.o(), (const unsigned char*)C.wo() + (size_t)j * DM * DM, rows_u, DM, DM, (int)blockIdx.x, EpiDelta{C.dl(), adaL, 2 * DM}, F8_SC_OW);
        else p_gemm8(lds, C.o(), (const unsigned char*)C.wo() + (size_t)j * DM * DM, rows_u, DM, DM, (int)blockIdx.x, EpiResid{C.h(), x0, ctx0, C.h(), adaL, 2 * DM}, F8_SC_OW);
        CVT_TAIL(gemm_units_of(rows_u, DM, Gn, cb_), ((rows_u / 256) * (DM / 256) + Gn - 1) / Gn);
    } else {
        p_gemm(lds, C.win() + (size_t)j * 3 * DM * DM, C.a(), 3 * DM, rows_u, DM, (int)blockIdx.x, EpiBfP{C.ut(), T_ALL});
        CVT_TAIL(gemm_units_of(3 * DM, rows_u, Gn, cb_), ((3 * DM / 256) * (rows_u / 256) + Gn - 1) / Gn);
        xcd_barrier(bar);
        p_hyena<ctx_upd>(lds, C.ut(), C.hy_conv_w() + (size_t)j * 9 * DM, C.hy_conv_b() + (size_t)j * 3 * DM, C.filt() + (size_t)j * 2 * DM * 4096, C.filtc(), C.yt());
        if (PROBE_DUP == 3) p_hyena<ctx_upd>(lds, C.ut(), C.hy_conv_w() + (size_t)j * 9 * DM, C.hy_conv_b() + (size_t)j * 3 * DM, C.filt() + (size_t)j * 2 * DM * 4096, C.filtc(), C.yt());
        xcd_barrier(bar);
        p_transpose_yt(lds, C.yt(), C.o(), rows_u);
        xcd_barrier(bar);
        if constexpr (DLT) p_gemm(lds, C.o(), C.wout() + (size_t)j * DM * DM, rows_u, DM, DM, (int)blockIdx.x, EpiDelta{C.dl(), adaL, 2 * DM});
        else p_gemm(lds, C.o(), C.wout() + (size_t)j * DM * DM, rows_u, DM, DM, (int)blockIdx.x, EpiResidP{C.h(), adaL, 2 * DM});
        CVT_TAIL(gemm_units_of(rows_u, DM, Gn, cb_), ((rows_u / 256) * (DM / 256) + Gn - 1) / Gn);
    }
    xcd_barrier(bar);
    p_normmod<true, true>(make_vb(lds), C.h(), DLT ? x0 : nullptr, DLT ? ctx0 : nullptr, C.norm_ffn_g() + I * DM, adaL, 3 * DM, 4 * DM, C.a(), rows_u, C.xd(), C.xsc(), DLT ? C.dl() : nullptr, H16 && I > 0 ? C.h16() : nullptr);
    xcd_barrier(bar);
    p_gemm8(lds, C.a(), (const unsigned char*)C.wq() + (size_t)I * DM * DM, rows_u, DM, DM, (int)blockIdx.x, EpiBfP{C.q(), DM}, F8_SC_AW);
    CVT_TAIL(gemm_units_of(rows_u, DM, Gn, cb_), ((rows_u / 256) * (DM / 256) + Gn - 1) / Gn);
    xcd_barrier(bar);
    p_peer_topk(lds, C.q(), C.peer_keys1() + (size_t)I * 8 * 128 * 128, C.peer_keys2() + (size_t)I * 8 * 128 * 128, C.idx(), C.gate(), rows_u);
    if (PROBE_DUP == 3) p_peer_topk(lds, C.q(), C.peer_keys1() + (size_t)I * 8 * 128 * 128, C.peer_keys2() + (size_t)I * 8 * 128 * 128, C.idx(), C.gate(), rows_u);
    CVT_PULL(-1);
    xcd_barrier(bar);
    p_peer_sliced<false>(C.qctr() + 64 * PG_NSL * (2 * I), rows_u, C.xd(), C.xsc(), C.idx(), C.wh(), C.part(), (const unsigned char*)C.pu(I), adaL, 5 * DM, C.h());
    xcd_barrier(bar);
    p_peer_combine(C.idx(), C.gate(), C.wh(), C.part(), C.psc(I), rows_u);
    xcd_barrier(bar);
    p_peer_sliced<true, DLT, H16, (!H16 || I == 0)>(C.qctr() + 64 * PG_NSL * (2 * I + 1), rows_u, C.xd(), C.xsc(), C.idx(), C.wh(), C.part(), (const unsigned char*)C.pv(I), adaL, 5 * DM, C.h(), DLT ? x0 : nullptr, DLT ? ctx0 : nullptr, C.dl(), C.h16());
    xcd_barrier(bar);
#undef CVT_PULL
#undef CVT_TAIL
}

__global__ void __launch_bounds__(512, 2) mega_fwd(Params P) {
    extern __shared__ __attribute__((aligned(16))) unsigned char lds[];
    volatile LAS unsigned* xbw = (volatile LAS unsigned*)(LAS unsigned char*)(lds + 2 * LDS_HALF);
    if (threadIdx.x < 4) xbw[threadIdx.x] = 0u;
    __syncthreads();
    unsigned char* ws = P.ws;
    XcdBarrier bar = xcd_barrier_post((unsigned*)(ws + W.bar), xbw);

    const float* c = P.in[1]; const float* c_ctx = P.in[3];
    const float* ada_w = P.in[4]; const float* ada_b = P.in[5];
    const float* final_g = P.in[8]; const float* attn_w_qkv = P.in[9]; const float* attn_w_o = P.in[10];
    const float* hy_w_in = P.in[12]; const float* hy_f_w1 = P.in[15];
    const float* hy_f_b1 = P.in[16]; const float* hy_f_w2 = P.in[17]; const float* hy_f_b2 = P.in[18]; const float* hy_f_w3 = P.in[19];
    const float* hy_decay = P.in[20]; const float* hy_fbias = P.in[21]; const float* hy_w_out = P.in[22]; const float* peer_w_q = P.in[23];
    float* cond = (float*)(ws + W.cond); float* h3 = (float*)(ws + W.h3);
    Ctx C; C.P = &P;

    p_cond(make_vb(lds), c, c_ctx, cond);
    p_rope(make_vb(lds), C.rope());
    for (int j = 0; j < 2; ++j) {
        p_wt<true>(make_vb(lds), attn_w_qkv + (size_t)j * DM * QKVW, (bf16_t*)((unsigned char*)C.wqkv() + (size_t)j * QKVW * DM), DM, QKVW, 2560);
        p_wt<true>(make_vb(lds), attn_w_o + (size_t)j * DM * DM, (bf16_t*)((unsigned char*)C.wo() + (size_t)j * DM * DM), DM, DM, 0);
        p_wt(make_vb(lds), hy_w_in + (size_t)j * DM * 3 * DM, C.win() + (size_t)j * 3 * DM * DM, DM, 3 * DM, 0);
        p_wt(make_vb(lds), hy_w_out + (size_t)j * DM * DM, C.wout() + (size_t)j * DM * DM, DM, DM, 0);
        float* h3l = h3 + (size_t)j * (SEQ + CTX) * 64;
        p_hy_h3(make_vb(lds), hy_f_w1 + j * 33 * 64, hy_f_b1 + j * 64, hy_f_w2 + j * 2 * 64 * 64, hy_f_b2 + j * 2 * 64, h3l, SEQ);
        if (j == 0) p_hy_h3(make_vb(lds), hy_f_w1, hy_f_b1, hy_f_w2, hy_f_b2, h3l + SEQ * 64, CTX);
    }
    for (int i = 0; i < 4; ++i) p_wt<true>(make_vb(lds), peer_w_q + (size_t)i * DM * DM, (bf16_t*)((unsigned char*)C.wq() + (size_t)i * DM * DM), DM, DM, 0);
    xcd_barrier(bar);
    p_ada2(lds, cond, ada_w, ada_b, C.ada());
    for (int j = 0; j < 2; ++j) {
        float* h3l = h3 + (size_t)j * (SEQ + CTX) * 64;
        p_hy_filt3<SEQ>(h3l, hy_f_w3 + (size_t)j * 64 * 4 * DM, hy_decay + j * 2 * DM, hy_fbias + j * 2 * DM, C.filt() + (size_t)j * 2 * DM * 4096);
        if (j == 0) p_hy_filt3<CTX>(h3l + SEQ * 64, hy_f_w3, hy_decay, hy_fbias, C.filtc());
    }
    xcd_barrier(bar);
    run_layer<0>(bar, C, lds);
    run_layer<1>(bar, C, lds);
    run_layer<2>(bar, C, lds);
    run_layer<3>(bar, C, lds);
    p_final(make_vb(lds), C.h16(), final_g, P.out);
}

extern "C" void kernel_launch(void* const* d_in, const int* in_sizes, int n_in, void* d_out, int out_size, void* d_ws, size_t ws_size, hipStream_t stream) {
    static int grid = 0;
    if (grid == 0) {
        if (n_in != 28 || ws_size < W.end) { fprintf(stderr, "kernel_launch: bad inputs / workspace too small: %zu < %zu\n", ws_size, W.end); grid = -1; return; }
        int dev = 0, cus = 0, per_cu = 0;
        if (hipGetDevice(&dev) != hipSuccess || hipDeviceGetAttribute(&cus, hipDeviceAttributeMultiprocessorCount, dev) != hipSuccess) { grid = -1; return; }
        if (hipFuncSetAttribute((const void*)mega_fwd, hipFuncAttributeMaxDynamicSharedMemorySize, LDS_BYTES) != hipSuccess) { fprintf(stderr, "kernel_launch: hipFuncSetAttribute failed\n"); grid = -1; return; }
        if (hipOccupancyMaxActiveBlocksPerMultiprocessor(&per_cu, (const void*)mega_fwd, 512, LDS_BYTES) != hipSuccess || per_cu < 1) fprintf(stderr, "kernel_launch: occupancy query says %d\n", per_cu);
        (void)hipGetLastError();
        grid = cus;
    }
    if (grid < 0) return;
    (void)hipMemsetAsync((unsigned char*)d_ws + W.bar, 0, 128 * 1024, stream);
    Params P{};
    for (int i = 0; i < 28; ++i) P.in[i] = (const float*)d_in[i];
    P.out = (float*)d_out; P.ws = (unsigned char*)d_ws;
    hipLaunchKernelGGL(mega_fwd, dim3(grid), dim3(512), LDS_BYTES, stream, P);
}
```

```cpp
#include <hip/hip_runtime.h>
#include <stdint.h>
#include <stdio.h>

typedef unsigned short bf16_t;
typedef short bf16x8 __attribute__((ext_vector_type(8)));
typedef float f32x4 __attribute__((ext_vector_type(4)));
typedef unsigned u32x4 __attribute__((ext_vector_type(4)));
typedef unsigned u32x2 __attribute__((ext_vector_type(2)));

#define DI __device__ __forceinline__

constexpr int DM = 2048;
constexpr int NB = 8;
constexpr int SEQ = 2048;
constexpr int CTX = 256;
constexpr int T_LAT = NB * SEQ;
constexpr int T_CTX = NB * CTX;
constexpr int T_ALL = T_LAT + T_CTX;
constexpr int NMOD = 6;
constexpr int HD = 128, NQH = 16, NKVH = 4;
constexpr int QKVW = 3072;
constexpr int PH = 8, PNK = 128, PTOPK = 16;
constexpr int NEXP = 16384;

DI bf16_t f2bf(float f) { unsigned u = __float_as_uint(f); u += 0x7fffu + ((u >> 16) & 1u); return (bf16_t)(u >> 16); }
DI float bf2f(bf16_t b) { return __uint_as_float(((unsigned)b) << 16); }
DI float wave_sum(float v) { for (int o = 32; o >= 1; o >>= 1) v += __shfl_xor(v, o); return v; }
DI float wave_max(float v) { for (int o = 32; o >= 1; o >>= 1) v = fmaxf(v, __shfl_xor(v, o)); return v; }

__host__ __device__ inline int head_perm(int p) { const int G = p >> 5, half = (p >> 4) & 1, j = p & 15; const int base = (G & 1) * 16 + (G >> 1) * 64; return base + j + 32 * half; }

struct WS {
    size_t bar, cond, ada, rope, h, a, q, k, vt, o, ut, yt, idx, gate, wqkv, wo, win, wout, wq, filt, filtc, h3, pu, pv, psc, part, xd, xsc, wh, dl, h16, end;
};
constexpr size_t ws_take(size_t& p, size_t bytes) { size_t r = p; p += (bytes + 255) & ~(size_t)255; return r; }
constexpr WS make_ws() {
    WS w{}; size_t p = 0;
    w.bar = ws_take(p, 128 * 1024);
    w.cond = ws_take(p, (size_t)9 * DM * 4);
    w.ada = ws_take(p, (size_t)4 * 9 * NMOD * DM * 4);
    w.rope = ws_take(p, (size_t)64 * 32 * 8);
    w.h = ws_take(p, (size_t)T_ALL * DM * 4);
    w.a = ws_take(p, (size_t)T_ALL * DM * 2);
    w.q = ws_take(p, (size_t)T_ALL * DM * 2);
    w.k = ws_take(p, (size_t)T_ALL * 512 * 2);
    w.vt = ws_take(p, (size_t)512 * T_ALL * 2);
    w.o = ws_take(p, (size_t)T_ALL * DM * 2);
    w.ut = ws_take(p, (size_t)3 * DM * T_ALL * 2);
    w.yt = ws_take(p, (size_t)DM * T_ALL * 2);
    w.idx = ws_take(p, (size_t)T_ALL * 128 * 4);
    w.gate = ws_take(p, (size_t)T_ALL * 128 * 4);
    w.wqkv = ws_take(p, (size_t)2 * QKVW * DM * 2);
    w.wo = ws_take(p, (size_t)2 * DM * DM * 2);
    w.win = ws_take(p, (size_t)2 * 3 * DM * DM * 2);
    w.wout = ws_take(p, (size_t)2 * DM * DM * 2);
    w.wq = ws_take(p, (size_t)4 * DM * DM * 2);
    w.filt = ws_take(p, (size_t)2 * 2 * DM * 4096 * 2);
    w.filtc = ws_take(p, (size_t)2 * DM * 512 * 2);
    w.h3 = ws_take(p, (size_t)2 * (SEQ + CTX) * 64 * 4);
    w.pu = ws_take(p, (size_t)4 * NEXP * DM / 2);
    w.pv = ws_take(p, (size_t)4 * NEXP * DM / 2);
    w.psc = ws_take(p, (size_t)4 * 2 * NEXP * 4);
    w.part = ws_take(p, (size_t)16 * T_ALL * 128 * 4);
    w.xd = ws_take(p, (size_t)T_ALL * 512 * 4);
    w.xsc = ws_take(p, (size_t)T_ALL * 4);
    w.wh = ws_take(p, (size_t)T_ALL * 64 * 4);
    w.dl = ws_take(p, (size_t)T_ALL * DM * 2);
    w.h16 = ws_take(p, (size_t)T_ALL * DM * 2);
    w.end = p;
    return w;
}
#ifndef PROBE_DUP
#define DELTA_LAYERS 3
#define PROBE_DUP 0
#endif
constexpr WS W = make_ws();
constexpr int PQ_OFF_WORDS = 4096;

namespace pg8 {
#define PG8_LAS __attribute__((address_space(3)))
typedef unsigned short bf16_t;
typedef short bf16x8 __attribute__((ext_vector_type(8)));
typedef float f32x4 __attribute__((ext_vector_type(4)));
typedef unsigned u32x4 __attribute__((ext_vector_type(4)));
constexpr int BM = 256, BK = 64, HALF = 128, HTB = HALF * BK * 2  , STAGE_BYTES = 8 * HTB, NXCD = 8, WGM = 8;

__host__ __device__ __forceinline__ int lds_byte(int r, int c) { const int st = (r >> 4) * 2 + (c >> 5), rr = r & 15, cc = c & 31, ob = rr * 64 + cc * 2; return st * 1024 + (ob ^ (((ob >> 9) & 1) << 5)); }
__host__ __device__ __forceinline__ void stage_rc(int b, int& R, int& C) { const int st = b / 1024, sb = b % 1024, swz = sb ^ (((sb >> 9) & 1) << 5); R = (st >> 1) * 16 + swz / 64; C = (st & 1) * 32 + (swz % 64) / 2; }
__host__ __device__ __forceinline__ int perm32(int rho) { const int n = rho >> 4, i = rho & 15; return 8 * (i >> 2) + 4 * n + (i & 3); }

struct Unit { int pm, pn; };
struct Gemm { const bf16_t* A; const bf16_t* Bt; int M, N, K; int sc; };
typedef int i32x4 __attribute__((ext_vector_type(4)));
typedef int i32x8 __attribute__((ext_vector_type(8)));

struct StaticOrder {
    int nM, nN, nwg, G, c;
    __host__ __device__ void init(int M, int N, int G_, int c_) { nM = M / BM; nN = N / BM; nwg = nM * nN; G = G_; c = c_; }
    __host__ __device__ bool next(int i, Unit& u) const {
        const long L = (long)i * G + c; if (L >= nwg) return false;
        int wgid = (int)L; { const int q = nwg / NXCD, r = nwg % NXCD, xcd = wgid % NXCD, off = wgid / NXCD; wgid = (xcd < r ? xcd * (q + 1) : r * (q + 1) + (xcd - r) * q) + off; }
        const int nig = WGM * nN, gid = wgid / nig, fm = gid * WGM, gsz = (nM - fm) < WGM ? (nM - fm) : WGM;
        u.pm = fm + ((wgid % nig) % gsz); u.pn = (wgid % nig) / gsz; return true;
    }
    __device__ __forceinline__ void a_ready(const Unit&) const {}
    __device__ __forceinline__ void done(const Unit&) const {}
};
struct CountedOrder : StaticOrder {
    const unsigned* ready; unsigned need; unsigned* tmo;
    __device__ __forceinline__ void a_ready(const Unit& u) const {
        if (threadIdx.x < 64) {
            const unsigned long long t0 = __builtin_amdgcn_s_memrealtime(); unsigned polls = 0;
            while ((unsigned)__builtin_amdgcn_readfirstlane(__hip_atomic_load(ready + 64 * u.pm, __ATOMIC_RELAXED, __HIP_MEMORY_SCOPE_AGENT)) < need) {
                if ((++polls & 255u) == 0u && __builtin_amdgcn_readfirstlane(__hip_atomic_load(tmo, __ATOMIC_RELAXED, __HIP_MEMORY_SCOPE_AGENT)) != 0u) break;
                if (__builtin_amdgcn_s_memrealtime() - t0 > 2000000ull) {
                    if (threadIdx.x == 0) { unsigned expect = 0u; __hip_atomic_compare_exchange_strong(tmo + 1, &expect, 0x600u | (unsigned)(u.pm & 0xff), __ATOMIC_RELAXED, __ATOMIC_RELAXED, __HIP_MEMORY_SCOPE_AGENT); __hip_atomic_store(tmo, 1u, __ATOMIC_RELAXED, __HIP_MEMORY_SCOPE_AGENT); }
                    break; }
                __builtin_amdgcn_s_sleep(2); }
            __builtin_amdgcn_fence(__ATOMIC_ACQUIRE, "agent");
            asm volatile("s_waitcnt vmcnt(0)" ::: "memory");
        }
#if !defined(BROKEN_HOOK_NO_BARRIER)
        asm volatile("" ::: "memory"); __builtin_amdgcn_s_barrier(); asm volatile("" ::: "memory");
#endif
    }
};

__device__ __forceinline__ unsigned cvt_pk_bf16(float lo, float hi) { unsigned r; asm volatile("v_cvt_pk_bf16_f32 %0, %1, %2" : "=v"(r) : "v"(lo), "v"(hi)); return r; }
template <class Epi, class Sched, bool STAMP = false, bool F8 = false>
__device__ __forceinline__ void gemm_phase(PG8_LAS unsigned char* lds, const Gemm g, const Sched& S, const Epi& E, unsigned long long* stamps) {
    int tid_ = threadIdx.x; asm volatile("" : "+v"(tid_));
    const int tid = tid_, wid = __builtin_amdgcn_readfirstlane(tid >> 6), lane = tid & 63, wr = wid >> 2, wc = wid & 3, fr = lane & 15, fq = lane >> 4;
    const int K = g.K, nt = K / BK;
    int ts_lo = 0, ts_hi = 0, nts = 0; const unsigned long long rt_entry = STAMP ? (unsigned long long)wall_clock64() : 0ull;
#define PG8_STAMP() do { if (STAMP && wid == 0 && nts < 64) { const unsigned long long _c = (unsigned long long)clock64(); \
        ts_lo = (lane == nts) ? (int)(unsigned)_c : ts_lo; ts_hi = (lane == nts) ? (int)(unsigned)(_c >> 32) : ts_hi; ++nts; } } while (0)
    PG8_STAMP();
    unsigned voffA[2], voffB[2];
#pragma unroll
    for (int i = 0; i < 2; ++i) { int R, C; stage_rc(tid * 16 + i * 8192, R, C); const int Rb = Epi::PERM ? ((R & ~31) + perm32(R & 31)) : R;
        voffA[i] = (unsigned)(R * K + C) * 2u; voffB[i] = (unsigned)(Rb * K + C) * 2u; }
    const size_t kstep = (size_t)(BK * 2);
    const size_t hstep = (size_t)HALF * K * 2;
    const size_t tstep = 2 * hstep;
    const unsigned ldsw = (unsigned)wid * 1024u;
    const int aoff = lds_byte(wr * 64 + fr, fq * 8), boff = lds_byte(wc * 32 + fr, fq * 8);
#define PG8_SA(b, h) (((b) * 2 + (h)) * HTB)
#define PG8_SB(b, h) ((4 + (b) * 2 + (h)) * HTB)
#define PG8_STAGE(bufoff, gbase, voff) do { _Pragma("unroll") for (int _i = 0; _i < 2; ++_i) \
        __builtin_amdgcn_global_load_lds((const unsigned*)((const char*)(gbase) + (voff)[_i]), (PG8_LAS unsigned*)(lds + (bufoff) + ldsw + _i * 8192), 16, 0, 0); } while (0)
#define PG8_RD(off) (*(const PG8_LAS i32x4*)(lds + (off)))
#define PG8_LDA(dst, b, h) do { _Pragma("unroll") for (int m = 0; m < 4; ++m) { if constexpr (F8) { dst##8[m].lo = PG8_RD(PG8_SA(b, h) + aoff + m * 2048); dst##8[m].hi = PG8_RD(PG8_SA(b, h) + aoff + m * 2048 + 1024); } \
        else { _Pragma("unroll") for (int k = 0; k < 2; ++k) dst[m][k] = *(const PG8_LAS bf16x8*)(lds + PG8_SA(b, h) + aoff + m * 2048 + k * 1024); } } } while (0)
#define PG8_LDB(dst, b, h) do { _Pragma("unroll") for (int n = 0; n < 2; ++n) { if constexpr (F8) { dst##8[n].lo = PG8_RD(PG8_SB(b, h) + boff + n * 2048); dst##8[n].hi = PG8_RD(PG8_SB(b, h) + boff + n * 2048 + 1024); } \
        else { _Pragma("unroll") for (int k = 0; k < 2; ++k) dst[n][k] = *(const PG8_LAS bf16x8*)(lds + PG8_SB(b, h) + boff + n * 2048 + k * 1024); } } } while (0)
#define PG8_MMA(ai, bj, At, Bt) do { __builtin_amdgcn_s_setprio(1); _Pragma("unroll") for (int m = 0; m < 4; ++m) _Pragma("unroll") for (int n = 0; n < 2; ++n) { \
        if constexpr (F8) asm volatile("v_mfma_scale_f32_16x16x128_f8f6f4 %0, %1, %2, %0, %3, %3 op_sel_hi:[0,0,0]" : "+v"(acc[ai][bj][m][n]) : "v"(Bt##8[n]), "v"(At##8[m]), "v"(scv));   \
        else { _Pragma("unroll") for (int k = 0; k < 2; ++k) acc[ai][bj][m][n] = __builtin_amdgcn_mfma_f32_16x16x32_bf16(Bt[n][k], At[m][k], acc[ai][bj][m][n], 0, 0, 0); } } \
        __builtin_amdgcn_s_setprio(0); } while (0)
#define PG8_WAIT_V(n) asm volatile("s_waitcnt vmcnt(" #n ")" ::: "memory")
#define PG8_WAIT_L(n) asm volatile("s_waitcnt lgkmcnt(" #n ")" ::: "memory")
#define PG8_BAR __builtin_amdgcn_s_barrier()
#define PG8_SCHED __builtin_amdgcn_sched_barrier(0)
    Unit cur, nxt; int ui = 0;
    if (!S.next(0, cur)) return;
    f32x4 acc[2][2][4][2];
#pragma unroll
    for (int a = 0; a < 2; ++a)
#pragma unroll
        for (int b = 0; b < 2; ++b)
#pragma unroll
            for (int m = 0; m < 4; ++m)
#pragma unroll
                for (int n = 0; n < 2; ++n) acc[a][b][m][n] = (f32x4){0.f, 0.f, 0.f, 0.f};
    bf16x8 At[4][2], B0[2][2], B1[2][2];
    const int scv = g.sc; i32x8 At8[4], B08[2], B18[2];
    const char* cA = (const char*)g.A + (size_t)cur.pm * tstep; const char* cB = (const char*)g.Bt + (size_t)cur.pn * tstep;
    S.a_ready(cur);
    PG8_STAGE(PG8_SB(0, 0), cB, voffB); PG8_STAGE(PG8_SA(0, 0), cA, voffA); PG8_STAGE(PG8_SB(0, 1), cB + hstep, voffB); PG8_STAGE(PG8_SA(0, 1), cA + hstep, voffA);
    if (wr == 1) PG8_BAR;
    PG8_WAIT_V(4); PG8_BAR;
    PG8_STAGE(PG8_SB(1, 0), cB + kstep, voffB); PG8_STAGE(PG8_SA(1, 0), cA + kstep, voffA); PG8_STAGE(PG8_SB(1, 1), cB + hstep + kstep, voffB);
    PG8_WAIT_V(6); PG8_BAR;
    PG8_STAMP();
    for (;;) {
        const bool has_next = S.next(ui + 1, nxt);
        const char* nA = has_next ? (const char*)g.A + (size_t)nxt.pm * tstep : cA; const char* nB = has_next ? (const char*)g.Bt + (size_t)nxt.pn * tstep : cB;
        for (int t = 0; t < nt; t += 2) {
            const bool last = (t == nt - 2);
            const char* a1 = cA + (size_t)(t + 1) * kstep;
            const char* a2 = last ? nA : cA + (size_t)(t + 2) * kstep; const char* b2 = last ? nB : cB + (size_t)(t + 2) * kstep;
            const char* a3 = a2 + kstep; const char* b3 = b2 + kstep;
            if (last && has_next) S.a_ready(nxt);
            PG8_LDB(B0, 0, 0); PG8_SCHED; PG8_LDA(At, 0, 0); PG8_STAGE(PG8_SA(1, 1), a1 + hstep, voffA);
            PG8_WAIT_L(8); PG8_BAR; PG8_WAIT_L(0); PG8_MMA(0, 0, At, B0); PG8_BAR; PG8_SCHED;
            PG8_LDB(B1, 0, 1); PG8_STAGE(PG8_SB(0, 0), b2, voffB);
            PG8_BAR; PG8_WAIT_L(0); PG8_MMA(0, 1, At, B1); PG8_BAR;
            PG8_LDA(At, 0, 1); PG8_STAGE(PG8_SA(0, 0), a2, voffA);
            PG8_BAR; PG8_WAIT_L(0); PG8_MMA(1, 0, At, B0); PG8_BAR; PG8_SCHED;
            PG8_STAGE(PG8_SB(0, 1), b2 + hstep, voffB);
            PG8_WAIT_V(6); PG8_BAR; PG8_MMA(1, 1, At, B1); PG8_BAR;
            PG8_LDB(B0, 1, 0); PG8_SCHED; PG8_LDA(At, 1, 0); PG8_STAGE(PG8_SA(0, 1), a2 + hstep, voffA);
            PG8_WAIT_L(8); PG8_BAR; PG8_WAIT_L(0); PG8_MMA(0, 0, At, B0); PG8_BAR; PG8_SCHED;
            PG8_LDB(B1, 1, 1); PG8_STAGE(PG8_SB(1, 0), b3, voffB);
            PG8_BAR; PG8_WAIT_L(0); PG8_MMA(0, 1, At, B1); PG8_BAR;
            PG8_LDA(At, 1, 1); PG8_STAGE(PG8_SA(1, 0), a3, voffA);
            PG8_BAR; PG8_WAIT_L(0); PG8_MMA(1, 0, At, B0); PG8_BAR; PG8_SCHED;
            PG8_STAGE(PG8_SB(1, 1), b3 + hstep, voffB);
            PG8_WAIT_V(6); PG8_BAR; PG8_MMA(1, 1, At, B1); PG8_BAR;
        }
        PG8_STAMP();
        if constexpr (F8) asm volatile("s_nop 15\n\ts_nop 15" ::: "memory");
        if constexpr (!Epi::AFTER_DRAIN) { E(acc, cur, wr, wc, fr, fq); S.done(cur); }
        PG8_STAMP();
        if (!has_next) break;
#pragma unroll
        for (int a = 0; a < 2; ++a)
#pragma unroll
            for (int b = 0; b < 2; ++b)
#pragma unroll
                for (int m = 0; m < 4; ++m)
#pragma unroll
                    for (int n = 0; n < 2; ++n) acc[a][b][m][n] = (f32x4){0.f, 0.f, 0.f, 0.f};
        cur = nxt; cA = nA; cB = nB; ++ui;
    }
    PG8_WAIT_V(0);
    if (wr == 0) PG8_BAR;
    PG8_BAR;
    if constexpr (Epi::AFTER_DRAIN) { E.fused(acc, cur, wr, wc, fr, fq, lds, wid, lane); S.done(cur); }
    PG8_STAMP();
    if (STAMP && wid == 0) { stamps[lane] = lane < nts ? (((unsigned long long)(unsigned)ts_hi << 32) | (unsigned)ts_lo) : 0ull;
        if (lane == 62) stamps[62] = rt_entry; if (lane == 63) stamps[63] = (unsigned long long)wall_clock64(); }
#undef PG8_STAMP
#undef PG8_SA
#undef PG8_SB
#undef PG8_STAGE
#undef PG8_LDA
#undef PG8_LDB
#undef PG8_MMA
#undef PG8_RD
#undef PG8_WAIT_V
#undef PG8_WAIT_L
#undef PG8_BAR
#undef PG8_SCHED
}
}

#define XB_TMO      128
#define XB_XCNT(j)  (256  + 64 * (j))
#define XB_XSUB(j)  (1280 + 64 * (j))
#define XB_XGEN(j)  (2304 + 64 * (j))
#define XB_TOP      3328
#define XB_TOPGEN   3392
#define XCD_BAR_WORDS 3456
#define XB_SPIN_CAP (1u << 21)
#define LAS __attribute__((address_space(3)))
__device__ __forceinline__ unsigned xb_ld(unsigned* p)              { return __hip_atomic_load(p, __ATOMIC_RELAXED, __HIP_MEMORY_SCOPE_AGENT); }
__device__ __forceinline__ unsigned xb_add(unsigned* p, unsigned v) { return __hip_atomic_fetch_add(p, v, __ATOMIC_RELAXED, __HIP_MEMORY_SCOPE_AGENT); }
__device__ __forceinline__ unsigned xb_xcc_id() { return (unsigned)__builtin_amdgcn_s_getreg((3 << 11) | 20) & 0xFu; }
#define XB_SPIN(cond, bar) do { unsigned _sp = 0; while (cond) { __builtin_amdgcn_s_sleep(1); \
    if ((++_sp & 255u) == 0u) { if (xb_ld(&(bar)[XB_TMO])) break; if (_sp > XB_SPIN_CAP) { atomicAdd(&(bar)[XB_TMO], 1u); break; } } } } while (0)
struct XcdBarrier { unsigned* bar; unsigned x; volatile LAS unsigned* st; };
__device__ __forceinline__ XcdBarrier xcd_barrier_post(unsigned* bar, volatile LAS unsigned* st) {
    XcdBarrier b; b.bar = bar; b.x = xb_xcc_id(); b.st = st;
    if (threadIdx.x == 0) (void)xb_add(&bar[XB_XCNT(b.x)], 1u);
    return b;
}
__device__ __forceinline__ void xcd_barrier_complete(unsigned* bar, unsigned x, unsigned& nloc, unsigned& nx) {
    const unsigned G = gridDim.x * gridDim.y * gridDim.z;
    unsigned sum, cnt, mine, sp = 0u;
    for (;;) {
        sum = 0u; cnt = 0u; mine = 0u;
#pragma unroll
        for (unsigned j = 0; j < 16; ++j) { const unsigned c = xb_ld(&bar[XB_XCNT(j)]); sum += c; cnt += (c > 0u) ? 1u : 0u; mine = (j == x) ? c : mine; }
        if (sum == G) break;
        __builtin_amdgcn_s_sleep(1);
        if ((++sp & 255u) == 0u) { if (xb_ld(&bar[XB_TMO])) break; if (sp > XB_SPIN_CAP) { atomicAdd(&bar[XB_TMO], 1u); break; } }
    }
    nloc = mine > 0u ? mine : 1u; nx = cnt > 0u ? cnt : 1u;
}
__device__ __forceinline__ void xcd_barrier(const XcdBarrier& b) {
    asm volatile("s_waitcnt vmcnt(0)" ::: "memory");
    __syncthreads();
    if (threadIdx.x == 0) {
        unsigned* bar = b.bar;
        __builtin_amdgcn_s_waitcnt(0);
        unsigned nloc = b.st[0], nx = b.st[1];
        if (nloc == 0u) { xcd_barrier_complete(bar, b.x, nloc, nx); b.st[0] = nloc; b.st[1] = nx; }
        const unsigned old = xb_add(&bar[XB_XSUB(b.x)], 1u);
        const unsigned gen = old / nloc;
        if (old + 1u == (gen + 1u) * nloc) {
            __builtin_amdgcn_fence(__ATOMIC_RELEASE, "agent");
            asm volatile("s_waitcnt vmcnt(0)" ::: "memory");
            const unsigned og = xb_add(&bar[XB_TOP], 1u);
            const unsigned tg = og / nx;
            if (og + 1u == (tg + 1u) * nx) xb_add(&bar[XB_TOPGEN], 1u);
            else XB_SPIN(xb_ld(&bar[XB_TOPGEN]) == tg, bar);
            __builtin_amdgcn_fence(__ATOMIC_ACQUIRE, "agent");
            xb_add(&bar[XB_XGEN(b.x)], 1u);
            asm volatile("s_waitcnt vmcnt(0)" ::: "memory");
        } else {
            XB_SPIN(xb_ld(&bar[XB_XGEN(b.x)]) == gen, bar);
            __builtin_amdgcn_fence(__ATOMIC_ACQUIRE, "agent");
            asm volatile("s_waitcnt vmcnt(0)" ::: "memory");
        }
    }
    __syncthreads();
}

constexpr int LDS_BYTES = 147456;
constexpr int LDS_HALF = 65536;
struct VB { int vb, nvb, vtid; unsigned char* lds; };
DI int tid_opaque() { int t = threadIdx.x; asm volatile("" : "+v"(t)); return t; }
DI VB make_vb(unsigned char* lds) { int t = threadIdx.x; asm volatile("" : "+v"(t)); VB V; V.vb = blockIdx.x * 2 + (t >> 8); V.nvb = gridDim.x * 2; V.vtid = t & 255; V.lds = lds + (t >> 8) * LDS_HALF; return V; }
DI unsigned pk_bf16(float lo, float hi) { return pg8::cvt_pk_bf16(lo, hi); }
DI unsigned pk_fp8x4(float x0, float x1, float x2, float x3, float sc) {
    x0 = __builtin_amdgcn_fmed3f(x0 * sc, -448.f, 448.f); x1 = __builtin_amdgcn_fmed3f(x1 * sc, -448.f, 448.f); x2 = __builtin_amdgcn_fmed3f(x2 * sc, -448.f, 448.f); x3 = __builtin_amdgcn_fmed3f(x3 * sc, -448.f, 448.f);
    int p = 0; p = __builtin_amdgcn_cvt_pk_fp8_f32(x0, x1, p, false); p = __builtin_amdgcn_cvt_pk_fp8_f32(x2, x3, p, true); return (unsigned)p; }
constexpr float F8_ACT = 16.f, F8_WT = 256.f, F8_O = 64.f;
constexpr int F8_SC_AW = 0x01010101 * (127 - 6), F8_SC_OW = 0x01010101 * (127 - 7);
typedef LAS unsigned char* lptr;
typedef _Float16 f16x2_t __attribute__((ext_vector_type(2)));
DI f16x2_t u2h(unsigned x) { return __builtin_bit_cast(f16x2_t, x); }
#define VB_LOOP(u, n) for (int _it = 0, u = V.vb; _it < ((n) + V.nvb - 1) / V.nvb; ++_it, u += V.nvb)

DI void p_cond(const VB& V, const float* __restrict__ c, const float* __restrict__ c_ctx, float* __restrict__ cond) {
    for (int i = V.vb * 256 + V.vtid; i < 9 * DM; i += V.nvb * 256) { const float v = i < 8 * DM ? c[i] : c_ctx[i - 8 * DM]; cond[i] = v / (1.0f + expf(-v)); }
}
template <bool F8 = false> DI void p_wt(const VB& V, const float* __restrict__ W, bf16_t* __restrict__ Wt, int K, int N, int nperm) {
    lptr tile = (lptr)V.lds;
    const int ntn = N / 64, ntk = K / 64, vt = V.vtid;
    const int lk = vt >> 4, lc = (vt & 15) * 4;
    const int sn = vt >> 2, sk = (vt & 3) * 16;
    VB_LOOP(u, ntn * ntk) {
        const bool act = u < ntn * ntk; const int n0 = (u % ntn) * 64, k0 = (u / ntn) * 64;
        if (act) { const int n = n0 + lc; const int src = n < nperm ? (n & ~127) + head_perm(n & 127) : n;
#pragma unroll
            for (int p = 0; p < 4; ++p) { const f32x4 v = *(const f32x4*)(W + (size_t)(k0 + lk + 16 * p) * N + src); *(LAS f32x4*)(tile + ((lk + 16 * p) * 68 + lc) * 4) = v; } }
        __syncthreads();
        if (act) { float e[16];
#pragma unroll
            for (int j = 0; j < 16; ++j) e[j] = *(const LAS float*)(tile + ((sk + j) * 68 + sn) * 4);
            if constexpr (F8) { u32x4 w; w.x = pk_fp8x4(e[0], e[1], e[2], e[3], F8_WT); w.y = pk_fp8x4(e[4], e[5], e[6], e[7], F8_WT); w.z = pk_fp8x4(e[8], e[9], e[10], e[11], F8_WT); w.w = pk_fp8x4(e[12], e[13], e[14], e[15], F8_WT);
                *(u32x4*)((unsigned char*)Wt + (size_t)(n0 + sn) * K + k0 + sk) = w; }
            else { u32x4 w0, w1; w0.x = pk_bf16(e[0], e[1]); w0.y = pk_bf16(e[2], e[3]); w0.z = pk_bf16(e[4], e[5]); w0.w = pk_bf16(e[6], e[7]);
                w1.x = pk_bf16(e[8], e[9]); w1.y = pk_bf16(e[10], e[11]); w1.z = pk_bf16(e[12], e[13]); w1.w = pk_bf16(e[14], e[15]);
                bf16_t* dst = Wt + (size_t)(n0 + sn) * K + k0 + sk; *(u32x4*)dst = w0; *(u32x4*)(dst + 8) = w1; } }
        __syncthreads();
    }
}
DI void p_rope(const VB& V, float2* __restrict__ rope) {
    for (int i = V.vb * 256 + V.vtid; i < 64 * 32; i += V.nvb * 256) {
        const int pos = i >> 5, f = i & 31; const float inv = powf(10000.0f, -(float)f / 32.0f); const float ang = (float)pos * inv;
        rope[i] = make_float2(cosf(ang), sinf(ang)); }
}
DI void p_hy_h3(const VB& V, const float* __restrict__ w1, const float* __restrict__ b1, const float* __restrict__ w2, const float* __restrict__ b2, float* __restrict__ h3, int L) {
    const int wv = V.vtid >> 6, j = V.vtid & 63;
    float* z = (float*)V.lds + wv * 256; float* ha = z + 64; float* hb = z + 128;
    const int nw = V.nvb * 4, w0 = V.vb * 4 + wv;
    for (int it = 0; it < (L + nw - 1) / nw; ++it) {
        const int t = it * nw + w0; const bool act = t < L;
        if (act) { if (j == 0) z[0] = (float)t / (float)L;
            if (j >= 1 && j <= 16) { const float ang = 2.0f * 3.14159265358979323846f * (float)t * (float)j / (float)L; z[j] = cosf(ang); z[16 + j] = sinf(ang); } }
        __syncthreads();
        float s = 0.f;
        if (act) { s = b1[j];
_Pragma("unroll 3") for (int k = 0; k < 33; ++k) s += z[k] * w1[k * 64 + j]; ha[j] = sinf(s); }
        __syncthreads();
        if (act) { s = b2[j];
_Pragma("unroll 4") for (int k = 0; k < 64; ++k) s += ha[k] * w2[k * 64 + j]; hb[j] = sinf(s); }
        __syncthreads();
        if (act) { s = b2[64 + j];
_Pragma("unroll 4") for (int k = 0; k < 64; ++k) s += hb[k] * w2[64 * 64 + k * 64 + j]; h3[(size_t)t * 64 + j] = sinf(s); }
        __syncthreads();
    }
}
DI const float* row_ptr(const float* h, const float* x, const float* ctx, int r) { return x ? (r < T_LAT ? x + (size_t)r * DM : ctx + (size_t)(r - T_LAT) * DM) : h + (size_t)r * DM; }
template <bool QX, bool F8 = false> DI void p_normmod(const VB& V, const float* __restrict__ h, const float* __restrict__ x0, const float* __restrict__ ctx0, const float* __restrict__ g, const float* __restrict__ adaL, int sh_off, int sc_off, bf16_t* __restrict__ a, int nrows,
                                     unsigned* __restrict__ xd = nullptr, float* __restrict__ xsc = nullptr, const unsigned short* __restrict__ dl = nullptr, const unsigned short* __restrict__ x16 = nullptr) {
    const int lane = V.vtid & 63;
    for (int r = V.vb * 4 + (V.vtid >> 6); r < nrows; r += V.nvb * 4) {
        const int bi = r < T_LAT ? r / SEQ : 8;
        const float* x = row_ptr(h, x0, ctx0, r); const float* sh = adaL + (size_t)bi * NMOD * DM + sh_off; const float* sc = adaL + (size_t)bi * NMOD * DM + sc_off;
        float4 v[8]; float ss = 0.f;
#pragma unroll
        for (int i = 0; i < 8; ++i) v[i] = make_float4(0.f, 0.f, 0.f, 0.f);
        if (x16) {
            u32x2 hw[8];
#pragma unroll
            for (int i = 0; i < 8; ++i) hw[i] = *(const u32x2*)(x16 + (size_t)r * DM + i * 256 + lane * 4);
#pragma unroll
            for (int i = 0; i < 8; ++i) { const f16x2_t h01 = u2h(hw[i].x), h23 = u2h(hw[i].y); v[i] = make_float4((float)h01.x, (float)h01.y, (float)h23.x, (float)h23.y); }
        } else {
#pragma unroll
            for (int i = 0; i < 8; ++i) v[i] = *(const float4*)(x + i * 256 + lane * 4);
        }
        if (dl) {
#pragma unroll
            for (int i = 0; i < 8; ++i) { const u32x2 dw = *(const u32x2*)(dl + (size_t)r * DM + i * 256 + lane * 4); const f16x2_t d01 = u2h(dw.x), d23 = u2h(dw.y);
                v[i].x += (float)d01.x; v[i].y += (float)d01.y; v[i].z += (float)d23.x; v[i].w += (float)d23.y; } }
#pragma unroll
        for (int i = 0; i < 8; ++i) ss += v[i].x * v[i].x + v[i].y * v[i].y + v[i].z * v[i].z + v[i].w * v[i].w;
        ss = wave_sum(ss); const float inv = rsqrtf(ss / (float)DM + 1e-6f);
        float amax = 0.f;
#pragma unroll
        for (int i = 0; i < 8; ++i) { const int c = i * 256 + lane * 4; const float4 gg = *(const float4*)(g + c), s1 = *(const float4*)(sc + c), s0 = *(const float4*)(sh + c);
            v[i].x = v[i].x * inv * gg.x * (1.f + s1.x) + s0.x; v[i].y = v[i].y * inv * gg.y * (1.f + s1.y) + s0.y; v[i].z = v[i].z * inv * gg.z * (1.f + s1.z) + s0.z; v[i].w = v[i].w * inv * gg.w * (1.f + s1.w) + s0.w;
            if constexpr (F8) *(unsigned*)((unsigned char*)a + (size_t)r * DM + c) = pk_fp8x4(v[i].x, v[i].y, v[i].z, v[i].w, F8_ACT);
            else { u32x2 o; o.x = f2bf(v[i].x) | ((unsigned)f2bf(v[i].y) << 16); o.y = f2bf(v[i].z) | ((unsigned)f2bf(v[i].w) << 16);
                *(u32x2*)(a + (size_t)r * DM + c) = o; }
            if constexpr (QX) amax = fmaxf(amax, fmaxf(fmaxf(fabsf(v[i].x), fabsf(v[i].y)), fmaxf(fabsf(v[i].z), fabsf(v[i].w)))); }
        if constexpr (QX) {
            amax = wave_max(amax); const float qs = amax > 0.f ? 119.0f / amax : 0.f;
            if (lane == 0) xsc[r] = amax * (1.0f / 119.0f);
#pragma unroll
            for (int i = 0; i < 8; ++i) { const int q0 = (int)rintf(v[i].x * qs), q1 = (int)rintf(v[i].y * qs), q2 = (int)rintf(v[i].z * qs), q3 = (int)rintf(v[i].w * qs);
                const unsigned hi = (unsigned)(((q0 + 8) >> 4) & 15) | ((unsigned)(((q1 + 8) >> 4) & 15) << 4) | ((unsigned)(((q2 + 8) >> 4) & 15) << 8) | ((unsigned)(((q3 + 8) >> 4) & 15) << 12);
                const unsigned lo = (unsigned)(q0 & 15) | ((unsigned)(q1 & 15) << 4) | ((unsigned)(q2 & 15) << 8) | ((unsigned)(q3 & 15) << 12);
                xd[(size_t)r * 512 + 64 * i + lane] = hi | (lo << 16); }
        }
    }
}
DI void p_final(const VB& V, const unsigned short* __restrict__ h16, const float* __restrict__ g, float* __restrict__ out) {
    const int lane = V.vtid & 63;
    for (int r = V.vb * 4 + (V.vtid >> 6); r < T_LAT; r += V.nvb * 4) {
        u32x2 hw[8]; float4 v[8]; float ss = 0.f;
#pragma unroll
        for (int i = 0; i < 8; ++i) hw[i] = *(const u32x2*)(h16 + (size_t)r * DM + i * 256 + lane * 4);
#pragma unroll
        for (int i = 0; i < 8; ++i) { const f16x2_t h01 = u2h(hw[i].x), h23 = u2h(hw[i].y); v[i] = make_float4((float)h01.x, (float)h01.y, (float)h23.x, (float)h23.y); ss += v[i].x * v[i].x + v[i].y * v[i].y + v[i].z * v[i].z + v[i].w * v[i].w; }
        ss = wave_sum(ss); const float inv = rsqrtf(ss / (float)DM + 1e-6f);
#pragma unroll
        for (int i = 0; i < 8; ++i) { const int c = i * 256 + lane * 4; const float4 gg = *(const float4*)(g + c);
            *(float4*)(out + (size_t)r * DM + c) = make_float4(v[i].x * inv * gg.x, v[i].y * inv * gg.y, v[i].z * inv * gg.z, v[i].w * inv * gg.w); }
    }
}

struct EpiQK {
    static constexpr bool PERM = false, AFTER_DRAIN = false;
    bf16_t* Q; bf16_t* Kb; const float2* rope;
    DI void operator()(const pg8::f32x4 (&acc)[2][2][4][2], const pg8::Unit& u, int wr, int wc, int fr, int fq) const {
        const int f0 = (wc & 1) * 16 + 4 * fq;
#pragma unroll
        for (int ai = 0; ai < 2; ++ai)
#pragma unroll
            for (int m = 0; m < 4; ++m) {
                const int row = u.pm * 256 + ai * 128 + wr * 64 + m * 16 + fr;
                const int t = row & (SEQ - 1); const int pos = (wc >> 1) ? (t & 63) : (t >> 6);
                float4 c01 = make_float4(1.f, 0.f, 1.f, 0.f), c23 = c01;
                if (row < T_LAT) { const float4* rp = (const float4*)(rope + pos * 32 + f0); c01 = rp[0]; c23 = rp[1]; }
#pragma unroll
                for (int bj = 0; bj < 2; ++bj) {
                    const pg8::f32x4 v0 = acc[ai][bj][m][0], v1 = acc[ai][bj][m][1];
                    const float a0 = v0[0] * c01.x - v1[0] * c01.y, b0 = v1[0] * c01.x + v0[0] * c01.y;
                    const float a1 = v0[1] * c01.z - v1[1] * c01.w, b1 = v1[1] * c01.z + v0[1] * c01.w;
                    const float a2 = v0[2] * c23.x - v1[2] * c23.y, b2 = v1[2] * c23.x + v0[2] * c23.y;
                    const float a3 = v0[3] * c23.z - v1[3] * c23.w, b3 = v1[3] * c23.z + v0[3] * c23.w;
                    const int colh = u.pn * 256 + bj * 128, c0 = colh + 32 * wc + 4 * fq;
                    bf16_t* dst = colh < 2048 ? Q + (size_t)row * DM + c0 : Kb + (size_t)row * 512 + (c0 - 2048);
                    u32x2 lo, hi; lo.x = pk_bf16(a0, a1); lo.y = pk_bf16(a2, a3); hi.x = pk_bf16(b0, b1); hi.y = pk_bf16(b2, b3);
                    *(u32x2*)dst = lo; *(u32x2*)(dst + 16) = hi;
                }
                asm volatile("" ::: "memory");
            }
    }
};
struct EpiResid {
    static constexpr bool PERM = false, AFTER_DRAIN = false;
    const float* h; const float* x0; const float* ctx0; float* hout; const float* adaL; int g_off;
    DI void operator()(const pg8::f32x4 (&acc)[2][2][4][2], const pg8::Unit& u, int wr, int wc, int fr, int fq) const {
#pragma unroll
        for (int ai = 0; ai < 2; ++ai)
#pragma unroll
            for (int m = 0; m < 4; ++m) {
                const int row = u.pm * 256 + ai * 128 + wr * 64 + m * 16 + fr; const int bi = row < T_LAT ? row >> 11 : 8;
                const float* base = row_ptr(h, x0, ctx0, row); const float* g = adaL + (size_t)bi * NMOD * DM + g_off; float* op = hout + (size_t)row * DM;
#pragma unroll
                for (int bj = 0; bj < 2; ++bj)
#pragma unroll
                    for (int n = 0; n < 2; ++n) { const int col = u.pn * 256 + bj * 128 + wc * 32 + n * 16 + 4 * fq;
                        const pg8::f32x4 b = *(const pg8::f32x4*)(base + col), gg = *(const pg8::f32x4*)(g + col);
                        *(pg8::f32x4*)(op + col) = b + gg * acc[ai][bj][m][n]; }
                asm volatile("" ::: "memory");
            }
    }
};
DI unsigned pk_f16(float lo, float hi) { return __builtin_bit_cast(unsigned, (f16x2_t){(_Float16)lo, (_Float16)hi}); }
struct EpiDelta {
    static constexpr bool PERM = true, AFTER_DRAIN = false;
    unsigned short* D; const float* adaL; int g_off;
    DI void operator()(const pg8::f32x4 (&acc)[2][2][4][2], const pg8::Unit& u, int wr, int wc, int fr, int fq) const {
        const int row0 = u.pm * 256 + wr * 64 + fr, col0 = u.pn * 256 + wc * 32 + 8 * fq; const int bi = u.pm * 256 < T_LAT ? (u.pm * 256) >> 11 : 8;
        const float* gp = adaL + (size_t)bi * NMOD * DM + g_off + col0;
        pg8::f32x4 g0[2], g1[2];
#pragma unroll
        for (int bj = 0; bj < 2; ++bj) { g0[bj] = *(const pg8::f32x4*)(gp + bj * 128); g1[bj] = *(const pg8::f32x4*)(gp + bj * 128 + 4); }
#pragma unroll
        for (int ai = 0; ai < 2; ++ai)
#pragma unroll
            for (int m = 0; m < 4; ++m) { unsigned short* rowp = D + (size_t)(row0 + ai * 128 + m * 16) * DM + col0;
#pragma unroll
                for (int bj = 0; bj < 2; ++bj) { const pg8::f32x4 v0 = acc[ai][bj][m][0] * g0[bj], v1 = acc[ai][bj][m][1] * g1[bj];
                    u32x4 w; w.x = pk_f16(v0[0], v0[1]); w.y = pk_f16(v0[2], v0[3]); w.z = pk_f16(v1[0], v1[1]); w.w = pk_f16(v1[2], v1[3]);
                    *(u32x4*)(rowp + bj * 128) = w; } }
    }
};
struct EpiResidP {
    static constexpr bool PERM = true, AFTER_DRAIN = false;
    float* H; const float* adaL; int g_off;
    DI void operator()(const pg8::f32x4 (&acc)[2][2][4][2], const pg8::Unit& u, int wr, int wc, int fr, int fq) const {
        const int row0 = u.pm * 256 + wr * 64 + fr, col0 = u.pn * 256 + wc * 32 + 8 * fq; const int bi = u.pm * 256 < T_LAT ? (u.pm * 256) >> 11 : 8;
        const float* gp = adaL + (size_t)bi * NMOD * DM + g_off + col0;
        pg8::f32x4 g0[2], g1[2];
#pragma unroll
        for (int bj = 0; bj < 2; ++bj) { g0[bj] = *(const pg8::f32x4*)(gp + bj * 128); g1[bj] = *(const pg8::f32x4*)(gp + bj * 128 + 4); }
#pragma unroll
        for (int ai = 0; ai < 2; ++ai)
#pragma unroll
            for (int m = 0; m < 4; ++m) { float* rowp = H + (size_t)(row0 + ai * 128 + m * 16) * DM + col0;
#pragma unroll
                for (int bj = 0; bj < 2; ++bj) { const pg8::f32x4 b0 = *(const pg8::f32x4*)(rowp + bj * 128), b1 = *(const pg8::f32x4*)(rowp + bj * 128 + 4);
                    *(pg8::f32x4*)(rowp + bj * 128) = b0 + acc[ai][bj][m][0] * g0[bj]; *(pg8::f32x4*)(rowp + bj * 128 + 4) = b1 + acc[ai][bj][m][1] * g1[bj]; }
                asm volatile("" ::: "memory"); }
    }
};
struct EpiBfP {
    static constexpr bool PERM = true, AFTER_DRAIN = false;
    bf16_t* O; int ldc;
    DI void operator()(const pg8::f32x4 (&acc)[2][2][4][2], const pg8::Unit& u, int wr, int wc, int fr, int fq) const {
        const int row0 = u.pm * 256 + wr * 64 + fr, col0 = u.pn * 256 + wc * 32 + 8 * fq;
#pragma unroll
        for (int ai = 0; ai < 2; ++ai)
#pragma unroll
            for (int m = 0; m < 4; ++m) { bf16_t* rowp = O + (size_t)(row0 + ai * 128 + m * 16) * ldc + col0;
#pragma unroll
                for (int bj = 0; bj < 2; ++bj) { const pg8::f32x4 v0 = acc[ai][bj][m][0], v1 = acc[ai][bj][m][1];
                    u32x4 w; w.x = pk_bf16(v0[0], v0[1]); w.y = pk_bf16(v0[2], v0[3]); w.z = pk_bf16(v1[0], v1[1]); w.w = pk_bf16(v1[2], v1[3]);
                    *(u32x4*)(rowp + bj * 128) = w; } }
    }
};
template <class Epi> DI void p_gemm(unsigned char* lds, const bf16_t* A, const bf16_t* Bt, int M, int N, int K, int c, const Epi& E) {
    pg8::Gemm g{A, Bt, M, N, K, 0}; pg8::StaticOrder S; S.init(M, N, (int)gridDim.x, c);
    pg8::gemm_phase<Epi, pg8::StaticOrder, false>((PG8_LAS unsigned char*)lds, g, S, E, nullptr);
}
template <class Epi> DI void p_gemm8(unsigned char* lds, const void* A, const void* Bt, int M, int N, int K, int c, const Epi& E, int sc) {
    pg8::Gemm g{(const bf16_t*)A, (const bf16_t*)Bt, M, N, K / 2, sc}; pg8::StaticOrder S; S.init(M, N, (int)gridDim.x, c);
    pg8::gemm_phase<Epi, pg8::StaticOrder, false, true>((PG8_LAS unsigned char*)lds, g, S, E, nullptr);
}

DI float gelu_erf(float s) { return 0.5f * s * (1.0f + erff(s * 0.70710678118654752f)); }
DI void p_ada2(unsigned char* lds_, const float* __restrict__ cond, const float* __restrict__ ada_w, const float* __restrict__ ada_b, float* __restrict__ ada) {
    lptr lds = (lptr)lds_; LAS float* cs = (LAS float*)lds; LAS float* part = (LAS float*)(lds + 9 * DM * 4);
    const int tid = tid_opaque(), w = tid >> 6, lane = tid & 63, kq = lane >> 4, cq = lane & 15;
    for (int e = tid; e < 9 * DM; e += 512) cs[e] = cond[e];
    __syncthreads();
    constexpr int NUN = 4 * NMOD * DM / 64;
    for (int u = blockIdx.x; u < NUN; u += gridDim.x) {
        const int i = u / (NMOD * DM / 64), n0 = (u % (NMOD * DM / 64)) * 64;
        const float* wp = ada_w + ((size_t)i * DM + w * 256 + kq) * (NMOD * DM) + n0 + cq * 4;
        float acc[9][4];
#pragma unroll
        for (int b = 0; b < 9; ++b) { acc[b][0] = 0.f; acc[b][1] = 0.f; acc[b][2] = 0.f; acc[b][3] = 0.f; }
        for (int kk = 0; kk < 64; kk += 8) {
            float4 wv[8];
#pragma unroll
            for (int j = 0; j < 8; ++j) wv[j] = *(const float4*)(wp + (size_t)(kk + j) * 4 * (NMOD * DM));
#pragma unroll
            for (int j = 0; j < 8; ++j) { const int k = w * 256 + (kk + j) * 4 + kq;
#pragma unroll
                for (int b = 0; b < 9; ++b) { const float c = cs[b * DM + k]; acc[b][0] += c * wv[j].x; acc[b][1] += c * wv[j].y; acc[b][2] += c * wv[j].z; acc[b][3] += c * wv[j].w; } }
        }
#pragma unroll
        for (int b = 0; b < 9; ++b)
#pragma unroll
            for (int q = 0; q < 4; ++q) { float v = acc[b][q]; v += __shfl_xor(v, 16); v += __shfl_xor(v, 32); acc[b][q] = v; }
        if (kq == 0) {
#pragma unroll
            for (int b = 0; b < 9; ++b) *(LAS f32x4*)(part + (w * 9 + b) * 64 + cq * 4) = (f32x4){acc[b][0], acc[b][1], acc[b][2], acc[b][3]};
        }
        __syncthreads();
        for (int e = tid; e < 9 * 64; e += 512) { const int b = e >> 6, c = e & 63; float sum = ada_b[i * NMOD * DM + n0 + c];
#pragma unroll
            for (int ww = 0; ww < 8; ++ww) sum += part[(ww * 9 + b) * 64 + c];
            ada[((size_t)i * 9 + b) * NMOD * DM + n0 + c] = sum; }
        __syncthreads();
    }
}
typedef float f32x16 __attribute__((ext_vector_type(16)));
template <int L> DI void p_hy_filt3(const float* __restrict__ h3, const float* __restrict__ w3, const float* __restrict__ decay, const float* __restrict__ fbias, bf16_t* __restrict__ G) {
    const int tid = tid_opaque(), lane = tid & 63, n = lane & 31, hh = lane >> 5;
    constexpr int NTT = L / 32, TPW = NTT >= 8 ? 8 : NTT, NPART = NTT / TPW, NWU = 256 * NPART;
    const float invL = 1.0f / (float)L;
    for (int wu = blockIdx.x * 8 + (tid >> 6); wu < NWU; wu += gridDim.x * 8) {
        const int part = wu >> 8, combo = wu & 255, dtile = combo & 63, od = combo >> 6, o = od >> 1, dir = od & 1;
        const int d = 32 * dtile + n, col = o * 2 * DM + dir * DM + d;
        bf16x8 bfr[4];
#pragma unroll
        for (int s = 0; s < 4; ++s) { float wv[8];
#pragma unroll
            for (int i = 0; i < 8; ++i) wv[i] = w3[(size_t)(16 * s + 8 * hh + i) * 4 * DM + col];
            u32x4 bv; bv.x = pk_bf16(wv[0], wv[1]); bv.y = pk_bf16(wv[2], wv[3]); bv.z = pk_bf16(wv[4], wv[5]); bv.w = pk_bf16(wv[6], wv[7]); bfr[s] = __builtin_bit_cast(bf16x8, bv); }
        const float dec = fabsf(decay[o * DM + d]) * invL, fb = fbias[o * DM + d];
        bf16_t* gp = G + ((size_t)o * DM + d) * (2 * L);
        if (dir == 0 && part == NPART - 1 && hh == 0) gp[0] = 0;
#pragma unroll 2
        for (int tt = 0; tt < TPW; ++tt) {
            const int t0 = 32 * (part * TPW + tt);
            f32x16 acc;
#pragma unroll
            for (int r = 0; r < 16; ++r) acc[r] = 0.f;
#pragma unroll
            for (int s = 0; s < 4; ++s) { const float* ap = h3 + (size_t)(t0 + n) * 64 + 16 * s + 8 * hh; const f32x4 a0 = *(const f32x4*)ap, a1 = *(const f32x4*)(ap + 4);
                u32x4 av; av.x = pk_bf16(a0[0], a0[1]); av.y = pk_bf16(a0[2], a0[3]); av.z = pk_bf16(a1[0], a1[1]); av.w = pk_bf16(a1[2], a1[3]);
                acc = __builtin_amdgcn_mfma_f32_32x32x16_bf16(__builtin_bit_cast(bf16x8, av), bfr[s], acc, 0, 0, 0); }
#pragma unroll
            for (int q = 0; q < 4; ++q) { const int tq = t0 + 8 * q + 4 * hh; float v[4];
#pragma unroll
                for (int i = 0; i < 4; ++i) { v[i] = acc[4 * q + i] * (__expf(-(float)(tq + i) * dec) + 0.05f); if (dir == 0 && tq + i == 0) v[i] += fb; }
                if (dir == 0) {
#pragma unroll
                    for (int i = 0; i < 4; ++i) gp[L - tq - i] = f2bf(v[i]);
                } else if (tq == 0) {
#pragma unroll
                    for (int i = 1; i < 4; ++i) gp[L + i] = f2bf(v[i]);
                } else { u32x2 w; w.x = pk_bf16(v[0], v[1]); w.y = pk_bf16(v[2], v[3]); *(u32x2*)(gp + L + tq) = w; }
            }
        }
    }
}

constexpr int HY_CS = 8224;
constexpr int HY_ZPAD = 512;
constexpr int HY_ZS = 3080;
constexpr int HY_XS = 2056;
constexpr int HY_F_OFF = 0, HY_Z_OFF = 4 * HY_CS, HY_X_OFF = HY_Z_OFF + 8 * HY_ZS * 2, HY_END = HY_X_OFF + 8 * HY_XS * 2;
static_assert(HY_END <= 2 * LDS_HALF, "hyena LDS");
template <int L> struct HyFilt { u32x4 lo[(2 * L / 8 + 2 + 511) / 512], hi[(2 * L / 8 + 2 + 511) / 512]; };
template <int L> DI void hy_issue_filter(HyFilt<L>& R, const bf16_t* __restrict__ g, int tid) {
#pragma unroll
    for (int it = 0; it < (2 * L / 8 + 2 + 511) / 512; ++it) { const int idx = tid + 512 * it, z0 = (idx - 1) * 8;
        R.lo[it] = (u32x4){0u, 0u, 0u, 0u}; R.hi[it] = (u32x4){0u, 0u, 0u, 0u};
        if (idx < 2 * L / 8 + 2) { if (z0 >= 0 && z0 < 2 * L) R.lo[it] = *(const u32x4*)(g + z0); if (z0 + 8 >= 0 && z0 + 8 < 2 * L) R.hi[it] = *(const u32x4*)(g + z0 + 8); } }
}
template <int L> DI void hy_commit_filter(const HyFilt<L>& R, lptr F, int tid) {
#pragma unroll
    for (int it = 0; it < (2 * L / 8 + 2 + 511) / 512; ++it) { const int idx = tid + 512 * it, z0 = (idx - 1) * 8;
        if (idx < 2 * L / 8 + 2) {
            const u32x4 lo = R.lo[it], hi = R.hi[it]; u32x4 c1, c2, c3;
            c1.x = __builtin_amdgcn_alignbit(lo.y, lo.x, 16); c1.y = __builtin_amdgcn_alignbit(lo.z, lo.y, 16); c1.z = __builtin_amdgcn_alignbit(lo.w, lo.z, 16); c1.w = __builtin_amdgcn_alignbit(hi.x, lo.w, 16);
            c2.x = lo.y; c2.y = lo.z; c2.z = lo.w; c2.w = hi.x;
            c3.x = __builtin_amdgcn_alignbit(lo.z, lo.y, 16); c3.y = __builtin_amdgcn_alignbit(lo.w, lo.z, 16); c3.z = __builtin_amdgcn_alignbit(hi.x, lo.w, 16); c3.w = __builtin_amdgcn_alignbit(hi.y, hi.x, 16);
            const int off = (z0 + 8) * 2;
            *(LAS u32x4*)(F + off) = lo; *(LAS u32x4*)(F + HY_CS + off) = c1; *(LAS u32x4*)(F + 2 * HY_CS + off) = c2; *(LAS u32x4*)(F + 3 * HY_CS + off) = c3; } }
}
template <int L> struct HyPart { u32x4 raw[(L + 511) / 512]; unsigned short pv[(L + 511) / 512], nx[(L + 511) / 512]; };
template <int L> DI void hy_issue_part(HyPart<L>& R, const bf16_t* __restrict__ urow, int tid) {
#pragma unroll
    for (int it = 0; it < (L + 511) / 512; ++it) { const int e8 = tid + 512 * it, e = e8 * 8, t0 = e % L;
        R.raw[it] = (u32x4){0u, 0u, 0u, 0u}; R.pv[it] = 0; R.nx[it] = 0;
        if (e8 < L) { R.raw[it] = *(const u32x4*)(urow + e); if (t0 > 0) R.pv[it] = urow[e - 1]; if (t0 + 8 < L) R.nx[it] = urow[e + 8]; } }
}
template <int L> DI void hy_commit_part(const HyPart<L>& R, float w0, float w1, float w2, float bb, lptr dst, int dstride, int doff, int tid) {
#pragma unroll
    for (int it = 0; it < (L + 511) / 512; ++it) { const int e8 = tid + 512 * it, e = e8 * 8, b = e / L, t0 = e % L;
        if (e8 < L) {
            const u32x4 raw = R.raw[it]; float x[10];
            x[0] = bf2f(R.pv[it]); x[9] = bf2f(R.nx[it]);
            x[1] = __uint_as_float(raw.x << 16); x[2] = __uint_as_float(raw.x & 0xffff0000u); x[3] = __uint_as_float(raw.y << 16); x[4] = __uint_as_float(raw.y & 0xffff0000u);
            x[5] = __uint_as_float(raw.z << 16); x[6] = __uint_as_float(raw.z & 0xffff0000u); x[7] = __uint_as_float(raw.w << 16); x[8] = __uint_as_float(raw.w & 0xffff0000u);
            float o[8];
#pragma unroll
            for (int j = 0; j < 8; ++j) o[j] = bb + w0 * x[j] + w1 * x[j + 1] + w2 * x[j + 2];
            u32x4 w; w.x = pk_bf16(o[0], o[1]); w.y = pk_bf16(o[2], o[3]); w.z = pk_bf16(o[4], o[5]); w.w = pk_bf16(o[6], o[7]);
            *(LAS u32x4*)(dst + (size_t)(b * dstride + doff + t0) * 2) = w; } }
}
template <int L, int NT, int NSTEP> DI void hy_conv_loop(f32x16 (&acc)[NT], lptr F, lptr Z, int T0w, int lane) {
    static_assert(NSTEP % 2 == 0 && NSTEP >= 4, "step count");
    const int i = lane & 31, h = lane >> 5, r = (4 - (i & 3)) & 3, col = lane & 31, b = col >> 2, di = col & 3;
    const int lb_lo = T0w - (L - 16);
    lptr ap = F + r * HY_CS + (L - lb_lo + 8 * h - i - r + 8) * 2;
    lptr bp = Z + (b * HY_ZS + HY_ZPAD + T0w + 32 * di - lb_lo + 8 * h) * 2;
    u32x2 a0[2], a1[2]; bf16x8 bq[2][NT];
#define HY_LOADF(s_) do { a0[s_] = *(const volatile LAS u32x2*)ap; a1[s_] = *(const volatile LAS u32x2*)(ap + 8); _Pragma("unroll") for (int m = 0; m < NT; ++m) bq[s_][m] = *(const LAS bf16x8*)(bp + m * 256); ap -= 32; bp -= 32; } while (0)
#define HY_MMA(s_, MASK) do { u32x4 av; av.x = a0[s_].x; av.y = a0[s_].y; av.z = a1[s_].x; av.w = a1[s_].y; const bf16x8 af = __builtin_bit_cast(bf16x8, av); \
        _Pragma("unroll") for (int m = 0; m < NT; ++m) if (((MASK) >> m) & 1) acc[m] = __builtin_amdgcn_mfma_f32_32x32x16_bf16(af, bq[s_][m], acc[m], 0, 0, 0); } while (0)
#define HY_REGION(N_, MASK) do { _Pragma("unroll 1") for (int st = 0; st < (N_); st += 2) { HY_LOADF(1); __builtin_amdgcn_sched_barrier(0); HY_MMA(0, MASK); __builtin_amdgcn_sched_barrier(0); \
        HY_LOADF(0); __builtin_amdgcn_sched_barrier(0); HY_MMA(1, MASK); __builtin_amdgcn_sched_barrier(0); } } while (0)
    HY_LOADF(0);
    if constexpr (NT == 4) {
        constexpr int FULL = NSTEP - 8 * 3 - 8 * 3;
        HY_REGION(8, 0x1); HY_REGION(8, 0x3); HY_REGION(8, 0x7); HY_REGION(FULL, 0xF); HY_REGION(8, 0xE); HY_REGION(8, 0xC); HY_REGION(6, 0x8);
        HY_LOADF(1); __builtin_amdgcn_sched_barrier(0); HY_MMA(0, 0x8); HY_MMA(1, 0x8);
    } else {
        HY_REGION(NSTEP - 2, (1 << NT) - 1);
        HY_LOADF(1); __builtin_amdgcn_sched_barrier(0); HY_MMA(0, (1 << NT) - 1); HY_MMA(1, (1 << NT) - 1);
    }
#undef HY_LOADF
#undef HY_MMA
#undef HY_REGION
}
template <int L> DI void p_hyena_unit(unsigned char* lds_, const bf16_t* __restrict__ Ut, const float* __restrict__ cw, const float* __restrict__ cb, const bf16_t* __restrict__ G, bf16_t* __restrict__ Yt, int d, int tok0) {
    constexpr int NT = L >= 2048 ? 4 : 1;
    constexpr int NSTEP = (L - 16 + 96 + 128 * (NT - 1)) / 16 + 1;
    lptr lds = (lptr)lds_; lptr F = lds + HY_F_OFF; lptr Z = lds + HY_Z_OFF; lptr X = lds + HY_X_OFF;
    const int tid = tid_opaque(), wave = tid >> 6, lane = tid & 63;
    const int T0w = wave * NT * 128; const bool active = T0w < L;
    const int col = lane & 31, hh = lane >> 5, b = col >> 2, di = col & 3;
    const bf16_t* u0 = Ut + (size_t)d * T_ALL + tok0; const bf16_t* u1 = Ut + (size_t)(DM + d) * T_ALL + tok0; const bf16_t* u2 = Ut + (size_t)(2 * DM + d) * T_ALL + tok0;
    {
        HyFilt<L> f0; HyPart<L> pv, px1;
        hy_issue_filter<L>(f0, G + (size_t)d * (2 * L), tid); hy_issue_part<L>(pv, u0, tid); hy_issue_part<L>(px1, u1, tid);
        hy_commit_filter<L>(f0, F, tid);
        hy_commit_part<L>(pv, cw[d], cw[3 * DM + d], cw[6 * DM + d], cb[d], Z, HY_ZS, HY_ZPAD, tid);
        hy_commit_part<L>(px1, cw[DM + d], cw[4 * DM + d], cw[7 * DM + d], cb[DM + d], X, HY_XS, 0, tid);
    }
    if (L < 2048) { for (int e = tid; e < 8 * 32; e += 512) *(LAS u32x4*)(Z + ((e >> 5) * HY_ZS + HY_ZPAD + L + (e & 31) * 8) * 2) = (u32x4){0u, 0u, 0u, 0u}; }
    HyFilt<L> f1; HyPart<L> px2;
    hy_issue_filter<L>(f1, G + ((size_t)DM + d) * (2 * L), tid); hy_issue_part<L>(px2, u2, tid);
    __syncthreads();
    f32x16 acc[NT];
#pragma unroll
    for (int m = 0; m < NT; ++m)
#pragma unroll
        for (int q = 0; q < 16; ++q) acc[m][q] = 0.f;
    if (active) hy_conv_loop<L, NT, NSTEP>(acc, F, Z, T0w, lane);
    __syncthreads();
    if (active) {
#pragma unroll
        for (int m = 0; m < NT; ++m)
#pragma unroll
            for (int g = 0; g < 4; ++g) { const int t4 = T0w + 128 * m + 32 * di + 8 * g + 4 * hh;
                const u32x2 xv = *(const LAS u32x2*)(X + (b * HY_XS + t4) * 2);
                const float z0 = __uint_as_float(xv.x << 16) * acc[m][4 * g + 0], z1 = __uint_as_float(xv.x & 0xffff0000u) * acc[m][4 * g + 1];
                const float z2 = __uint_as_float(xv.y << 16) * acc[m][4 * g + 2], z3 = __uint_as_float(xv.y & 0xffff0000u) * acc[m][4 * g + 3];
                u32x2 zw; zw.x = pk_bf16(z0, z1); zw.y = pk_bf16(z2, z3);
                *(LAS u32x2*)(Z + (b * HY_ZS + HY_ZPAD + t4) * 2) = zw; }
    }
    hy_commit_filter<L>(f1, F, tid);
    __syncthreads();
    hy_commit_part<L>(px2, cw[2 * DM + d], cw[5 * DM + d], cw[8 * DM + d], cb[2 * DM + d], X, HY_XS, 0, tid);
    __syncthreads();
#pragma unroll
    for (int m = 0; m < NT; ++m)
#pragma unroll
        for (int q = 0; q < 16; ++q) acc[m][q] = 0.f;
    if (active) hy_conv_loop<L, NT, NSTEP>(acc, F, Z, T0w, lane);
    if (active) {
#pragma unroll
        for (int m = 0; m < NT; ++m)
#pragma unroll
            for (int g = 0; g < 4; ++g) { const int t4 = T0w + 128 * m + 32 * di + 8 * g + 4 * hh;
                lptr xp = X + (b * HY_XS + t4) * 2; const u32x2 xv = *(const LAS u32x2*)xp;
                const float y0 = __uint_as_float(xv.x << 16) * acc[m][4 * g + 0], y1 = __uint_as_float(xv.x & 0xffff0000u) * acc[m][4 * g + 1];
                const float y2 = __uint_as_float(xv.y << 16) * acc[m][4 * g + 2], y3 = __uint_as_float(xv.y & 0xffff0000u) * acc[m][4 * g + 3];
                u32x2 yw; yw.x = pk_bf16(y0, y1); yw.y = pk_bf16(y2, y3);
                *(LAS u32x2*)xp = yw; }
    }
    __syncthreads();
    for (int e8 = tid; e8 < L; e8 += 512) { const int e = e8 * 8, bb = e / L, t0 = e % L; *(u32x4*)(Yt + (size_t)d * T_ALL + tok0 + e) = *(const LAS u32x4*)(X + (bb * HY_XS + t0) * 2); }
    __syncthreads();
}
template <bool WITH_CTX> DI void p_hyena(unsigned char* lds, const bf16_t* __restrict__ Ut, const float* __restrict__ cw, const float* __restrict__ cb, const bf16_t* __restrict__ G, const bf16_t* __restrict__ Gc, bf16_t* __restrict__ Yt) {
    for (int e = tid_opaque(); e < 8 * HY_ZS / 8; e += 512) *(LAS u32x4*)((lptr)lds + HY_Z_OFF + e * 16) = (u32x4){0u, 0u, 0u, 0u};
    __syncthreads();
    for (int d = blockIdx.x; d < DM; d += gridDim.x) {
        p_hyena_unit<SEQ>(lds, Ut, cw, cb, G, Yt, d, 0);
        if constexpr (WITH_CTX) p_hyena_unit<CTX>(lds, Ut, cw, cb, Gc, Yt, d, T_LAT);
    }
}
DI void p_transpose_yt(unsigned char* lds_, const bf16_t* __restrict__ Yt, bf16_t* __restrict__ Y, int nrows) {
    const int t = tid_opaque(), half = t >> 8, tt = t & 255; lptr tile = (lptr)lds_ + half * (64 * 66 * 2);
    const int ntok = nrows / 64, nun = ntok * (DM / 64), nvb = gridDim.x * 2;
    for (int it = 0, u = blockIdx.x * 2 + half; it < (nun + nvb - 1) / nvb; ++it, u += nvb) {
        const bool act = u < nun; const int tk0 = (u % ntok) * 64, d0 = (u / ntok) * 64;
        if (act) { for (int k = tt; k < 64 * 8; k += 256) { const int dr = k >> 3, c8 = (k & 7) * 8; const u32x4 v = *(const u32x4*)(Yt + (size_t)(d0 + dr) * T_ALL + tk0 + c8);
                LAS unsigned* p = (LAS unsigned*)(tile + (dr * 66 + c8) * 2); p[0] = v.x; p[1] = v.y; p[2] = v.z; p[3] = v.w; } }
        __syncthreads();
        if (act) { for (int k = tt; k < 64 * 8; k += 256) { const int tr = k >> 3, d8 = (k & 7) * 8; unsigned short e[8];
#pragma unroll
                for (int j = 0; j < 8; ++j) e[j] = *(const LAS unsigned short*)(tile + ((d8 + j) * 66 + tr) * 2);
                u32x4 w; w.x = e[0] | ((unsigned)e[1] << 16); w.y = e[2] | ((unsigned)e[3] << 16); w.z = e[4] | ((unsigned)e[5] << 16); w.w = e[6] | ((unsigned)e[7] << 16);
                *(u32x4*)(Y + (size_t)(tk0 + tr) * DM + d0 + d8) = w; } }
        __syncthreads();
    }
}


constexpr int AT_KS = 288, AT_VS = 272;
constexpr int AT_K_OFF = 0, AT_V_OFF = 128 * AT_KS, AT_END = AT_V_OFF + 128 * AT_VS;
static_assert(AT_END <= 2 * LDS_HALF, "attention LDS");
DI void at_prefetch(u32x4 (&kr)[4], u32x4 (&vr)[4], const bf16_t* __restrict__ Kb, const bf16_t* __restrict__ Vt, int kvh, int krow0, int tid) {
#pragma unroll
    for (int i = 0; i < 4; ++i) { const int c = tid + 512 * i, row = c >> 4, part = c & 15;
        kr[i] = *(const u32x4*)(Kb + (size_t)(krow0 + row) * 512 + kvh * 128 + part * 8);
        vr[i] = *(const u32x4*)(Vt + (size_t)(kvh * 128 + row) * T_ALL + krow0 + part * 8); }
}
DI void at_commit(const u32x4 (&kr)[4], const u32x4 (&vr)[4], lptr lds, int tid) {
#pragma unroll
    for (int i = 0; i < 4; ++i) { const int c = tid + 512 * i, row = c >> 4, part = c & 15;
        *(LAS u32x4*)(lds + AT_K_OFF + row * AT_KS + part * 16) = kr[i];
        *(LAS u32x4*)(lds + AT_V_OFF + row * AT_VS + part * 16) = vr[i]; }
}
DI void p_attn(unsigned char* lds_, const bf16_t* __restrict__ Q, const bf16_t* __restrict__ Kb, const bf16_t* __restrict__ Vt, const float* __restrict__ sink, bf16_t* __restrict__ O, bool with_ctxq) {
    lptr lds = (lptr)lds_;
    const int tid = tid_opaque(), wave = tid >> 6, lane = tid & 63, fr = lane & 15, g = lane >> 4;
    const int nlat = NB * 16 * NQH, nun = nlat + (with_ctxq ? NB * NQH * 2 : 0);
    const float c2 = 0.08838834764831845f * 1.4426950408889634f;
    for (int u = blockIdx.x; u < nun; u += gridDim.x) {
        int b, j, hq, qrow0, nwin, jlo;
        if (u < nlat) { hq = u & 15; j = (u >> 4) & 15; b = u >> 8; qrow0 = b * SEQ + j * 128; jlo = j > 0 ? j - 1 : 0; nwin = (j < 15 ? j + 1 : 15) - jlo + 1; }
        else { const int v = u - nlat; hq = v & 15; const int cb = (v >> 4) & 1; b = v >> 5; j = 0; jlo = 0; nwin = 0; qrow0 = T_LAT + b * CTX + cb * 128; }
        const int nblk = nwin + 2, kvh = hq >> 2;
#define AT_KROW(kb) ((kb) < nwin ? b * SEQ + (jlo + (kb)) * 128 : T_LAT + b * CTX + ((kb) - nwin) * 128)
        const int qw = 16 * wave;
        bf16x8 qf[4];
#pragma unroll
        for (int ks = 0; ks < 4; ++ks) qf[ks] = *(const bf16x8*)(Q + (size_t)(qrow0 + qw + fr) * DM + hq * 128 + 32 * ks + 8 * g);
        const float sk2 = sink[hq] * 1.4426950408889634f;
        float mrun = sk2, lrun = g == 0 ? 1.f : 0.f;
        f32x4 oacc[8];
#pragma unroll
        for (int dt = 0; dt < 8; ++dt) oacc[dt] = (f32x4){0.f, 0.f, 0.f, 0.f};
        u32x4 kr[4], vr[4];
        at_prefetch(kr, vr, Kb, Vt, kvh, AT_KROW(0), tid);
#pragma unroll 1
        for (int kb = 0; kb < nblk; ++kb) {
            const int mask = kb < nwin ? (jlo + kb < j ? 1 : (jlo + kb > j ? 2 : 0)) : 0; const int krow_next = AT_KROW(kb + 1);
            __syncthreads();
            at_commit(kr, vr, lds, tid);
            __syncthreads();
            if (kb + 1 < nblk) at_prefetch(kr, vr, Kb, Vt, kvh, krow_next, tid);
            f32x4 sacc[8];
#pragma unroll
            for (int kt = 0; kt < 8; ++kt) { sacc[kt] = (f32x4){0.f, 0.f, 0.f, 0.f};
#pragma unroll
                for (int ks = 0; ks < 4; ++ks) { const bf16x8 kf = *(const LAS bf16x8*)(lds + AT_K_OFF + (16 * kt + fr) * AT_KS + (32 * ks + 8 * g) * 2);
                    sacc[kt] = __builtin_amdgcn_mfma_f32_16x16x32_bf16(kf, qf[ks], sacc[kt], 0, 0, 0); } }
            bf16x8 pf[4];
            {
                const int a = qw + fr; float mx = mrun;
                const int klo = (mask == 1 ? a : 0) - 4 * g, kspan = (mask == 1 ? 127 - a : (mask == 2 ? a : 127));
                if (mask != 0) {
#pragma unroll
                    for (int kt = 0; kt < 8; ++kt)
#pragma unroll
                        for (int r = 0; r < 4; ++r) { float v = sacc[kt][r] * c2;
                            const bool dead = (unsigned)(16 * kt + r - klo) > (unsigned)kspan; v = dead ? -__builtin_inff() : v; sacc[kt][r] = v; mx = fmaxf(mx, v); }
                } else {
#pragma unroll
                    for (int kt = 0; kt < 8; ++kt)
#pragma unroll
                        for (int r = 0; r < 4; ++r) { const float v = sacc[kt][r] * c2; sacc[kt][r] = v; mx = fmaxf(mx, v); }
                }
                mx = fmaxf(mx, __shfl_xor(mx, 16)); mx = fmaxf(mx, __shfl_xor(mx, 32));
                const float alpha = __builtin_amdgcn_exp2f(mrun - mx); mrun = mx; float ls = 0.f;
#pragma unroll
                for (int kt = 0; kt < 8; ++kt)
#pragma unroll
                    for (int r = 0; r < 4; ++r) { const float p = __builtin_amdgcn_exp2f(sacc[kt][r] - mx); sacc[kt][r] = p; ls += p; }
                lrun = lrun * alpha + ls;
#pragma unroll
                for (int dt = 0; dt < 8; ++dt) oacc[dt] *= alpha;
#pragma unroll
                for (int p4 = 0; p4 < 4; ++p4) { u32x4 w; w.x = pk_bf16(sacc[2 * p4][0], sacc[2 * p4][1]); w.y = pk_bf16(sacc[2 * p4][2], sacc[2 * p4][3]);
                    w.z = pk_bf16(sacc[2 * p4 + 1][0], sacc[2 * p4 + 1][1]); w.w = pk_bf16(sacc[2 * p4 + 1][2], sacc[2 * p4 + 1][3]); pf[p4] = __builtin_bit_cast(bf16x8, w); }
            }
            u32x2 vlo[2][4], vhi[2][4];
#define AT_LOADV(s_, dt_) do { _Pragma("unroll") for (int p4 = 0; p4 < 4; ++p4) { lptr vp = lds + AT_V_OFF + (16 * (dt_) + fr) * AT_VS + (32 * p4 + 4 * g) * 2; vlo[s_][p4] = *(const volatile LAS u32x2*)vp; vhi[s_][p4] = *(const volatile LAS u32x2*)(vp + 32); } } while (0)
            AT_LOADV(0, 0);
#pragma unroll
            for (int dt = 0; dt < 8; ++dt) {
                if (dt + 1 < 8) { if (dt & 1) AT_LOADV(0, dt + 1); else AT_LOADV(1, dt + 1); }
                __builtin_amdgcn_sched_barrier(0);
#pragma unroll
                for (int p4 = 0; p4 < 4; ++p4) { u32x4 vv; vv.x = vlo[dt & 1][p4].x; vv.y = vlo[dt & 1][p4].y; vv.z = vhi[dt & 1][p4].x; vv.w = vhi[dt & 1][p4].y; const bf16x8 vf = __builtin_bit_cast(bf16x8, vv);
                    oacc[dt] = __builtin_amdgcn_mfma_f32_16x16x32_bf16(vf, pf[p4], oacc[dt], 0, 0, 0); }
                __builtin_amdgcn_sched_barrier(0);
            }
#undef AT_LOADV
        }
        {   float l = lrun; l += __shfl_xor(l, 16); l += __shfl_xor(l, 32); const float inv = 1.0f / l;
            unsigned char* op = (unsigned char*)O + (size_t)(qrow0 + qw + fr) * DM + hq * 128 + 4 * g;
#pragma unroll
            for (int dt = 0; dt < 8; ++dt) *(unsigned*)(op + 16 * dt) = pk_fp8x4(oacc[dt][0] * inv, oacc[dt][1] * inv, oacc[dt][2] * inv, oacc[dt][3] * inv, F8_O); }
    }
    __syncthreads();
}


constexpr int TK_KS = 288;
constexpr int TK_K_OFF = 0, TK_W_OFF = 2 * 128 * TK_KS, TK_END = TK_W_OFF + 8 * 768;
static_assert(TK_END <= 2 * LDS_HALF, "topk LDS");
DI unsigned ord_key(float v) { const unsigned b = __float_as_uint(v); return b ^ ((unsigned)((int)b >> 31) | 0x80000000u); }
DI float ord_val(unsigned k) { return __uint_as_float((k & 0x80000000u) ? (k ^ 0x80000000u) : ~k); }
template <int CTRL> DI unsigned dpp_u(unsigned x) { return (unsigned)__builtin_amdgcn_update_dpp(0, (int)x, CTRL, 0xF, 0xF, true); }
DI unsigned umax(unsigned a, unsigned b) { return a > b ? a : b; }
DI unsigned rowmax16(unsigned x) { x = umax(x, dpp_u<0xB1>(x)); x = umax(x, dpp_u<0x4E>(x)); x = umax(x, dpp_u<0x141>(x)); x = umax(x, dpp_u<0x140>(x)); return x; }
DI float rowsum16(float x) { x += __uint_as_float(dpp_u<0xB1>(__float_as_uint(x))); x += __uint_as_float(dpp_u<0x4E>(__float_as_uint(x))); x += __uint_as_float(dpp_u<0x141>(__float_as_uint(x))); x += __uint_as_float(dpp_u<0x140>(__float_as_uint(x))); return x; }
DI unsigned umin(unsigned a, unsigned b) { return a < b ? a : b; }
#define TK_CE(i, j) do { const unsigned _a = umax(key[i], key[j]), _b = umin(key[i], key[j]); key[i] = _a; key[j] = _b; } while (0)
DI unsigned row_top16(unsigned (&key)[8], int fr) {
    TK_CE(0, 1); TK_CE(2, 3); TK_CE(4, 5); TK_CE(6, 7);
    TK_CE(0, 2); TK_CE(1, 3); TK_CE(4, 6); TK_CE(5, 7);
    TK_CE(1, 2); TK_CE(5, 6);
    TK_CE(0, 4); TK_CE(1, 5); TK_CE(2, 6); TK_CE(3, 7);
    TK_CE(2, 4); TK_CE(3, 5);
    TK_CE(1, 2); TK_CE(3, 4); TK_CE(5, 6);
    unsigned sel = 0u;
#pragma unroll 4
    for (int t = 0; t < 16; ++t) {
        const unsigned m = rowmax16(key[0]); sel = (fr == t) ? m : sel;
        const bool own = key[0] == m;
        key[0] = own ? key[1] : key[0]; key[1] = own ? key[2] : key[1]; key[2] = own ? key[3] : key[2]; key[3] = own ? key[4] : key[3];
        key[4] = own ? key[5] : key[4]; key[5] = own ? key[6] : key[5]; key[6] = own ? key[7] : key[6]; key[7] = own ? 0u : key[7];
    }
    return sel;
}
#undef TK_CE
DI void p_peer_topk(unsigned char* lds_, const bf16_t* __restrict__ qb, const float* __restrict__ keys1, const float* __restrict__ keys2, int* __restrict__ idx, float* __restrict__ gate, int nrows) {
    lptr lds = (lptr)lds_;
    const int tid = tid_opaque(), wave = tid >> 6, lane = tid & 63, fr = lane & 15, g = lane >> 4;
    const int ntile = nrows / 16, nchunk = 32, tpc = (ntile + nchunk - 1) / nchunk;
    LAS float* wl = (LAS float*)(lds + TK_W_OFF + wave * 768 + g * 192);
    for (int u = blockIdx.x; u < 8 * nchunk; u += gridDim.x) {
        const int h = u & 7, chunk = u >> 3;
        __syncthreads();
        for (int e = tid; e < 2 * 128 * 16; e += 512) {
            const int half = e >> 11, key = (e >> 4) & 127, part = e & 15; const float* src = (half ? keys2 : keys1) + ((size_t)h * 128 + key) * 128 + part * 8;
            const float4 a = *(const float4*)src, b2 = *(const float4*)(src + 4);
            u32x4 w; w.x = pk_bf16(a.x, a.y); w.y = pk_bf16(a.z, a.w); w.z = pk_bf16(b2.x, b2.y); w.w = pk_bf16(b2.z, b2.w);
            *(LAS u32x4*)(lds + TK_K_OFF + (half * 128 + key) * TK_KS + part * 16) = w; }
        __syncthreads();
        for (int tl = chunk * tpc + wave; tl < (chunk + 1) * tpc && tl < ntile; tl += 8) {
            const int tok0 = tl * 16;
            unsigned W1[4], W2[4];
#pragma unroll
            for (int half = 0; half < 2; ++half) {
                bf16x8 qf[4];
#pragma unroll
                for (int ks = 0; ks < 4; ++ks) qf[ks] = *(const bf16x8*)(qb + (size_t)(tok0 + fr) * DM + h * 256 + half * 128 + 32 * ks + 8 * g);
                f32x4 sc[8];
#pragma unroll
                for (int nt = 0; nt < 8; ++nt) { sc[nt] = (f32x4){0.f, 0.f, 0.f, 0.f};
#pragma unroll
                    for (int ks = 0; ks < 4; ++ks) { const bf16x8 kf = *(const LAS bf16x8*)(lds + TK_K_OFF + (half * 128 + 16 * nt + fr) * TK_KS + (32 * ks + 8 * g) * 2);
                        sc[nt] = __builtin_amdgcn_mfma_f32_16x16x32_bf16(qf[ks], kf, sc[nt], 0, 0, 0); } }
#pragma unroll
                for (int r = 0; r < 4; ++r) { unsigned key[8];
#pragma unroll
                    for (int nt = 0; nt < 8; ++nt) key[nt] = (ord_key(sc[nt][r]) & ~127u) | (unsigned)(127 - (fr + 16 * nt));
                    const unsigned w = row_top16(key, fr); if (half == 0) W1[r] = w; else W2[r] = w; }
            }
#pragma unroll
            for (int r = 0; r < 4; ++r) {
                const float v1 = ord_val(W1[r] & ~127u), v2 = ord_val(W2[r] & ~127u);
                wl[fr] = v2; ((LAS int*)wl)[16 + fr] = 127 - (int)(W1[r] & 127u); ((LAS int*)wl)[32 + fr] = 127 - (int)(W2[r] & 127u);
                int j = 0; float v2c = wl[0]; unsigned sel = 0u;
#pragma unroll 4
                for (int t = 0; t < 16; ++t) {
                    const float cand = v1 + v2c;
                    const unsigned key = j < 16 ? ((ord_key(cand) & ~255u) | (unsigned)(255 - (fr * 16 + j))) : 0u;
                    const unsigned m = rowmax16(key); sel = (fr == t) ? m : sel;
                    j += (key == m) ? 1 : 0; v2c = wl[j < 16 ? j : 15];
                }
                const float sm = ord_val(sel & ~255u); const int flat = 255 - (int)(sel & 255u);
                const int e1 = ((LAS int*)wl)[16 + (flat >> 4)], e2 = ((LAS int*)wl)[32 + (flat & 15)];
                const float mx = ord_val(rowmax16(sel) & ~255u); const float p = __expf(sm - mx); const float tot = rowsum16(p);
                const size_t o = (size_t)(tok0 + 4 * g + r) * 128 + h * 16 + fr;
                idx[o] = e1 * 128 + e2; gate[o] = p / tot;
            }
        }
    }
    __syncthreads();
}


typedef float f32x2_t __attribute__((ext_vector_type(2)));
constexpr int CVT_CHUNK = 16;
constexpr int CVT_Q_WORD = 24576;
DI void p_cvt_pull(unsigned* __restrict__ qw, int max_chunks, int drain_to, const float* __restrict__ su_all, const float* __restrict__ sv_all, unsigned char* __restrict__ du_all, unsigned char* __restrict__ dv_all, float* __restrict__ sc_all) {
    const int tid = tid_opaque(), lane = tid & 63;
    constexpr int CPL = 2 * NEXP / CVT_CHUNK;
    for (int n = 0; max_chunks < 0 || n < max_chunks; ++n) {
        if (max_chunks < 0) { if ((int)__builtin_amdgcn_readfirstlane((int)__hip_atomic_load(qw, __ATOMIC_RELAXED, __HIP_MEMORY_SCOPE_AGENT)) >= drain_to) break; }
        int g0 = 0; if (lane == 0) g0 = (int)__hip_atomic_fetch_add(qw, 1u, __ATOMIC_RELAXED, __HIP_MEMORY_SCOPE_AGENT);
        g0 = __builtin_amdgcn_readfirstlane(g0);
        if (g0 >= 4 * CPL) break;
        const int L = g0 / CPL, c0 = g0 % CPL;
        const float* su = su_all + (size_t)L * NEXP * DM; const float* sv = sv_all + (size_t)L * NEXP * DM;
        unsigned char* du = du_all + (size_t)L * (NEXP * DM / 2); unsigned char* dv = dv_all + (size_t)L * (NEXP * DM / 2); float* sc = sc_all + (size_t)L * 2 * NEXP;
#pragma unroll 2
        for (int rr = 0; rr < CVT_CHUNK; ++rr) {
            const int row = c0 * CVT_CHUNK + rr;
            const bool second = row >= NEXP; const int e = second ? row - NEXP : row; const float* src = (second ? sv : su) + (size_t)e * DM + lane * 4;
            float4 v[8]; float amax = 0.f;
#pragma unroll
            for (int i = 0; i < 8; ++i) { v[i] = *(const float4*)(src + i * 256); amax = fmaxf(amax, fmaxf(fmaxf(fabsf(v[i].x), fabsf(v[i].y)), fmaxf(fabsf(v[i].z), fabsf(v[i].w)))); }
            amax = wave_max(amax);
            const float scale = amax > 0.f ? (second ? 8.0f : 10.0f) / amax : 1.0f, inv = amax > 0.f ? amax * (second ? 0.125f : 0.1f) : 1.0f;
            unsigned char* dst = (second ? dv : du) + (size_t)e * 128 + (second ? 16 * (lane & 7) + 2 * (lane >> 3) : lane * 2);
            if (second) {
#pragma unroll
                for (int i = 0; i < 8; ++i) { unsigned p = 0u; p = __builtin_amdgcn_cvt_scalef32_pk_fp4_f32(p, v[i].x * scale, v[i].y * scale, 1.0f, 0); p = __builtin_amdgcn_cvt_scalef32_pk_fp4_f32(p, v[i].z * scale, v[i].w * scale, 1.0f, 1);
                    *(unsigned short*)(dst + (size_t)i * (NEXP * 128)) = (unsigned short)p; }
            } else {
#pragma unroll
                for (int i = 0; i < 8; ++i) { const int q0 = max(-7, min(7, (int)rintf(v[i].x * scale))), q1 = max(-7, min(7, (int)rintf(v[i].y * scale))), q2 = max(-7, min(7, (int)rintf(v[i].z * scale))), q3 = max(-7, min(7, (int)rintf(v[i].w * scale)));
                    *(unsigned short*)(dst + (size_t)i * (NEXP * 128)) = (unsigned short)((unsigned)(q0 & 15) | ((unsigned)(q1 & 15) << 4) | ((unsigned)(q2 & 15) << 8) | ((unsigned)(q3 & 15) << 12)); }
            }
            if (lane == 0) sc[row] = inv;
        }
    }
}
DI int gemm_units_of(int M, int N, int G, int c) { const int nwg = (M / 256) * (N / 256); return c < nwg ? (nwg - c + G - 1) / G : 0; }
constexpr int PG_GRP = 16;
constexpr int PG_NSL = 8;
#define P4_LOAD4(buf, tab, idq, k0) do { _Pragma("unroll") for (int _kk = 0; _kk < 4; ++_kk) { const unsigned _id = idq[((k0) + _kk) >> 2][((k0) + _kk) & 3]; \
        buf[_kk] = *(const u32x4*)((tab) + (_id * 128u + toff)); } asm volatile("" ::: "memory"); } while (0)
#define P4_LOAD8(buf, tab, idq, k0) do { _Pragma("unroll") for (int _kk = 0; _kk < 8; ++_kk) { const unsigned _id = idq[((k0) + _kk) >> 2][((k0) + _kk) & 3]; \
        buf[_kk] = *(const u32x4*)((tab) + (_id * 128u + toff)); } asm volatile("" ::: "memory"); } while (0)
typedef _Float16 h2v_t __attribute__((ext_vector_type(2)));
DI int rowsum8i(int x) { x += (int)dpp_u<0xB1>((unsigned)x); x += (int)dpp_u<0x4E>((unsigned)x); x += (int)dpp_u<0x141>((unsigned)x); return x; }
DI void peer_u_wave(int t0, int xs, const unsigned* __restrict__ xd, const float* __restrict__ xsc, const int* __restrict__ idx, const unsigned char* __restrict__ pu4, float* __restrict__ part, int lane) {
    const int sub = lane & 7, eg = lane >> 3; const unsigned toff = (unsigned)xs * (NEXP * 128) + 16 * sub; const int xoff = 8 * (8 * xs + sub);
    u32x4 idA[4], idB[4], xwA[2], xwB[2];
    const float sxl = xsc[t0 + (lane & (PG_GRP - 1))];
    u32x4 bA0[8], bA1[8], bB0[8], bB1[8];
    {   u32x4 id0[4];
#pragma unroll
        for (int q = 0; q < 4; ++q) { id0[q] = *(const u32x4*)(idx + (size_t)t0 * 128 + 16 * eg + 4 * q); idA[q] = *(const u32x4*)(idx + (size_t)(t0 + 1) * 128 + 16 * eg + 4 * q); }
        xwA[0] = *(const u32x4*)(xd + (size_t)t0 * 512 + xoff); xwA[1] = *(const u32x4*)(xd + (size_t)t0 * 512 + xoff + 4);
        P4_LOAD8(bA0, pu4, id0, 0); P4_LOAD8(bA1, pu4, id0, 8); }
#define P4_DOT8(buf, k0) do { _Pragma("unroll") for (int _kk = 0; _kk < 8; ++_kk) { int ah, al; \
          \
        { const int r0_ = (int)buf[_kk][0], x0_ = (int)xh8[0]; asm("v_dot8_i32_i4 %0, %1, %2, 0" : "=v"(ah) : "v"(r0_), "v"(x0_)); } \
        _Pragma("unroll") for (int d = 1; d < 4; ++d) ah = __builtin_amdgcn_sdot8((int)buf[_kk][d], (int)xh8[d], ah, false); \
        al = ah << 4; \
        _Pragma("unroll") for (int d = 0; d < 4; ++d) al = __builtin_amdgcn_sdot8((int)buf[_kk][d], (int)xl8[d], al, false); \
        const int sd = rowsum8i(al); const int _k = (k0) + _kk; \
        if ((_k & 1) == 0) d0 = (sub == (_k >> 1)) ? sd : d0; else d1 = (sub == (_k >> 1)) ? sd : d1; } } while (0)
    typedef _Float16 h2_t __attribute__((ext_vector_type(2)));
#define P4_USTEP(C0, C1, N0, N1, IDC, IDN, XWC, XWN, tt_) do { const int t = t0 + (tt_), tn1 = (tt_) < PG_GRP - 1 ? t + 1 : t, tn2 = (tt_) < PG_GRP - 2 ? t + 2 : t; \
        _Pragma("unroll") for (int q = 0; q < 4; ++q) IDN[q] = *(const u32x4*)(idx + (size_t)tn2 * 128 + 16 * eg + 4 * q); \
        XWN[0] = *(const u32x4*)(xd + (size_t)tn1 * 512 + xoff); XWN[1] = *(const u32x4*)(xd + (size_t)tn1 * 512 + xoff + 4); \
        asm volatile("" ::: "memory"); \
        P4_LOAD8(N0, pu4, IDC, 0); P4_LOAD8(N1, pu4, IDC, 8); \
        __builtin_amdgcn_sched_barrier(0); \
        unsigned xh8[4], xl8[4]; \
        _Pragma("unroll") for (int d = 0; d < 4; ++d) { const unsigned w0 = XWC[d >> 1][2 * (d & 1)], w1 = XWC[d >> 1][2 * (d & 1) + 1]; \
            xh8[d] = __builtin_amdgcn_perm(w1, w0, 0x05040100u); xl8[d] = __builtin_amdgcn_perm(w1, w0, 0x07060302u); } \
        int d0 = 0, d1 = 0; P4_DOT8(C0, 0); P4_DOT8(C1, 8); \
        const float sx = __builtin_bit_cast(float, __builtin_amdgcn_readlane(__builtin_bit_cast(int, sxl), (tt_))); \
        *(h2_t*)(part + ((size_t)xs * T_ALL + t) * 64 + 8 * eg + sub) = (h2_t){(_Float16)((float)d0 * sx), (_Float16)((float)d1 * sx)}; \
        __builtin_amdgcn_sched_barrier(0); } while (0)
#pragma unroll 1
    for (int tt = 0; tt < PG_GRP; tt += 2) { P4_USTEP(bA0, bA1, bB0, bB1, idA, idB, xwA, xwB, tt); P4_USTEP(bB0, bB1, bA0, bA1, idB, idA, xwB, xwA, tt + 1); }
}
DI void p_peer_combine(const int* __restrict__ idx, const float* __restrict__ gate, unsigned* __restrict__ wh, const float* __restrict__ part, const float* __restrict__ sc, int nrows) {
    typedef _Float16 h2_t __attribute__((ext_vector_type(2)));
    const int tid = tid_opaque(), lane = tid & 63; const int nw = gridDim.x * 8;
    for (int t = blockIdx.x * 8 + (tid >> 6); t < nrows; t += nw) {
        const int2 id2 = *(const int2*)(idx + (size_t)t * 128 + 2 * lane); float dA = 0.f, dB = 0.f;
#pragma unroll
        for (int s2 = 0; s2 < PG_NSL; ++s2) { const h2_t p = *(const h2_t*)(part + ((size_t)s2 * T_ALL + t) * 64 + lane); dA += (float)p.x; dB += (float)p.y; }
        float2 g = *(const float2*)(gate + (size_t)t * 128 + 2 * lane);
        g.x = g.x * gelu_erf(dA * sc[id2.x]) * sc[NEXP + id2.x]; g.y = g.y * gelu_erf(dB * sc[id2.y]) * sc[NEXP + id2.y];
        const h2_t w = (h2_t){(_Float16)g.x, (_Float16)g.y}; wh[(size_t)t * 64 + lane] = __builtin_bit_cast(unsigned, w);
    }
}
template <bool DLT, bool W16, bool H32> DI void peer_v_wave(int t0, int xs, const int* __restrict__ idx, const unsigned* __restrict__ wh, const unsigned char* __restrict__ pv4, const float* __restrict__ adaL, int g_off, const float* hin, const unsigned short* __restrict__ dl, float* hio, unsigned short* h16, int lane) {
    const int sub = lane & 7, eg = lane >> 3, ccol = 256 * xs + 4 * lane; const unsigned toff = (unsigned)xs * (NEXP * 128) + 16 * sub;
    typedef _Float16 h2_t __attribute__((ext_vector_type(2)));
    auto H2U = [](h2_t x) { return __builtin_bit_cast(unsigned, x); }; auto U2H = [](unsigned x) { return __builtin_bit_cast(h2_t, x); };
    u32x4 idA[4], idB[4], whA[2], whB[2], hA, hB; u32x2 dA, dB;
    const int bi = t0 < T_LAT ? t0 >> 11 : 8;
    const f32x4 gg = *(const f32x4*)(adaL + (size_t)bi * NMOD * DM + g_off + ccol);
    u32x4 bA0[8], bA1[8], bB0[8], bB1[8];
    {   u32x4 id0[4];
#pragma unroll
        for (int q = 0; q < 4; ++q) { id0[q] = *(const u32x4*)(idx + (size_t)t0 * 128 + 16 * eg + 4 * q); idA[q] = *(const u32x4*)(idx + (size_t)(t0 + 1) * 128 + 16 * eg + 4 * q); }
        whA[0] = *(const u32x4*)(wh + (size_t)t0 * 64 + 8 * eg); whA[1] = *(const u32x4*)(wh + (size_t)t0 * 64 + 8 * eg + 4); hA = (u32x4){0u, 0u, 0u, 0u}; hB = hA; if constexpr (H32) hA = *(const u32x4*)(hin + (size_t)t0 * DM + ccol); else { const u32x2 hw_ = *(const u32x2*)(h16 + (size_t)t0 * DM + ccol); hA.x = hw_.x; hA.y = hw_.y; } dA = (u32x2){0u, 0u}; dB = dA; if constexpr (DLT) dA = *(const u32x2*)(dl + (size_t)t0 * DM + ccol);
        P4_LOAD8(bA0, pv4, id0, 0); P4_LOAD8(bA1, pv4, id0, 8); }
#define P4_ACC8(buf, WHC, k0) do { _Pragma("unroll") for (int _kk = 0; _kk < 8; ++_kk) { const h2_t wp = U2H(WHC[((k0) + _kk) >> 3][(((k0) + _kk) >> 1) & 3]); const _Float16 w1 = (((k0) + _kk) & 1) ? wp.y : wp.x; const h2_t w2 = (h2_t){w1, w1}; \
        _Pragma("unroll") for (int d = 0; d < 4; ++d) { acc[4 * d] += w2 * __builtin_amdgcn_cvt_scalef32_pk_f16_fp4(buf[_kk][d], 1.0f, 0); acc[4 * d + 1] += w2 * __builtin_amdgcn_cvt_scalef32_pk_f16_fp4(buf[_kk][d], 1.0f, 1); \
            acc[4 * d + 2] += w2 * __builtin_amdgcn_cvt_scalef32_pk_f16_fp4(buf[_kk][d], 1.0f, 2); acc[4 * d + 3] += w2 * __builtin_amdgcn_cvt_scalef32_pk_f16_fp4(buf[_kk][d], 1.0f, 3); } } } while (0)
#define P4_VSTEP(C0, C1, N0, N1, IDC, IDN, WHC, WHN, HC, HN, DC, DN, tt_) do { const int t = t0 + (tt_), tn1 = (tt_) < PG_GRP - 1 ? t + 1 : t, tn2 = (tt_) < PG_GRP - 2 ? t + 2 : t; \
        _Pragma("unroll") for (int q = 0; q < 4; ++q) IDN[q] = *(const u32x4*)(idx + (size_t)tn2 * 128 + 16 * eg + 4 * q); \
        WHN[0] = *(const u32x4*)(wh + (size_t)tn1 * 64 + 8 * eg); WHN[1] = *(const u32x4*)(wh + (size_t)tn1 * 64 + 8 * eg + 4); if constexpr (H32) HN = *(const u32x4*)(hin + (size_t)tn1 * DM + ccol); else { const u32x2 hw_ = *(const u32x2*)(h16 + (size_t)tn1 * DM + ccol); HN.x = hw_.x; HN.y = hw_.y; } if constexpr (DLT) DN = *(const u32x2*)(dl + (size_t)tn1 * DM + ccol); \
        asm volatile("" ::: "memory"); \
        P4_LOAD8(N0, pv4, IDC, 0); P4_LOAD8(N1, pv4, IDC, 8); \
        __builtin_amdgcn_sched_barrier(0); \
        h2_t acc[16]; \
        _Pragma("unroll") for (int i = 0; i < 16; ++i) acc[i] = (h2_t){(_Float16)0.f, (_Float16)0.f}; \
        P4_ACC8(C0, WHC, 0); P4_ACC8(C1, WHC, 8); \
        h2_t s1[8], s2[4], s3[2]; \
        _Pragma("unroll") for (int i = 0; i < 8; ++i) { const auto r = __builtin_amdgcn_permlane32_swap(H2U(acc[i]), H2U(acc[i + 8]), false, false); s1[i] = U2H(r[0]) + U2H(r[1]); } \
        _Pragma("unroll") for (int i = 0; i < 4; ++i) { const auto r = __builtin_amdgcn_permlane16_swap(H2U(s1[i]), H2U(s1[i + 4]), false, false); s2[i] = U2H(r[0]) + U2H(r[1]); } \
        _Pragma("unroll") for (int i = 0; i < 2; ++i) { const bool up = (lane & 8) != 0; const unsigned keep = up ? H2U(s2[i + 2]) : H2U(s2[i]), send = up ? H2U(s2[i]) : H2U(s2[i + 2]); \
            s3[i] = U2H(keep) + U2H(dpp_u<0x128>(send)); } \
        const h2_t dd0 = U2H(DC.x), dd1 = U2H(DC.y); f32x4 o; if constexpr (H32) o = __builtin_bit_cast(f32x4, HC); else { const h2_t b0 = U2H(HC.x), b1 = U2H(HC.y); o = (f32x4){(float)b0.x, (float)b0.y, (float)b1.x, (float)b1.y}; } o[0] += (float)dd0.x + gg[0] * (float)s3[0].x; o[1] += (float)dd0.y + gg[1] * (float)s3[0].y; o[2] += (float)dd1.x + gg[2] * (float)s3[1].x; o[3] += (float)dd1.y + gg[3] * (float)s3[1].y; \
        if constexpr (W16) { u32x2 ow; ow.x = pk_f16(o[0], o[1]); ow.y = pk_f16(o[2], o[3]); *(u32x2*)(h16 + (size_t)t * DM + ccol) = ow; } else *(f32x4*)(hio + (size_t)t * DM + ccol) = o; \
        __builtin_amdgcn_sched_barrier(0); } while (0)
#pragma unroll 1
    for (int tt = 0; tt < PG_GRP; tt += 2) { P4_VSTEP(bA0, bA1, bB0, bB1, idA, idB, whA, whB, hA, hB, dA, dB, tt); P4_VSTEP(bB0, bB1, bA0, bA1, idB, idA, whB, whA, hB, hA, dB, dA, tt + 1); }
}
template <bool VPHASE, bool DLT = false, bool W16 = false, bool H32 = true> DI void p_peer_sliced(unsigned* __restrict__ qctr, int nrows, const unsigned* __restrict__ xd, const float* __restrict__ xsc, const int* __restrict__ idx, const unsigned* __restrict__ wh, float* __restrict__ part,
                                            const unsigned char* __restrict__ tab4, const float* __restrict__ adaL, int g_off, float* __restrict__ hio, const float* __restrict__ xin = nullptr, const float* __restrict__ cin = nullptr, const unsigned short* __restrict__ dl = nullptr, unsigned short* h16 = nullptr) {
    const int lane = tid_opaque() & 63;
    const int x0 = (int)(xb_xcc_id() & 7u);
    int j = 0, xs = x0;
    int nxt = 0; if (lane == 0) nxt = (int)__hip_atomic_fetch_add(qctr + 64 * xs, (unsigned)PG_GRP, __ATOMIC_RELAXED, __HIP_MEMORY_SCOPE_AGENT);
    while (j < PG_NSL) {
        const int t0 = __builtin_amdgcn_readfirstlane(nxt);
        if (t0 >= nrows) { ++j; if (j >= PG_NSL) break; xs = (x0 + j) & 7;
            nxt = 0; if (lane == 0) nxt = (int)__hip_atomic_fetch_add(qctr + 64 * xs, (unsigned)PG_GRP, __ATOMIC_RELAXED, __HIP_MEMORY_SCOPE_AGENT);
            continue; }
        const int xcur = xs;
        nxt = 0; if (lane == 0) nxt = (int)__hip_atomic_fetch_add(qctr + 64 * xs, (unsigned)PG_GRP, __ATOMIC_RELAXED, __HIP_MEMORY_SCOPE_AGENT);
        if constexpr (VPHASE) { const float* hin = xin ? (t0 < T_LAT ? xin : cin - (size_t)T_LAT * DM) : hio;
            peer_v_wave<DLT, W16, H32>(t0, xcur, idx, wh, tab4, adaL, g_off, hin, dl, hio, h16, lane); }
        else peer_u_wave(t0, xcur, xd, xsc, idx, tab4, part, lane);
    }
}

struct Params {
    const float* in[28]; float* out; unsigned char* ws;
};

struct Ctx {
    const Params* P;
    DI unsigned char* ws() const { size_t z = 0; asm volatile("" : "+s"(z)); return P->ws + z; }
    DI float* ada() const { return (float*)(ws() + W.ada); }
    DI float2* rope() const { return (float2*)(ws() + W.rope); }
    DI float* h() const { return (float*)(ws() + W.h); }
    DI bf16_t* a() const { return (bf16_t*)(ws() + W.a); }
    DI bf16_t* q() const { return (bf16_t*)(ws() + W.q); }
    DI bf16_t* kb() const { return (bf16_t*)(ws() + W.k); }
    DI bf16_t* vt() const { return (bf16_t*)(ws() + W.vt); }
    DI bf16_t* o() const { return (bf16_t*)(ws() + W.o); }
    DI bf16_t* ut() const { return (bf16_t*)(ws() + W.ut); }
    DI int* idx() const { return (int*)(ws() + W.idx); }
    DI float* gate() const { return (float*)(ws() + W.gate); }
    DI bf16_t* wqkv() const { return (bf16_t*)(ws() + W.wqkv); }
    DI bf16_t* wo() const { return (bf16_t*)(ws() + W.wo); }
    DI bf16_t* win() const { return (bf16_t*)(ws() + W.win); }
    DI bf16_t* wout() const { return (bf16_t*)(ws() + W.wout); }
    DI bf16_t* wq() const { return (bf16_t*)(ws() + W.wq); }
    DI bf16_t* filt() const { return (bf16_t*)(ws() + W.filt); }
    DI bf16_t* filtc() const { return (bf16_t*)(ws() + W.filtc); }
    DI unsigned char* pu(int L = 0) const { return ws() + W.pu + (size_t)L * (NEXP * DM / 2); }
    DI unsigned char* pv(int L = 0) const { return ws() + W.pv + (size_t)L * (NEXP * DM / 2); }
    DI bf16_t* yt() const { return (bf16_t*)(ws() + W.yt); }
    DI unsigned short* h16() const { return (unsigned short*)(ws() + W.h16); }
    DI unsigned short* dl() const { return (unsigned short*)(ws() + W.dl); }
    DI float* psc(int L = 0) const { return (float*)(ws() + W.psc) + (size_t)L * 2 * NEXP; }
    DI float* part() const { return (float*)(ws() + W.part); }
    DI unsigned* xd() const { return (unsigned*)(ws() + W.xd); }
    DI float* xsc() const { return (float*)(ws() + W.xsc); }
    DI unsigned* wh() const { return (unsigned*)(ws() + W.wh); }
    DI unsigned* qctr() const { return (unsigned*)(ws() + W.bar) + PQ_OFF_WORDS; }
    DI const float* x() const { return P->in[0]; }
    DI const float* ctx() const { return P->in[2]; }
    DI const float* norm_mix_g() const { return P->in[6]; }
    DI const float* norm_ffn_g() const { return P->in[7]; }
    DI const float* attn_sink() const { return P->in[11]; }
    DI const float* hy_conv_w() const { return P->in[13]; }
    DI const float* hy_conv_b() const { return P->in[14]; }
    DI const float* peer_keys1() const { return P->in[24]; }
    DI const float* peer_keys2() const { return P->in[25]; }
    DI const float* peer_u() const { return P->in[26]; }
    DI const float* peer_v() const { return P->in[27]; }
};
template <int I> DI void run_layer(const XcdBarrier& bar, const Ctx& C, unsigned char* lds) {
    constexpr bool is_attn = (I % 2) == 0, ctx_upd = I < 2; constexpr int j = I / 2;
    constexpr bool H16 = DELTA_LAYERS == 3;
    constexpr bool DLT = DELTA_LAYERS == 3 || (DELTA_LAYERS == 1 && is_attn) || (DELTA_LAYERS == 2 && !is_attn);
    const float* adaL = C.ada() + (size_t)I * 9 * NMOD * DM;
    constexpr int rows_a = I <= 2 ? T_ALL : T_LAT;
    constexpr int rows_u = ctx_upd ? T_ALL : T_LAT;
    const float* x0 = I == 0 ? C.x() : nullptr; const float* ctx0 = I == 0 ? C.ctx() : nullptr;
    const int Gn = (int)gridDim.x, cb_ = (int)blockIdx.x;
#define CVT_PULL(n) p_cvt_pull((unsigned*)(C.ws() + W.bar) + CVT_Q_WORD, (n), (I + 1) * (2 * NEXP / CVT_CHUNK), C.peer_u(), C.peer_v(), C.pu(), C.pv(), C.psc())
#define CVT_TAIL(mine, most) do { if ((mine) < (most)) CVT_PULL((most) - (mine)); } while (0)
    p_normmod<false, is_attn>(make_vb(lds), C.h(), x0, ctx0, C.norm_mix_g() + I * DM, adaL, 0, DM, C.a(), rows_a, nullptr, nullptr, nullptr, H16 && I > 0 ? C.h16() : nullptr);
    xcd_barrier(bar);
    if constexpr (is_attn) {
        const unsigned char* wj = (const unsigned char*)C.wqkv() + (size_t)j * QKVW * DM; const int G = (int)gridDim.x;
        p_gemm8(lds, C.a(), wj, T_ALL, 2560, DM, (int)blockIdx.x, EpiQK{C.q(), C.kb(), C.rope()}, F8_SC_AW);
        p_gemm8(lds, wj + (size_t)2560 * DM, C.a(), 512, T_ALL, DM, (int)((blockIdx.x + G - (720 % G)) % G), EpiBfP{C.vt(), T_ALL}, F8_SC_AW);
        {   const int cv = (cb_ + Gn - (720 % Gn)) % Gn; const int mine = gemm_units_of(T_ALL, 2560, Gn, cb_) + gemm_units_of(512, T_ALL, Gn, cv), most = (864 + Gn - 1) / Gn; CVT_TAIL(mine, most); }
        xcd_barrier(bar);
        p_attn(lds, C.q(), C.kb(), C.vt(), C.attn_sink() + j * NQH, C.o(), ctx_upd);
        if (PROBE_DUP == 3) p_attn(lds, C.q(), C.kb(), C.vt(), C.attn_sink() + j * NQH, C.o(), ctx_upd);
        xcd_barrier(bar);
        if constexpr (DLT) p_gemm8(lds, C.o(), (const unsigned char*)C.wo() + (size_t)j * DM * DM, rows_u, DM, DM, (int)blockIdx.x, EpiDelta{C.dl(), adaL, 2 * DM}, F8_SC_OW);
        else p_gemm8(lds, C.o(), (const unsigned char*)C.wo() + (size_t)j * DM * DM, rows_u, DM, DM, (int)blockIdx.x, EpiResid{C.h(), x0, ctx0, C.h(), adaL, 2 * DM}, F8_SC_OW);
        CVT_TAIL(gemm_units_of(rows_u, DM, Gn, cb_), ((rows_u / 256) * (DM / 256) + Gn - 1) / Gn);
    } else {
        p_gemm(lds, C.win() + (size_t)j * 3 * DM * DM, C.a(), 3 * DM, rows_u, DM, (int)blockIdx.x, EpiBfP{C.ut(), T_ALL});
        CVT_TAIL(gemm_units_of(3 * DM, rows_u, Gn, cb_), ((3 * DM / 256) * (rows_u / 256) + Gn - 1) / Gn);
        xcd_barrier(bar);
        p_hyena<ctx_upd>(lds, C.ut(), C.hy_conv_w() + (size_t)j * 9 * DM, C.hy_conv_b() + (size_t)j * 3 * DM, C.filt() + (size_t)j * 2 * DM * 4096, C.filtc(), C.yt());
        if (PROBE_DUP == 3) p_hyena<ctx_upd>(lds, C.ut(), C.hy_conv_w() + (size_t)j * 9 * DM, C.hy_conv_b() + (size_t)j * 3 * DM, C.filt() + (size_t)j * 2 * DM * 4096, C.filtc(), C.yt());
        xcd_barrier(bar);
        p_transpose_yt(lds, C.yt(), C.o(), rows_u);
        xcd_barrier(bar);
        if constexpr (DLT) p_gemm(lds, C.o(), C.wout() + (size_t)j * DM * DM, rows_u, DM, DM, (int)blockIdx.x, EpiDelta{C.dl(), adaL, 2 * DM});
        else p_gemm(lds, C.o(), C.wout() + (size_t)j * DM * DM, rows_u, DM, DM, (int)blockIdx.x, EpiResidP{C.h(), adaL, 2 * DM});
        CVT_TAIL(gemm_units_of(rows_u, DM, Gn, cb_), ((rows_u / 256) * (DM / 256) + Gn - 1) / Gn);
    }
    xcd_barrier(bar);
    p_normmod<true, true>(make_vb(lds), C.h(), DLT ? x0 : nullptr, DLT ? ctx0 : nullptr, C.norm_ffn_g() + I * DM, adaL, 3 * DM, 4 * DM, C.a(), rows_u, C.xd(), C.xsc(), DLT ? C.dl() : nullptr, H16 && I > 0 ? C.h16() : nullptr);
    xcd_barrier(bar);
    p_gemm8(lds, C.a(), (const unsigned char*)C.wq() + (size_t)I * DM * DM, rows_u, DM, DM, (int)blockIdx.x, EpiBfP{C.q(), DM}, F8_SC_AW);
    CVT_TAIL(gemm_units_of(rows_u, DM, Gn, cb_), ((rows_u / 256) * (DM / 256) + Gn - 1) / Gn);
    xcd_barrier(bar);
    p_peer_topk(lds, C.q(), C.peer_keys1() + (size_t)I * 8 * 128 * 128, C.peer_keys2() + (size_t)I * 8 * 128 * 128, C.idx(), C.gate(), rows_u);
    if (PROBE_DUP == 3) p_peer_topk(lds, C.q(), C.peer_keys1() + (size_t)I * 8 * 128 * 128, C.peer_keys2() + (size_t)I * 8 * 128 * 128, C.idx(), C.gate(), rows_u);
    CVT_PULL(-1);
    xcd_barrier(bar);
    p_peer_sliced<false>(C.qctr() + 64 * PG_NSL * (2 * I), rows_u, C.xd(), C.xsc(), C.idx(), C.wh(), C.part(), (const unsigned char*)C.pu(I), adaL, 5 * DM, C.h());
    xcd_barrier(bar);
    p_peer_combine(C.idx(), C.gate(), C.wh(), C.part(), C.psc(I), rows_u);
    xcd_barrier(bar);
    p_peer_sliced<true, DLT, H16, (!H16 || I == 0)>(C.qctr() + 64 * PG_NSL * (2 * I + 1), rows_u, C.xd(), C.xsc(), C.idx(), C.wh(), C.part(), (const unsigned char*)C.pv(I), adaL, 5 * DM, C.h(), DLT ? x0 : nullptr, DLT ? ctx0 : nullptr, C.dl(), C.h16());
    xcd_barrier(bar);
#undef CVT_PULL
#undef CVT_TAIL
}

__global__ void __launch_bounds__(512, 2) mega_fwd(Params P) {
    extern __shared__ __attribute__((aligned(16))) unsigned char lds[];
    volatile LAS unsigned* xbw = (volatile LAS unsigned*)(LAS unsigned char*)(lds + 2 * LDS_HALF);
    if (threadIdx.x < 4) xbw[threadIdx.x] = 0u;
    __syncthreads();
    unsigned char* ws = P.ws;
    XcdBarrier bar = xcd_barrier_post((unsigned*)(ws + W.bar), xbw);

    const float* c = P.in[1]; const float* c_ctx = P.in[3];
    const float* ada_w = P.in[4]; const float* ada_b = P.in[5];
    const float* final_g = P.in[8]; const float* attn_w_qkv = P.in[9]; const float* attn_w_o = P.in[10];
    const float* hy_w_in = P.in[12]; const float* hy_f_w1 = P.in[15];
    const float* hy_f_b1 = P.in[16]; const float* hy_f_w2 = P.in[17]; const float* hy_f_b2 = P.in[18]; const float* hy_f_w3 = P.in[19];
    const float* hy_decay = P.in[20]; const float* hy_fbias = P.in[21]; const float* hy_w_out = P.in[22]; const float* peer_w_q = P.in[23];
    float* cond = (float*)(ws + W.cond); float* h3 = (float*)(ws + W.h3);
    Ctx C; C.P = &P;

    p_cond(make_vb(lds), c, c_ctx, cond);
    p_rope(make_vb(lds), C.rope());
    for (int j = 0; j < 2; ++j) {
        p_wt<true>(make_vb(lds), attn_w_qkv + (size_t)j * DM * QKVW, (bf16_t*)((unsigned char*)C.wqkv() + (size_t)j * QKVW * DM), DM, QKVW, 2560);
        p_wt<true>(make_vb(lds), attn_w_o + (size_t)j * DM * DM, (bf16_t*)((unsigned char*)C.wo() + (size_t)j * DM * DM), DM, DM, 0);
        p_wt(make_vb(lds), hy_w_in + (size_t)j * DM * 3 * DM, C.win() + (size_t)j * 3 * DM * DM, DM, 3 * DM, 0);
        p_wt(make_vb(lds), hy_w_out + (size_t)j * DM * DM, C.wout() + (size_t)j * DM * DM, DM, DM, 0);
        float* h3l = h3 + (size_t)j * (SEQ + CTX) * 64;
        p_hy_h3(make_vb(lds), hy_f_w1 + j * 33 * 64, hy_f_b1 + j * 64, hy_f_w2 + j * 2 * 64 * 64, hy_f_b2 + j * 2 * 64, h3l, SEQ);
        if (j == 0) p_hy_h3(make_vb(lds), hy_f_w1, hy_f_b1, hy_f_w2, hy_f_b2, h3l + SEQ * 64, CTX);
    }
    for (int i = 0; i < 4; ++i) p_wt<true>(make_vb(lds), peer_w_q + (size_t)i * DM * DM, (bf16_t*)((unsigned char*)C.wq() + (size_t)i * DM * DM), DM, DM, 0);
    xcd_barrier(bar);
    p_ada2(lds, cond, ada_w, ada_b, C.ada());
    for (int j = 0; j < 2; ++j) {
        float* h3l = h3 + (size_t)j * (SEQ + CTX) * 64;
        p_hy_filt3<SEQ>(h3l, hy_f_w3 + (size_t)j * 64 * 4 * DM, hy_decay + j * 2 * DM, hy_fbias + j * 2 * DM, C.filt() + (size_t)j * 2 * DM * 4096);
        if (j == 0) p_hy_filt3<CTX>(h3l + SEQ * 64, hy_f_w3, hy_decay, hy_fbias, C.filtc());
    }
    xcd_barrier(bar);
    run_layer<0>(bar, C, lds);
    run_layer<1>(bar, C, lds);
    run_layer<2>(bar, C, lds);
    run_layer<3>(bar, C, lds);
    p_final(make_vb(lds), C.h16(), final_g, P.out);
}

extern "C" void kernel_launch(void* const* d_in, const int* in_sizes, int n_in, void* d_out, int out_size, void* d_ws, size_t ws_size, hipStream_t stream) {
    static int grid = 0;
    if (grid == 0) {
        if (n_in != 28 || ws_size < W.end) { fprintf(stderr, "kernel_launch: bad inputs / workspace too small: %zu < %zu\n", ws_size, W.end); grid = -1; return; }
        int dev = 0, cus = 0, per_cu = 0;
        if (hipGetDevice(&dev) != hipSuccess || hipDeviceGetAttribute(&cus, hipDeviceAttributeMultiprocessorCount, dev) != hipSuccess) { grid = -1; return; }
        if (hipFuncSetAttribute((const void*)mega_fwd, hipFuncAttributeMaxDynamicSharedMemorySize, LDS_BYTES) != hipSuccess) { fprintf(stderr, "kernel_launch: hipFuncSetAttribute failed\n"); grid = -1; return; }
        if (hipOccupancyMaxActiveBlocksPerMultiprocessor(&per_cu, (const void*)mega_fwd, 512, LDS_BYTES) != hipSuccess || per_cu < 1) fprintf(stderr, "kernel_launch: occupancy query says %d\n", per_cu);
        (void)hipGetLastError();
        grid = cus;
    }
    if (grid < 0) return;
    (void)hipMemsetAsync((unsigned char*)d_ws + W.bar, 0, 128 * 1024, stream);
    Params P{};
    for (int i = 0; i < 28; ++i) P.in[i] = (const float*)d_in[i];
    P.out = (float*)d_out; P.ws = (unsigned char*)d_ws;
    hipLaunchKernelGGL(mega_fwd, dim3(grid), dim3(512), LDS_BYTES, stream, P);
}
```

```cpp
#include <hip/hip_runtime.h>
#include <stdint.h>
#include <stdio.h>

typedef unsigned short bf16_t;
typedef short bf16x8 __attribute__((ext_vector_type(8)));
typedef float f32x4 __attribute__((ext_vector_type(4)));
typedef unsigned u32x4 __attribute__((ext_vector_type(4)));
typedef unsigned u32x2 __attribute__((ext_vector_type(2)));

#define DI __device__ __forceinline__

constexpr int DM = 2048;
constexpr int NB = 8;
constexpr int SEQ = 2048;
constexpr int CTX = 256;
constexpr int T_LAT = NB * SEQ;
constexpr int T_CTX = NB * CTX;
constexpr int T_ALL = T_LAT + T_CTX;
constexpr int NMOD = 6;
constexpr int HD = 128, NQH = 16, NKVH = 4;
constexpr int QKVW = 3072;
constexpr int PH = 8, PNK = 128, PTOPK = 16;
constexpr int NEXP = 16384;

DI bf16_t f2bf(float f) { unsigned u = __float_as_uint(f); u += 0x7fffu + ((u >> 16) & 1u); return (bf16_t)(u >> 16); }
DI float bf2f(bf16_t b) { return __uint_as_float(((unsigned)b) << 16); }
DI float wave_sum(float v) { for (int o = 32; o >= 1; o >>= 1) v += __shfl_xor(v, o); return v; }
DI float wave_max(float v) { for (int o = 32; o >= 1; o >>= 1) v = fmaxf(v, __shfl_xor(v, o)); return v; }

__host__ __device__ inline int head_perm(int p) { const int G = p >> 5, half = (p >> 4) & 1, j = p & 15; const int base = (G & 1) * 16 + (G >> 1) * 64; return base + j + 32 * half; }

struct WS {
    size_t bar, cond, ada, rope, h, a, q, k, vt, o, ut, yt, idx, gate, wqkv, wo, win, wout, wq, filt, filtc, h3, pu, pv, psc, part, xd, xsc, wh, dl, h16, end;
};
constexpr size_t ws_take(size_t& p, size_t bytes) { size_t r = p; p += (bytes + 255) & ~(size_t)255; return r; }
constexpr WS make_ws() {
    WS w{}; size_t p = 0;
    w.bar = ws_take(p, 128 * 1024);
    w.cond = ws_take(p, (size_t)9 * DM * 4);
    w.ada = ws_take(p, (size_t)4 * 9 * NMOD * DM * 4);
    w.rope = ws_take(p, (size_t)64 * 32 * 8);
    w.h = ws_take(p, (size_t)T_ALL * DM * 4);
    w.a = ws_take(p, (size_t)T_ALL * DM * 2);
    w.q = ws_take(p, (size_t)T_ALL * DM * 2);
    w.k = ws_take(p, (size_t)T_ALL * 512 * 2);
    w.vt = ws_take(p, (size_t)512 * T_ALL * 2);
    w.o = ws_take(p, (size_t)T_ALL * DM * 2);
    w.ut = ws_take(p, (size_t)3 * DM * T_ALL * 2);
    w.yt = ws_take(p, (size_t)DM * T_ALL * 2);
    w.idx = ws_take(p, (size_t)T_ALL * 128 * 4);
    w.gate = ws_take(p, (size_t)T_ALL * 128 * 4);
    w.wqkv = ws_take(p, (size_t)2 * QKVW * DM * 2);
    w.wo = ws_take(p, (size_t)2 * DM * DM * 2);
    w.win = ws_take(p, (size_t)2 * 3 * DM * DM * 2);
    w.wout = ws_take(p, (size_t)2 * DM * DM * 2);
    w.wq = ws_take(p, (size_t)4 * DM * DM * 2);
    w.filt = ws_take(p, (size_t)2 * 2 * DM * 4096 * 2);
    w.filtc = ws_take(p, (size_t)2 * DM * 512 * 2);
    w.h3 = ws_take(p, (size_t)2 * (SEQ + CTX) * 64 * 4);
    w.pu = ws_take(p, (size_t)4 * NEXP * DM / 2);
    w.pv = ws_take(p, (size_t)4 * NEXP * DM / 2);
    w.psc = ws_take(p, (size_t)4 * 2 * NEXP * 4);
    w.part = ws_take(p, (size_t)16 * T_ALL * 128 * 4);
    w.xd = ws_take(p, (size_t)T_ALL * 512 * 4);
    w.xsc = ws_take(p, (size_t)T_ALL * 4);
    w.wh = ws_take(p, (size_t)T_ALL * 64 * 4);
    w.dl = ws_take(p, (size_t)T_ALL * DM * 2);
    w.h16 = ws_take(p, (size_t)T_ALL * DM * 2);
    w.end = p;
    return w;
}
#ifndef PROBE_DUP
#define DELTA_LAYERS 3
#define PROBE_DUP 0
#endif
constexpr WS W = make_ws();
constexpr int PQ_OFF_WORDS = 4096;

namespace pg8 {
#define PG8_LAS __attribute__((address_space(3)))
typedef unsigned short bf16_t;
typedef short bf16x8 __attribute__((ext_vector_type(8)));
typedef float f32x4 __attribute__((ext_vector_type(4)));
typedef unsigned u32x4 __attribute__((ext_vector_type(4)));
constexpr int BM = 256, BK = 64, HALF = 128, HTB = HALF * BK * 2  , STAGE_BYTES = 8 * HTB, NXCD = 8, WGM = 8;

__host__ __device__ __forceinline__ int lds_byte(int r, int c) { const int st = (r >> 4) * 2 + (c >> 5), rr = r & 15, cc = c & 31, ob = rr * 64 + cc * 2; return st * 1024 + (ob ^ (((ob >> 9) & 1) << 5)); }
__host__ __device__ __forceinline__ void stage_rc(int b, int& R, int& C) { const int st = b / 1024, sb = b % 1024, swz = sb ^ (((sb >> 9) & 1) << 5); R = (st >> 1) * 16 + swz / 64; C = (st & 1) * 32 + (swz % 64) / 2; }
__host__ __device__ __forceinline__ int perm32(int rho) { const int n = rho >> 4, i = rho & 15; return 8 * (i >> 2) + 4 * n + (i & 3); }

struct Unit { int pm, pn; };
struct Gemm { const bf16_t* A; const bf16_t* Bt; int M, N, K; int sc; };
typedef int i32x4 __attribute__((ext_vector_type(4)));
typedef int i32x8 __attribute__((ext_vector_type(8)));

struct StaticOrder {
    int nM, nN, nwg, G, c;
    __host__ __device__ void init(int M, int N, int G_, int c_) { nM = M / BM; nN = N / BM; nwg = nM * nN; G = G_; c = c_; }
    __host__ __device__ bool next(int i, Unit& u) const {
        const long L = (long)i * G + c; if (L >= nwg) return false;
        int wgid = (int)L; { const int q = nwg / NXCD, r = nwg % NXCD, xcd = wgid % NXCD, off = wgid / NXCD; wgid = (xcd < r ? xcd * (q + 1) : r * (q + 1) + (xcd - r) * q) + off; }
        const int nig = WGM * nN, gid = wgid / nig, fm = gid * WGM, gsz = (nM - fm) < WGM ? (nM - fm) : WGM;
        u.pm = fm + ((wgid % nig) % gsz); u.pn = (wgid % nig) / gsz; return true;
    }
    __device__ __forceinline__ void a_ready(const Unit&) const {}
    __device__ __forceinline__ void done(const Unit&) const {}
};
struct CountedOrder : StaticOrder {
    const unsigned* ready; unsigned need; unsigned* tmo;
    __device__ __forceinline__ void a_ready(const Unit& u) const {
        if (threadIdx.x < 64) {
            const unsigned long long t0 = __builtin_amdgcn_s_memrealtime(); unsigned polls = 0;
            while ((unsigned)__builtin_amdgcn_readfirstlane(__hip_atomic_load(ready + 64 * u.pm, __ATOMIC_RELAXED, __HIP_MEMORY_SCOPE_AGENT)) < need) {
                if ((++polls & 255u) == 0u && __builtin_amdgcn_readfirstlane(__hip_atomic_load(tmo, __ATOMIC_RELAXED, __HIP_MEMORY_SCOPE_AGENT)) != 0u) break;
                if (__builtin_amdgcn_s_memrealtime() - t0 > 2000000ull) {
                    if (threadIdx.x == 0) { unsigned expect = 0u; __hip_atomic_compare_exchange_strong(tmo + 1, &expect, 0x600u | (unsigned)(u.pm & 0xff), __ATOMIC_RELAXED, __ATOMIC_RELAXED, __HIP_MEMORY_SCOPE_AGENT); __hip_atomic_store(tmo, 1u, __ATOMIC_RELAXED, __HIP_MEMORY_SCOPE_AGENT); }
                    break; }
                __builtin_amdgcn_s_sleep(2); }
            __builtin_amdgcn_fence(__ATOMIC_ACQUIRE, "agent");
            asm volatile("s_waitcnt vmcnt(0)" ::: "memory");
        }
#if !defined(BROKEN_HOOK_NO_BARRIER)
        asm volatile("" ::: "memory"); __builtin_amdgcn_s_barrier(); asm volatile("" ::: "memory");
#endif
    }
};

__device__ __forceinline__ unsigned cvt_pk_bf16(float lo, float hi) { unsigned r; asm volatile("v_cvt_pk_bf16_f32 %0, %1, %2" : "=v"(r) : "v"(lo), "v"(hi)); return r; }
template <class Epi, class Sched, bool STAMP = false, bool F8 = false>
__device__ __forceinline__ void gemm_phase(PG8_LAS unsigned char* lds, const Gemm g, const Sched& S, const Epi& E, unsigned long long* stamps) {
    int tid_ = threadIdx.x; asm volatile("" : "+v"(tid_));
    const int tid = tid_, wid = __builtin_amdgcn_readfirstlane(tid >> 6), lane = tid & 63, wr = wid >> 2, wc = wid & 3, fr = lane & 15, fq = lane >> 4;
    const int K = g.K, nt = K / BK;
    int ts_lo = 0, ts_hi = 0, nts = 0; const unsigned long long rt_entry = STAMP ? (unsigned long long)wall_clock64() : 0ull;
#define PG8_STAMP() do { if (STAMP && wid == 0 && nts < 64) { const unsigned long long _c = (unsigned long long)clock64(); \
        ts_lo = (lane == nts) ? (int)(unsigned)_c : ts_lo; ts_hi = (lane == nts) ? (int)(unsigned)(_c >> 32) : ts_hi; ++nts; } } while (0)
    PG8_STAMP();
    unsigned voffA[2], voffB[2];
#pragma unroll
    for (int i = 0; i < 2; ++i) { int R, C; stage_rc(tid * 16 + i * 8192, R, C); const int Rb = Epi::PERM ? ((R & ~31) + perm32(R & 31)) : R;
        voffA[i] = (unsigned)(R * K + C) * 2u; voffB[i] = (unsigned)(Rb * K + C) * 2u; }
    const size_t kstep = (size_t)(BK * 2);
    const size_t hstep = (size_t)HALF * K * 2;
    const size_t tstep = 2 * hstep;
    const unsigned ldsw = (unsigned)wid * 1024u;
    const int aoff = lds_byte(wr * 64 + fr, fq * 8), boff = lds_byte(wc * 32 + fr, fq * 8);
#define PG8_SA(b, h) (((b) * 2 + (h)) * HTB)
#define PG8_SB(b, h) ((4 + (b) * 2 + (h)) * HTB)
#define PG8_STAGE(bufoff, gbase, voff) do { _Pragma("unroll") for (int _i = 0; _i < 2; ++_i) \
        __builtin_amdgcn_global_load_lds((const unsigned*)((const char*)(gbase) + (voff)[_i]), (PG8_LAS unsigned*)(lds + (bufoff) + ldsw + _i * 8192), 16, 0, 0); } while (0)
#define PG8_RD(off) (*(const PG8_LAS i32x4*)(lds + (off)))
#define PG8_LDA(dst, b, h) do { _Pragma("unroll") for (int m = 0; m < 4; ++m) { if constexpr (F8) { dst##8[m].lo = PG8_RD(PG8_SA(b, h) + aoff + m * 2048); dst##8[m].hi = PG8_RD(PG8_SA(b, h) + aoff + m * 2048 + 1024); } \
        else { _Pragma("unroll") for (int k = 0; k < 2; ++k) dst[m][k] = *(const PG8_LAS bf16x8*)(lds + PG8_SA(b, h) + aoff + m * 2048 + k * 1024); } } } while (0)
#define PG8_LDB(dst, b, h) do { _Pragma("unroll") for (int n = 0; n < 2; ++n) { if constexpr (F8) { dst##8[n].lo = PG8_RD(PG8_SB(b, h) + boff + n * 2048); dst##8[n].hi = PG8_RD(PG8_SB(b, h) + boff + n * 2048 + 1024); } \
        else { _Pragma("unroll") for (int k = 0; k < 2; ++k) dst[n][k] = *(const PG8_LAS bf16x8*)(lds + PG8_SB(b, h) + boff + n * 2048 + k * 1024); } } } while (0)
#define PG8_MMA(ai, bj, At, Bt) do { __builtin_amdgcn_s_setprio(1); _Pragma("unroll") for (int m = 0; m < 4; ++m) _Pragma("unroll") for (int n = 0; n < 2; ++n) { \
        if constexpr (F8) asm volatile("v_mfma_scale_f32_16x16x128_f8f6f4 %0, %1, %2, %0, %3, %3 op_sel_hi:[0,0,0]" : "+v"(acc[ai][bj][m][n]) : "v"(Bt##8[n]), "v"(At##8[m]), "v"(scv));   \
        else { _Pragma("unroll") for (int k = 0; k < 2; ++k) acc[ai][bj][m][n] = __builtin_amdgcn_mfma_f32_16x16x32_bf16(Bt[n][k], At[m][k], acc[ai][bj][m][n], 0, 0, 0); } } \
        __builtin_amdgcn_s_setprio(0); } while (0)
#define PG8_WAIT_V(n) asm volatile("s_waitcnt vmcnt(" #n ")" ::: "memory")
#define PG8_WAIT_L(n) asm volatile("s_waitcnt lgkmcnt(" #n ")" ::: "memory")
#define PG8_BAR __builtin_amdgcn_s_barrier()
#define PG8_SCHED __builtin_amdgcn_sched_barrier(0)
    Unit cur, nxt; int ui = 0;
    if (!S.next(0, cur)) return;
    f32x4 acc[2][2][4][2];
#pragma unroll
    for (int a = 0; a < 2; ++a)
#pragma unroll
        for (int b = 0; b < 2; ++b)
#pragma unroll
            for (int m = 0; m < 4; ++m)
#pragma unroll
                for (int n = 0; n < 2; ++n) acc[a][b][m][n] = (f32x4){0.f, 0.f, 0.f, 0.f};
    bf16x8 At[4][2], B0[2][2], B1[2][2];
    const int scv = g.sc; i32x8 At8[4], B08[2], B18[2];
    const char* cA = (const char*)g.A + (size_t)cur.pm * tstep; const char* cB = (const char*)g.Bt + (size_t)cur.pn * tstep;
    S.a_ready(cur);
    PG8_STAGE(PG8_SB(0, 0), cB, voffB); PG8_STAGE(PG8_SA(0, 0), cA, voffA); PG8_STAGE(PG8_SB(0, 1), cB + hstep, voffB); PG8_STAGE(PG8_SA(0, 1), cA + hstep, voffA);
    if (wr == 1) PG8_BAR;
    PG8_WAIT_V(4); PG8_BAR;
    PG8_STAGE(PG8_SB(1, 0), cB + kstep, voffB); PG8_STAGE(PG8_SA(1, 0), cA + kstep, voffA); PG8_STAGE(PG8_SB(1, 1), cB + hstep + kstep, voffB);
    PG8_WAIT_V(6); PG8_BAR;
    PG8_STAMP();
    for (;;) {
        const bool has_next = S.next(ui + 1, nxt);
        const char* nA = has_next ? (const char*)g.A + (size_t)nxt.pm * tstep : cA; const char* nB = has_next ? (const char*)g.Bt + (size_t)nxt.pn * tstep : cB;
        for (int t = 0; t < nt; t += 2) {
            const bool last = (t == nt - 2);
            const char* a1 = cA + (size_t)(t + 1) * kstep;
            const char* a2 = last ? nA : cA + (size_t)(t + 2) * kstep; const char* b2 = last ? nB : cB + (size_t)(t + 2) * kstep;
            const char* a3 = a2 + kstep; const char* b3 = b2 + kstep;
            if (last && has_next) S.a_ready(nxt);
            PG8_LDB(B0, 0, 0); PG8_SCHED; PG8_LDA(At, 0, 0); PG8_STAGE(PG8_SA(1, 1), a1 + hstep, voffA);
            PG8_WAIT_L(8); PG8_BAR; PG8_WAIT_L(0); PG8_MMA(0, 0, At, B0); PG8_BAR; PG8_SCHED;
            PG8_LDB(B1, 0, 1); PG8_STAGE(PG8_SB(0, 0), b2, voffB);
            PG8_BAR; PG8_WAIT_L(0); PG8_MMA(0, 1, At, B1); PG8_BAR;
            PG8_LDA(At, 0, 1); PG8_STAGE(PG8_SA(0, 0), a2, voffA);
            PG8_BAR; PG8_WAIT_L(0); PG8_MMA(1, 0, At, B0); PG8_BAR; PG8_SCHED;
            PG8_STAGE(PG8_SB(0, 1), b2 + hstep, voffB);
            PG8_WAIT_V(6); PG8_BAR; PG8_MMA(1, 1, At, B1); PG8_BAR;
            PG8_LDB(B0, 1, 0); PG8_SCHED; PG8_LDA(At, 1, 0); PG8_STAGE(PG8_SA(0, 1), a2 + hstep, voffA);
            PG8_WAIT_L(8); PG8_BAR; PG8_WAIT_L(0); PG8_MMA(0, 0, At, B0); PG8_BAR; PG8_SCHED;
            PG8_LDB(B1, 1, 1); PG8_STAGE(PG8_SB(1, 0), b3, voffB);
            PG8_BAR; PG8_WAIT_L(0); PG8_MMA(0, 1, At, B1); PG8_BAR;
            PG8_LDA(At, 1, 1); PG8_STAGE(PG8_SA(1, 0), a3, voffA);
            PG8_BAR; PG8_WAIT_L(0); PG8_MMA(1, 0, At, B0); PG8_BAR; PG8_SCHED;
            PG8_STAGE(PG8_SB(1, 1), b3 + hstep, voffB);
            PG8_WAIT_V(6); PG8_BAR; PG8_MMA(1, 1, At, B1); PG8_BAR;
        }
        PG8_STAMP();
        if constexpr (F8) asm volatile("s_nop 15\n\ts_nop 15" ::: "memory");
        if constexpr (!Epi::AFTER_DRAIN) { E(acc, cur, wr, wc, fr, fq); S.done(cur); }
        PG8_STAMP();
        if (!has_next) break;
#pragma unroll
        for (int a = 0; a < 2; ++a)
#pragma unroll
            for (int b = 0; b < 2; ++b)
#pragma unroll
                for (int m = 0; m < 4; ++m)
#pragma unroll
                    for (int n = 0; n < 2; ++n) acc[a][b][m][n] = (f32x4){0.f, 0.f, 0.f, 0.f};
        cur = nxt; cA = nA; cB = nB; ++ui;
    }
    PG8_WAIT_V(0);
    if (wr == 0) PG8_BAR;
    PG8_BAR;
    if constexpr (Epi::AFTER_DRAIN) { E.fused(acc, cur, wr, wc, fr, fq, lds, wid, lane); S.done(cur); }
    PG8_STAMP();
    if (STAMP && wid == 0) { stamps[lane] = lane < nts ? (((unsigned long long)(unsigned)ts_hi << 32) | (unsigned)ts_lo) : 0ull;
        if (lane == 62) stamps[62] = rt_entry; if (lane == 63) stamps[63] = (unsigned long long)wall_clock64(); }
#undef PG8_STAMP
#undef PG8_SA
#undef PG8_SB
#undef PG8_STAGE
#undef PG8_LDA
#undef PG8_LDB
#undef PG8_MMA
#undef PG8_RD
#undef PG8_WAIT_V
#undef PG8_WAIT_L
#undef PG8_BAR
#undef PG8_SCHED
}
}

#define XB_TMO      128
#define XB_XCNT(j)  (256  + 64 * (j))
#define XB_XSUB(j)  (1280 + 64 * (j))
#define XB_XGEN(j)  (2304 + 64 * (j))
#define XB_TOP      3328
#define XB_TOPGEN   3392
#define XCD_BAR_WORDS 3456
#define XB_SPIN_CAP (1u << 21)
#define LAS __attribute__((address_space(3)))
__device__ __forceinline__ unsigned xb_ld(unsigned* p)              { return __hip_atomic_load(p, __ATOMIC_RELAXED, __HIP_MEMORY_SCOPE_AGENT); }
__device__ __forceinline__ unsigned xb_add(unsigned* p, unsigned v) { return __hip_atomic_fetch_add(p, v, __ATOMIC_RELAXED, __HIP_MEMORY_SCOPE_AGENT); }
__device__ __forceinline__ unsigned xb_xcc_id() { return (unsigned)__builtin_amdgcn_s_getreg((3 << 11) | 20) & 0xFu; }
#define XB_SPIN(cond, bar) do { unsigned _sp = 0; while (cond) { __builtin_amdgcn_s_sleep(1); \
    if ((++_sp & 255u) == 0u) { if (xb_ld(&(bar)[XB_TMO])) break; if (_sp > XB_SPIN_CAP) { atomicAdd(&(bar)[XB_TMO], 1u); break; } } } } while (0)
struct XcdBarrier { unsigned* bar; unsigned x; volatile LAS unsigned* st; };
__device__ __forceinline__ XcdBarrier xcd_barrier_post(unsigned* bar, volatile LAS unsigned* st) {
    XcdBarrier b; b.bar = bar; b.x = xb_xcc_id(); b.st = st;
    if (threadIdx.x == 0) (void)xb_add(&bar[XB_XCNT(b.x)], 1u);
    return b;
}
__device__ __forceinline__ void xcd_barrier_complete(unsigned* bar, unsigned x, unsigned& nloc, unsigned& nx) {
    const unsigned G = gridDim.x * gridDim.y * gridDim.z;
    unsigned sum, cnt, mine, sp = 0u;
    for (;;) {
        sum = 0u; cnt = 0u; mine = 0u;
#pragma unroll
        for (unsigned j = 0; j < 16; ++j) { const unsigned c = xb_ld(&bar[XB_XCNT(j)]); sum += c; cnt += (c > 0u) ? 1u : 0u; mine = (j == x) ? c : mine; }
        if (sum == G) break;
        __builtin_amdgcn_s_sleep(1);
        if ((++sp & 255u) == 0u) { if (xb_ld(&bar[XB_TMO])) break; if (sp > XB_SPIN_CAP) { atomicAdd(&bar[XB_TMO], 1u); break; } }
    }
    nloc = mine > 0u ? mine : 1u; nx = cnt > 0u ? cnt : 1u;
}
__device__ __forceinline__ void xcd_barrier(const XcdBarrier& b) {
    asm volatile("s_waitcnt vmcnt(0)" ::: "memory");
    __syncthreads();
    if (threadIdx.x == 0) {
        unsigned* bar = b.bar;
        __builtin_amdgcn_s_waitcnt(0);
        unsigned nloc = b.st[0], nx = b.st[1];
        if (nloc == 0u) { xcd_barrier_complete(bar, b.x, nloc, nx); b.st[0] = nloc; b.st[1] = nx; }
        const unsigned old = xb_add(&bar[XB_XSUB(b.x)], 1u);
        const unsigned gen = old / nloc;
        if (old + 1u == (gen + 1u) * nloc) {
            __builtin_amdgcn_fence(__ATOMIC_RELEASE, "agent");
            asm volatile("s_waitcnt vmcnt(0)" ::: "memory");
            const unsigned og = xb_add(&bar[XB_TOP], 1u);
            const unsigned tg = og / nx;
            if (og + 1u == (tg + 1u) * nx) xb_add(&bar[XB_TOPGEN], 1u);
            else XB_SPIN(xb_ld(&bar[XB_TOPGEN]) == tg, bar);
            __builtin_amdgcn_fence(__ATOMIC_ACQUIRE, "agent");
            xb_add(&bar[XB_XGEN(b.x)], 1u);
            asm volatile("s_waitcnt vmcnt(0)" ::: "memory");
        } else {
            XB_SPIN(xb_ld(&bar[XB_XGEN(b.x)]) == gen, bar);
            __builtin_amdgcn_fence(__ATOMIC_ACQUIRE, "agent");
            asm volatile("s_waitcnt vmcnt(0)" ::: "memory");
        }
    }
    __syncthreads();
}

constexpr int LDS_BYTES = 147456;
constexpr int LDS_HALF = 65536;
struct VB { int vb, nvb, vtid; unsigned char* lds; };
DI int tid_opaque() { int t = threadIdx.x; asm volatile("" : "+v"(t)); return t; }
DI VB make_vb(unsigned char* lds) { int t = threadIdx.x; asm volatile("" : "+v"(t)); VB V; V.vb = blockIdx.x * 2 + (t >> 8); V.nvb = gridDim.x * 2; V.vtid = t & 255; V.lds = lds + (t >> 8) * LDS_HALF; return V; }
DI unsigned pk_bf16(float lo, float hi) { return pg8::cvt_pk_bf16(lo, hi); }
DI unsigned pk_fp8x4(float x0, float x1, float x2, float x3, float sc) {
    x0 = __builtin_amdgcn_fmed3f(x0 * sc, -448.f, 448.f); x1 = __builtin_amdgcn_fmed3f(x1 * sc, -448.f, 448.f); x2 = __builtin_amdgcn_fmed3f(x2 * sc, -448.f, 448.f); x3 = __builtin_amdgcn_fmed3f(x3 * sc, -448.f, 448.f);
    int p = 0; p = __builtin_amdgcn_cvt_pk_fp8_f32(x0, x1, p, false); p = __builtin_amdgcn_cvt_pk_fp8_f32(x2, x3, p, true); return (unsigned)p; }
constexpr float F8_ACT = 16.f, F8_WT = 256.f, F8_O = 64.f;
constexpr int F8_SC_AW = 0x01010101 * (127 - 6), F8_SC_OW = 0x01010101 * (127 - 7);
typedef LAS unsigned char* lptr;
typedef _Float16 f16x2_t __attribute__((ext_vector_type(2)));
DI f16x2_t u2h(unsigned x) { return __builtin_bit_cast(f16x2_t, x); }
#define VB_LOOP(u, n) for (int _it = 0, u = V.vb; _it < ((n) + V.nvb - 1) / V.nvb; ++_it, u += V.nvb)

DI void p_cond(const VB& V, const float* __restrict__ c, const float* __restrict__ c_ctx, float* __restrict__ cond) {
    for (int i = V.vb * 256 + V.vtid; i < 9 * DM; i += V.nvb * 256) { const float v = i < 8 * DM ? c[i] : c_ctx[i - 8 * DM]; cond[i] = v / (1.0f + expf(-v)); }
}
template <bool F8 = false> DI void p_wt(const VB& V, const float* __restrict__ W, bf16_t* __restrict__ Wt, int K, int N, int nperm) {
    lptr tile = (lptr)V.lds;
    const int ntn = N / 64, ntk = K / 64, vt = V.vtid;
    const int lk = vt >> 4, lc = (vt & 15) * 4;
    const int sn = vt >> 2, sk = (vt & 3) * 16;
    VB_LOOP(u, ntn * ntk) {
        const bool act = u < ntn * ntk; const int n0 = (u % ntn) * 64, k0 = (u / ntn) * 64;
        if (act) { const int n = n0 + lc; const int src = n < nperm ? (n & ~127) + head_perm(n & 127) : n;
#pragma unroll
            for (int p = 0; p < 4; ++p) { const f32x4 v = *(const f32x4*)(W + (size_t)(k0 + lk + 16 * p) * N + src); *(LAS f32x4*)(tile + ((lk + 16 * p) * 68 + lc) * 4) = v; } }
        __syncthreads();
        if (act) { float e[16];
#pragma unroll
            for (int j = 0; j < 16; ++j) e[j] = *(const LAS float*)(tile + ((sk + j) * 68 + sn) * 4);
            if constexpr (F8) { u32x4 w; w.x = pk_fp8x4(e[0], e[1], e[2], e[3], F8_WT); w.y = pk_fp8x4(e[4], e[5], e[6], e[7], F8_WT); w.z = pk_fp8x4(e[8], e[9], e[10], e[11], F8_WT); w.w = pk_fp8x4(e[12], e[13], e[14], e[15], F8_WT);
                *(u32x4*)((unsigned char*)Wt + (size_t)(n0 + sn) * K + k0 + sk) = w; }
            else { u32x4 w0, w1; w0.x = pk_bf16(e[0], e[1]); w0.y = pk_bf16(e[2], e[3]); w0.z = pk_bf16(e[4], e[5]); w0.w = pk_bf16(e[6], e[7]);
                w1.x = pk_bf16(e[8], e[9]); w1.y = pk_bf16(e[10], e[11]); w1.z = pk_bf16(e[12], e[13]); w1.w = pk_bf16(e[14], e[15]);
                bf16_t* dst = Wt + (size_t)(n0 + sn) * K + k0 + sk; *(u32x4*)dst = w0; *(u32x4*)(dst + 8) = w1; } }
        __syncthreads();
    }
}
DI void p_rope(const VB& V, float2* __restrict__ rope) {
    for (int i = V.vb * 256 + V.vtid; i < 64 * 32; i += V.nvb * 256) {
        const int pos = i >> 5, f = i & 31; const float inv = powf(10000.0f, -(float)f / 32.0f); const float ang = (float)pos * inv;
        rope[i] = make_float2(cosf(ang), sinf(ang)); }
}
DI void p_hy_h3(const VB& V, const float* __restrict__ w1, const float* __restrict__ b1, const float* __restrict__ w2, const float* __restrict__ b2, float* __restrict__ h3, int L) {
    const int wv = V.vtid >> 6, j = V.vtid & 63;
    float* z = (float*)V.lds + wv * 256; float* ha = z + 64; float* hb = z + 128;
    const int nw = V.nvb * 4, w0 = V.vb * 4 + wv;
    for (int it = 0; it < (L + nw - 1) / nw; ++it) {
        const int t = it * nw + w0; const bool act = t < L;
        if (act) { if (j == 0) z[0] = (float)t / (float)L;
            if (j >= 1 && j <= 16) { const float ang = 2.0f * 3.14159265358979323846f * (float)t * (float)j / (float)L; z[j] = cosf(ang); z[16 + j] = sinf(ang); } }
        __syncthreads();
        float s = 0.f;
        if (act) { s = b1[j];
_Pragma("unroll 3") for (int k = 0; k < 33; ++k) s += z[k] * w1[k * 64 + j]; ha[j] = sinf(s); }
        __syncthreads();
        if (act) { s = b2[j];
_Pragma("unroll 4") for (int k = 0; k < 64; ++k) s += ha[k] * w2[k * 64 + j]; hb[j] = sinf(s); }
        __syncthreads();
        if (act) { s = b2[64 + j];
_Pragma("unroll 4") for (int k = 0; k < 64; ++k) s += hb[k] * w2[64 * 64 + k * 64 + j]; h3[(size_t)t * 64 + j] = sinf(s); }
        __syncthreads();
    }
}
DI const float* row_ptr(const float* h, const float* x, const float* ctx, int r) { return x ? (r < T_LAT ? x + (size_t)r * DM : ctx + (size_t)(r - T_LAT) * DM) : h + (size_t)r * DM; }
template <bool QX, bool F8 = false> DI void p_normmod(const VB& V, const float* __restrict__ h, const float* __restrict__ x0, const float* __restrict__ ctx0, const float* __restrict__ g, const float* __restrict__ adaL, int sh_off, int sc_off, bf16_t* __restrict__ a, int nrows,
                                     unsigned* __restrict__ xd = nullptr, float* __restrict__ xsc = nullptr, const unsigned short* __restrict__ dl = nullptr, const unsigned short* __restrict__ x16 = nullptr) {
    const int lane = V.vtid & 63;
    for (int r = V.vb * 4 + (V.vtid >> 6); r < nrows; r += V.nvb * 4) {
        const int bi = r < T_LAT ? r / SEQ : 8;
        const float* x = row_ptr(h, x0, ctx0, r); const float* sh = adaL + (size_t)bi * NMOD * DM + sh_off; const float* sc = adaL + (size_t)bi * NMOD * DM + sc_off;
        float4 v[8]; float ss = 0.f;
#pragma unroll
        for (int i = 0; i < 8; ++i) v[i] = make_float4(0.f, 0.f, 0.f, 0.f);
        if (x16) {
            u32x2 hw[8];
#pragma unroll
            for (int i = 0; i < 8; ++i) hw[i] = *(const u32x2*)(x16 + (size_t)r * DM + i * 256 + lane * 4);
#pragma unroll
            for (int i = 0; i < 8; ++i) { const f16x2_t h01 = u2h(hw[i].x), h23 = u2h(hw[i].y); v[i] = make_float4((float)h01.x, (float)h01.y, (float)h23.x, (float)h23.y); }
        } else {
#pragma unroll
            for (int i = 0; i < 8; ++i) v[i] = *(const float4*)(x + i * 256 + lane * 4);
        }
        if (dl) {
#pragma unroll
            for (int i = 0; i < 8; ++i) { const u32x2 dw = *(const u32x2*)(dl + (size_t)r * DM + i * 256 + lane * 4); const f16x2_t d01 = u2h(dw.x), d23 = u2h(dw.y);
                v[i].x += (float)d01.x; v[i].y += (float)d01.y; v[i].z += (float)d23.x; v[i].w += (float)d23.y; } }
#pragma unroll
        for (int i = 0; i < 8; ++i) ss += v[i].x * v[i].x + v[i].y * v[i].y + v[i].z * v[i].z + v[i].w * v[i].w;
        ss = wave_sum(ss); const float inv = rsqrtf(ss / (float)DM + 1e-6f);
        float amax = 0.f;
#pragma unroll
        for (int i = 0; i < 8; ++i) { const int c = i * 256 + lane * 4; const float4 gg = *(const float4*)(g + c), s1 = *(const float4*)(sc + c), s0 = *(const float4*)(sh + c);
            v[i].x = v[i].x * inv * gg.x * (1.f + s1.x) + s0.x; v[i].y = v[i].y * inv * gg.y * (1.f + s1.y) + s0.y; v[i].z = v[i].z * inv * gg.z * (1.f + s1.z) + s0.z; v[i].w = v[i].w * inv * gg.w * (1.f + s1.w) + s0.w;
            if constexpr (F8) *(unsigned*)((unsigned char*)a + (size_t)r * DM + c) = pk_fp8x4(v[i].x, v[i].y, v[i].z, v[i].w, F8_ACT);
            else { u32x2 o; o.x = f2bf(v[i].x) | ((unsigned)f2bf(v[i].y) << 16); o.y = f2bf(v[i].z) | ((unsigned)f2bf(v[i].w) << 16);
                *(u32x2*)(a + (size_t)r * DM + c) = o; }
            if constexpr (QX) amax = fmaxf(amax, fmaxf(fmaxf(fabsf(v[i].x), fabsf(v[i].y)), fmaxf(fabsf(v[i].z), fabsf(v[i].w)))); }
        if constexpr (QX) {
            amax = wave_max(amax); const float qs = amax > 0.f ? 119.0f / amax : 0.f;
            if (lane == 0) xsc[r] = amax * (1.0f / 119.0f);
#pragma unroll
            for (int i = 0; i < 8; ++i) { const int q0 = (int)rintf(v[i].x * qs), q1 = (int)rintf(v[i].y * qs), q2 = (int)rintf(v[i].z * qs), q3 = (int)rintf(v[i].w * qs);
                const unsigned hi = (unsigned)(((q0 + 8) >> 4) & 15) | ((unsigned)(((q1 + 8) >> 4) & 15) << 4) | ((unsigned)(((q2 + 8) >> 4) & 15) << 8) | ((unsigned)(((q3 + 8) >> 4) & 15) << 12);
                const unsigned lo = (unsigned)(q0 & 15) | ((unsigned)(q1 & 15) << 4) | ((unsigned)(q2 & 15) << 8) | ((unsigned)(q3 & 15) << 12);
                xd[(size_t)r * 512 + 64 * i + lane] = hi | (lo << 16); }
        }
    }
}
DI void p_final(const VB& V, const unsigned short* __restrict__ h16, const float* __restrict__ g, float* __restrict__ out) {
    const int lane = V.vtid & 63;
    for (int r = V.vb * 4 + (V.vtid >> 6); r < T_LAT; r += V.nvb * 4) {
        u32x2 hw[8]; float4 v[8]; float ss = 0.f;
#pragma unroll
        for (int i = 0; i < 8; ++i) hw[i] = *(const u32x2*)(h16 + (size_t)r * DM + i * 256 + lane * 4);
#pragma unroll
        for (int i = 0; i < 8; ++i) { const f16x2_t h01 = u2h(hw[i].x), h23 = u2h(hw[i].y); v[i] = make_float4((float)h01.x, (float)h01.y, (float)h23.x, (float)h23.y); ss += v[i].x * v[i].x + v[i].y * v[i].y + v[i].z * v[i].z + v[i].w * v[i].w; }
        ss = wave_sum(ss); const float inv = rsqrtf(ss / (float)DM + 1e-6f);
#pragma unroll
        for (int i = 0; i < 8; ++i) { const int c = i * 256 + lane * 4; const float4 gg = *(const float4*)(g + c);
            *(float4*)(out + (size_t)r * DM + c) = make_float4(v[i].x * inv * gg.x, v[i].y * inv * gg.y, v[i].z * inv * gg.z, v[i].w * inv * gg.w); }
    }
}

struct EpiQK {
    static constexpr bool PERM = false, AFTER_DRAIN = false;
    bf16_t* Q; bf16_t* Kb; const float2* rope;
    DI void operator()(const pg8::f32x4 (&acc)[2][2][4][2], const pg8::Unit& u, int wr, int wc, int fr, int fq) const {
        const int f0 = (wc & 1) * 16 + 4 * fq;
#pragma unroll
        for (int ai = 0; ai < 2; ++ai)
#pragma unroll
            for (int m = 0; m < 4; ++m) {
                const int row = u.pm * 256 + ai * 128 + wr * 64 + m * 16 + fr;
                const int t = row & (SEQ - 1); const int pos = (wc >> 1) ? (t & 63) : (t >> 6);
                float4 c01 = make_float4(1.f, 0.f, 1.f, 0.f), c23 = c01;
                if (row < T_LAT) { const float4* rp = (const float4*)(rope + pos * 32 + f0); c01 = rp[0]; c23 = rp[1]; }
#pragma unroll
                for (int bj = 0; bj < 2; ++bj) {
                    const pg8::f32x4 v0 = acc[ai][bj][m][0], v1 = acc[ai][bj][m][1];
                    const float a0 = v0[0] * c01.x - v1[0] * c01.y, b0 = v1[0] * c01.x + v0[0] * c01.y;
                    const float a1 = v0[1] * c01.z - v1[1] * c01.w, b1 = v1[1] * c01.z + v0[1] * c01.w;
                    const float a2 = v0[2] * c23.x - v1[2] * c23.y, b2 = v1[2] * c23.x + v0[2] * c23.y;
                    const float a3 = v0[3] * c23.z - v1[3] * c23.w, b3 = v1[3] * c23.z + v0[3] * c23.w;
                    const int colh = u.pn * 256 + bj * 128, c0 = colh + 32 * wc + 4 * fq;
                    bf16_t* dst = colh < 2048 ? Q + (size_t)row * DM + c0 : Kb + (size_t)row * 512 + (c0 - 2048);
                    u32x2 lo, hi; lo.x = pk_bf16(a0, a1); lo.y = pk_bf16(a2, a3); hi.x = pk_bf16(b0, b1); hi.y = pk_bf16(b2, b3);
                    *(u32x2*)dst = lo; *(u32x2*)(dst + 16) = hi;
                }
                asm volatile("" ::: "memory");
            }
    }
};
struct EpiResid {
    static constexpr bool PERM = false, AFTER_DRAIN = false;
    const float* h; const float* x0; const float* ctx0; float* hout; const float* adaL; int g_off;
    DI void operator()(const pg8::f32x4 (&acc)[2][2][4][2], const pg8::Unit& u, int wr, int wc, int fr, int fq) const {
#pragma unroll
        for (int ai = 0; ai < 2; ++ai)
#pragma unroll
            for (int m = 0; m < 4; ++m) {
                const int row = u.pm * 256 + ai * 128 + wr * 64 + m * 16 + fr; const int bi = row < T_LAT ? row >> 11 : 8;
                const float* base = row_ptr(h, x0, ctx0, row); const float* g = adaL + (size_t)bi * NMOD * DM + g_off; float* op = hout + (size_t)row * DM;
#pragma unroll
                for (int bj = 0; bj < 2; ++bj)
#pragma unroll
                    for (int n = 0; n < 2; ++n) { const int col = u.pn * 256 + bj * 128 + wc * 32 + n * 16 + 4 * fq;
                        const pg8::f32x4 b = *(const pg8::f32x4*)(base + col), gg = *(const pg8::f32x4*)(g + col);
                        *(pg8::f32x4*)(op + col) = b + gg * acc[ai][bj][m][n]; }
                asm volatile("" ::: "memory");
            }
    }
};
DI unsigned pk_f16(float lo, float hi) { return __builtin_bit_cast(unsigned, (f16x2_t){(_Float16)lo, (_Float16)hi}); }
struct EpiDelta {
    static constexpr bool PERM = true, AFTER_DRAIN = false;
    unsigned short* D; const float* adaL; int g_off;
    DI void operator()(const pg8::f32x4 (&acc)[2][2][4][2], const pg8::Unit& u, int wr, int wc, int fr, int fq) const {
        const int row0 = u.pm * 256 + wr * 64 + fr, col0 = u.pn * 256 + wc * 32 + 8 * fq; const int bi = u.pm * 256 < T_LAT ? (u.pm * 256) >> 11 : 8;
        const float* gp = adaL + (size_t)bi * NMOD * DM + g_off + col0;
        pg8::f32x4 g0[2], g1[2];
#pragma unroll
        for (int bj = 0; bj < 2; ++bj) { g0[bj] = *(const pg8::f32x4*)(gp + bj * 128); g1[bj] = *(const pg8::f32x4*)(gp + bj * 128 + 4); }
#pragma unroll
        for (int ai = 0; ai < 2; ++ai)
#pragma unroll
            for (int m = 0; m < 4; ++m) { unsigned short* rowp = D + (size_t)(row0 + ai * 128 + m * 16) * DM + col0;
#pragma unroll
                for (int bj = 0; bj < 2; ++bj) { const pg8::f32x4 v0 = acc[ai][bj][m][0] * g0[bj], v1 = acc[ai][bj][m][1] * g1[bj];
                    u32x4 w; w.x = pk_f16(v0[0], v0[1]); w.y = pk_f16(v0[2], v0[3]); w.z = pk_f16(v1[0], v1[1]); w.w = pk_f16(v1[2], v1[3]);
                    *(u32x4*)(rowp + bj * 128) = w; } }
    }
};
struct EpiResidP {
    static constexpr bool PERM = true, AFTER_DRAIN = false;
    float* H; const float* adaL; int g_off;
    DI void operator()(const pg8::f32x4 (&acc)[2][2][4][2], const pg8::Unit& u, int wr, int wc, int fr, int fq) const {
        const int row0 = u.pm * 256 + wr * 64 + fr, col0 = u.pn * 256 + wc * 32 + 8 * fq; const int bi = u.pm * 256 < T_LAT ? (u.pm * 256) >> 11 : 8;
        const float* gp = adaL + (size_t)bi * NMOD * DM + g_off + col0;
        pg8::f32x4 g0[2], g1[2];
#pragma unroll
        for (int bj = 0; bj < 2; ++bj) { g0[bj] = *(const pg8::f32x4*)(gp + bj * 128); g1[bj] = *(const pg8::f32x4*)(gp + bj * 128 + 4); }
#pragma unroll
        for (int ai = 0; ai < 2; ++ai)
#pragma unroll
            for (int m = 0; m < 4; ++m) { float* rowp = H + (size_t)(row0 + ai * 128 + m * 16) * DM + col0;
#pragma unroll
                for (int bj = 0; bj < 2; ++bj) { const pg8::f32x4 b0 = *(const pg8::f32x4*)(rowp + bj * 128), b1 = *(const pg8::f32x4*)(rowp + bj * 128 + 4);
                    *(pg8::f32x4*)(rowp + bj * 128) = b0 + acc[ai][bj][m][0] * g0[bj]; *(pg8::f32x4*)(rowp + bj * 128 + 4) = b1 + acc[ai][bj][m][1] * g1[bj]; }
                asm volatile("" ::: "memory"); }
    }
};
struct EpiBfP {
    static constexpr bool PERM = true, AFTER_DRAIN = false;
    bf16_t* O; int ldc;
    DI void operator()(const pg8::f32x4 (&acc)[2][2][4][2], const pg8::Unit& u, int wr, int wc, int fr, int fq) const {
        const int row0 = u.pm * 256 + wr * 64 + fr, col0 = u.pn * 256 + wc * 32 + 8 * fq;
#pragma unroll
        for (int ai = 0; ai < 2; ++ai)
#pragma unroll
            for (int m = 0; m < 4; ++m) { bf16_t* rowp = O + (size_t)(row0 + ai * 128 + m * 16) * ldc + col0;
#pragma unroll
                for (int bj = 0; bj < 2; ++bj) { const pg8::f32x4 v0 = acc[ai][bj][m][0], v1 = acc[ai][bj][m][1];
                    u32x4 w; w.x = pk_bf16(v0[0], v0[1]); w.y = pk_bf16(v0[2], v0[3]); w.z = pk_bf16(v1[0], v1[1]); w.w = pk_bf16(v1[2], v1[3]);
                    *(u32x4*)(rowp + bj * 128) = w; } }
    }
};
template <class Epi> DI void p_gemm(unsigned char* lds, const bf16_t* A, const bf16_t* Bt, int M, int N, int K, int c, const Epi& E) {
    pg8::Gemm g{A, Bt, M, N, K, 0}; pg8::StaticOrder S; S.init(M, N, (int)gridDim.x, c);
    pg8::gemm_phase<Epi, pg8::StaticOrder, false>((PG8_LAS unsigned char*)lds, g, S, E, nullptr);
}
template <class Epi> DI void p_gemm8(unsigned char* lds, const void* A, const void* Bt, int M, int N, int K, int c, const Epi& E, int sc) {
    pg8::Gemm g{(const bf16_t*)A, (const bf16_t*)Bt, M, N, K / 2, sc}; pg8::StaticOrder S; S.init(M, N, (int)gridDim.x, c);
    pg8::gemm_phase<Epi, pg8::StaticOrder, false, true>((PG8_LAS unsigned char*)lds, g, S, E, nullptr);
}

DI float gelu_erf(float s) { return 0.5f * s * (1.0f + erff(s * 0.70710678118654752f)); }
DI void p_ada2(unsigned char* lds_, const float* __restrict__ cond, const float* __restrict__ ada_w, const float* __restrict__ ada_b, float* __restrict__ ada) {
    lptr lds = (lptr)lds_; LAS float* cs = (LAS float*)lds; LAS float* part = (LAS float*)(lds + 9 * DM * 4);
    const int tid = tid_opaque(), w = tid >> 6, lane = tid & 63, kq = lane >> 4, cq = lane & 15;
    for (int e = tid; e < 9 * DM; e += 512) cs[e] = cond[e];
    __syncthreads();
    constexpr int NUN = 4 * NMOD * DM / 64;
    for (int u = blockIdx.x; u < NUN; u += gridDim.x) {
        const int i = u / (NMOD * DM / 64), n0 = (u % (NMOD * DM / 64)) * 64;
        const float* wp = ada_w + ((size_t)i * DM + w * 256 + kq) * (NMOD * DM) + n0 + cq * 4;
        float acc[9][4];
#pragma unroll
        for (int b = 0; b < 9; ++b) { acc[b][0] = 0.f; acc[b][1] = 0.f; acc[b][2] = 0.f; acc[b][3] = 0.f; }
        for (int kk = 0; kk < 64; kk += 8) {
            float4 wv[8];
#pragma unroll
            for (int j = 0; j < 8; ++j) wv[j] = *(const float4*)(wp + (size_t)(kk + j) * 4 * (NMOD * DM));
#pragma unroll
            for (int j = 0; j < 8; ++j) { const int k = w * 256 + (kk + j) * 4 + kq;
#pragma unroll
                for (int b = 0; b < 9; ++b) { const float c = cs[b * DM + k]; acc[b][0] += c * wv[j].x; acc[b][1] += c * wv[j].y; acc[b][2] += c * wv[j].z; acc[b][3] += c * wv[j].w; } }
        }
#pragma unroll
        for (int b = 0; b < 9; ++b)
#pragma unroll
            for (int q = 0; q < 4; ++q) { float v = acc[b][q]; v += __shfl_xor(v, 16); v += __shfl_xor(v, 32); acc[b][q] = v; }
        if (kq == 0) {
#pragma unroll
            for (int b = 0; b < 9; ++b) *(LAS f32x4*)(part + (w * 9 + b) * 64 + cq * 4) = (f32x4){acc[b][0], acc[b][1], acc[b][2], acc[b][3]};
        }
        __syncthreads();
        for (int e = tid; e < 9 * 64; e += 512) { const int b = e >> 6, c = e & 63; float sum = ada_b[i * NMOD * DM + n0 + c];
#pragma unroll
            for (int ww = 0; ww < 8; ++ww) sum += part[(ww * 9 + b) * 64 + c];
            ada[((size_t)i * 9 + b) * NMOD * DM + n0 + c] = sum; }
        __syncthreads();
    }
}
typedef float f32x16 __attribute__((ext_vector_type(16)));
template <int L> DI void p_hy_filt3(const float* __restrict__ h3, const float* __restrict__ w3, const float* __restrict__ decay, const float* __restrict__ fbias, bf16_t* __restrict__ G) {
    const int tid = tid_opaque(), lane = tid & 63, n = lane & 31, hh = lane >> 5;
    constexpr int NTT = L / 32, TPW = NTT >= 8 ? 8 : NTT, NPART = NTT / TPW, NWU = 256 * NPART;
    const float invL = 1.0f / (float)L;
    for (int wu = blockIdx.x * 8 + (tid >> 6); wu < NWU; wu += gridDim.x * 8) {
        const int part = wu >> 8, combo = wu & 255, dtile = combo & 63, od = combo >> 6, o = od >> 1, dir = od & 1;
        const int d = 32 * dtile + n, col = o * 2 * DM + dir * DM + d;
        bf16x8 bfr[4];
#pragma unroll
        for (int s = 0; s < 4; ++s) { float wv[8];
#pragma unroll
            for (int i = 0; i < 8; ++i) wv[i] = w3[(size_t)(16 * s + 8 * hh + i) * 4 * DM + col];
            u32x4 bv; bv.x = pk_bf16(wv[0], wv[1]); bv.y = pk_bf16(wv[2], wv[3]); bv.z = pk_bf16(wv[4], wv[5]); bv.w = pk_bf16(wv[6], wv[7]); bfr[s] = __builtin_bit_cast(bf16x8, bv); }
        const float dec = fabsf(decay[o * DM + d]) * invL, fb = fbias[o * DM + d];
        bf16_t* gp = G + ((size_t)o * DM + d) * (2 * L);
        if (dir == 0 && part == NPART - 1 && hh == 0) gp[0] = 0;
#pragma unroll 2
        for (int tt = 0; tt < TPW; ++tt) {
            const int t0 = 32 * (part * TPW + tt);
            f32x16 acc;
#pragma unroll
            for (int r = 0; r < 16; ++r) acc[r] = 0.f;
#pragma unroll
            for (int s = 0; s < 4; ++s) { const float* ap = h3 + (size_t)(t0 + n) * 64 + 16 * s + 8 * hh; const f32x4 a0 = *(const f32x4*)ap, a1 = *(const f32x4*)(ap + 4);
                u32x4 av; av.x = pk_bf16(a0[0], a0[1]); av.y = pk_bf16(a0[2], a0[3]); av.z = pk_bf16(a1[0], a1[1]); av.w = pk_bf16(a1[2], a1[3]);
                acc = __builtin_amdgcn_mfma_f32_32x32x16_bf16(__builtin_bit_cast(bf16x8, av), bfr[s], acc, 0, 0, 0); }
#pragma unroll
            for (int q = 0; q < 4; ++q) { const int tq = t0 + 8 * q + 4 * hh; float v[4];
#pragma unroll
                for (int i = 0; i < 4; ++i) { v[i] = acc[4 * q + i] * (__expf(-(float)(tq + i) * dec) + 0.05f); if (dir == 0 && tq + i == 0) v[i] += fb; }
                if (dir == 0) {
#pragma unroll
                    for (int i = 0; i < 4; ++i) gp[L - tq - i] = f2bf(v[i]);
                } else if (tq == 0) {
#pragma unroll
                    for (int i = 1; i < 4; ++i) gp[L + i] = f2bf(v[i]);
                } else { u32x2 w; w.x = pk_bf16(v[0], v[1]); w.y = pk_bf16(v[2], v[3]); *(u32x2*)(gp + L + tq) = w; }
            }
        }
    }
}

constexpr int HY_CS = 8224;
constexpr int HY_ZPAD = 512;
constexpr int HY_ZS = 3080;
constexpr int HY_XS = 2056;
constexpr int HY_F_OFF = 0, HY_Z_OFF = 4 * HY_CS, HY_X_OFF = HY_Z_OFF + 8 * HY_ZS * 2, HY_END = HY_X_OFF + 8 * HY_XS * 2;
static_assert(HY_END <= 2 * LDS_HALF, "hyena LDS");
template <int L> struct HyFilt { u32x4 lo[(2 * L / 8 + 2 + 511) / 512], hi[(2 * L / 8 + 2 + 511) / 512]; };
template <int L> DI void hy_issue_filter(HyFilt<L>& R, const bf16_t* __restrict__ g, int tid) {
#pragma unroll
    for (int it = 0; it < (2 * L / 8 + 2 + 511) / 512; ++it) { const int idx = tid + 512 * it, z0 = (idx - 1) * 8;
        R.lo[it] = (u32x4){0u, 0u, 0u, 0u}; R.hi[it] = (u32x4){0u, 0u, 0u, 0u};
        if (idx < 2 * L / 8 + 2) { if (z0 >= 0 && z0 < 2 * L) R.lo[it] = *(const u32x4*)(g + z0); if (z0 + 8 >= 0 && z0 + 8 < 2 * L) R.hi[it] = *(const u32x4*)(g + z0 + 8); } }
}
template <int L> DI void hy_commit_filter(const HyFilt<L>& R, lptr F, int tid) {
#pragma unroll
    for (int it = 0; it < (2 * L / 8 + 2 + 511) / 512; ++it) { const int idx = tid + 512 * it, z0 = (idx - 1) * 8;
        if (idx < 2 * L / 8 + 2) {
            const u32x4 lo = R.lo[it], hi = R.hi[it]; u32x4 c1, c2, c3;
            c1.x = __builtin_amdgcn_alignbit(lo.y, lo.x, 16); c1.y = __builtin_amdgcn_alignbit(lo.z, lo.y, 16); c1.z = __builtin_amdgcn_alignbit(lo.w, lo.z, 16); c1.w = __builtin_amdgcn_alignbit(hi.x, lo.w, 16);
            c2.x = lo.y; c2.y = lo.z; c2.z = lo.w; c2.w = hi.x;
            c3.x = __builtin_amdgcn_alignbit(lo.z, lo.y, 16); c3.y = __builtin_amdgcn_alignbit(lo.w, lo.z, 16); c3.z = __builtin_amdgcn_alignbit(hi.x, lo.w, 16); c3.w = __builtin_amdgcn_alignbit(hi.y, hi.x, 16);
            const int off = (z0 + 8) * 2;
            *(LAS u32x4*)(F + off) = lo; *(LAS u32x4*)(F + HY_CS + off) = c1; *(LAS u32x4*)(F + 2 * HY_CS + off) = c2; *(LAS u32x4*)(F + 3 * HY_CS + off) = c3; } }
}
template <int L> struct HyPart { u32x4 raw[(L + 511) / 512]; unsigned short pv[(L + 511) / 512], nx[(L + 511) / 512]; };
template <int L> DI void hy_issue_part(HyPart<L>& R, const bf16_t* __restrict__ urow, int tid) {
#pragma unroll
    for (int it = 0; it < (L + 511) / 512; ++it) { const int e8 = tid + 512 * it, e = e8 * 8, t0 = e % L;
        R.raw[it] = (u32x4){0u, 0u, 0u, 0u}; R.pv[it] = 0; R.nx[it] = 0;
        if (e8 < L) { R.raw[it] = *(const u32x4*)(urow + e); if (t0 > 0) R.pv[it] = urow[e - 1]; if (t0 + 8 < L) R.nx[it] = urow[e + 8]; } }
}
template <int L> DI void hy_commit_part(const HyPart<L>& R, float w0, float w1, float w2, float bb, lptr dst, int dstride, int doff, int tid) {
#pragma unroll
    for (int it = 0; it < (L + 511) / 512; ++it) { const int e8 = tid + 512 * it, e = e8 * 8, b = e / L, t0 = e % L;
        if (e8 < L) {
            const u32x4 raw = R.raw[it]; float x[10];
            x[0] = bf2f(R.pv[it]); x[9] = bf2f(R.nx[it]);
            x[1] = __uint_as_float(raw.x << 16); x[2] = __uint_as_float(raw.x & 0xffff0000u); x[3] = __uint_as_float(raw.y << 16); x[4] = __uint_as_float(raw.y & 0xffff0000u);
            x[5] = __uint_as_float(raw.z << 16); x[6] = __uint_as_float(raw.z & 0xffff0000u); x[7] = __uint_as_float(raw.w << 16); x[8] = __uint_as_float(raw.w & 0xffff0000u);
            float o[8];
#pragma unroll
            for (int j = 0; j < 8; ++j) o[j] = bb + w0 * x[j] + w1 * x[j + 1] + w2 * x[j + 2];
            u32x4 w; w.x = pk_bf16(o[0], o[1]); w.y = pk_bf16(o[2], o[3]); w.z = pk_bf16(o[4], o[5]); w.w = pk_bf16(o[6], o[7]);
            *(LAS u32x4*)(dst + (size_t)(b * dstride + doff + t0) * 2) = w; } }
}
template <int L, int NT, int NSTEP> DI void hy_conv_loop(f32x16 (&acc)[NT], lptr F, lptr Z, int T0w, int lane) {
    static_assert(NSTEP % 2 == 0 && NSTEP >= 4, "step count");
    const int i = lane & 31, h = lane >> 5, r = (4 - (i & 3)) & 3, col = lane & 31, b = col >> 2, di = col & 3;
    const int lb_lo = T0w - (L - 16);
    lptr ap = F + r * HY_CS + (L - lb_lo + 8 * h - i - r + 8) * 2;
    lptr bp = Z + (b * HY_ZS + HY_ZPAD + T0w + 32 * di - lb_lo + 8 * h) * 2;
    u32x2 a0[2], a1[2]; bf16x8 bq[2][NT];
#define HY_LOADF(s_) do { a0[s_] = *(const volatile LAS u32x2*)ap; a1[s_] = *(const volatile LAS u32x2*)(ap + 8); _Pragma("unroll") for (int m = 0; m < NT; ++m) bq[s_][m] = *(const LAS bf16x8*)(bp + m * 256); ap -= 32; bp -= 32; } while (0)
#define HY_MMA(s_, MASK) do { u32x4 av; av.x = a0[s_].x; av.y = a0[s_].y; av.z = a1[s_].x; av.w = a1[s_].y; const bf16x8 af = __builtin_bit_cast(bf16x8, av); \
        _Pragma("unroll") for (int m = 0; m < NT; ++m) if (((MASK) >> m) & 1) acc[m] = __builtin_amdgcn_mfma_f32_32x32x16_bf16(af, bq[s_][m], acc[m], 0, 0, 0); } while (0)
#define HY_REGION(N_, MASK) do { _Pragma("unroll 1") for (int st = 0; st < (N_); st += 2) { HY_LOADF(1); __builtin_amdgcn_sched_barrier(0); HY_MMA(0, MASK); __builtin_amdgcn_sched_barrier(0); \
        HY_LOADF(0); __builtin_amdgcn_sched_barrier(0); HY_MMA(1, MASK); __builtin_amdgcn_sched_barrier(0); } } while (0)
    HY_LOADF(0);
    if constexpr (NT == 4) {
        constexpr int FULL = NSTEP - 8 * 3 - 8 * 3;
        HY_REGION(8, 0x1); HY_REGION(8, 0x3); HY_REGION(8, 0x7); HY_REGION(FULL, 0xF); HY_REGION(8, 0xE); HY_REGION(8, 0xC); HY_REGION(6, 0x8);
        HY_LOADF(1); __builtin_amdgcn_sched_barrier(0); HY_MMA(0, 0x8); HY_MMA(1, 0x8);
    } else {
        HY_REGION(NSTEP - 2, (1 << NT) - 1);
        HY_LOADF(1); __builtin_amdgcn_sched_barrier(0); HY_MMA(0, (1 << NT) - 1); HY_MMA(1, (1 << NT) - 1);
    }
#undef HY_LOADF
#undef HY_MMA
#undef HY_REGION
}
template <int L> DI void p_hyena_unit(unsigned char* lds_, const bf16_t* __restrict__ Ut, const float* __restrict__ cw, const float* __restrict__ cb, const bf16_t* __restrict__ G, bf16_t* __restrict__ Yt, int d, int tok0) {
    constexpr int NT = L >= 2048 ? 4 : 1;
    constexpr int NSTEP = (L - 16 + 96 + 128 * (NT - 1)) / 16 + 1;
    lptr lds = (lptr)lds_; lptr F = lds + HY_F_OFF; lptr Z = lds + HY_Z_OFF; lptr X = lds + HY_X_OFF;
    const int tid = tid_opaque(), wave = tid >> 6, lane = tid & 63;
    const int T0w = wave * NT * 128; const bool active = T0w < L;
    const int col = lane & 31, hh = lane >> 5, b = col >> 2, di = col & 3;
    const bf16_t* u0 = Ut + (size_t)d * T_ALL + tok0; const bf16_t* u1 = Ut + (size_t)(DM + d) * T_ALL + tok0; const bf16_t* u2 = Ut + (size_t)(2 * DM + d) * T_ALL + tok0;
    {
        HyFilt<L> f0; HyPart<L> pv, px1;
        hy_issue_filter<L>(f0, G + (size_t)d * (2 * L), tid); hy_issue_part<L>(pv, u0, tid); hy_issue_part<L>(px1, u1, tid);
        hy_commit_filter<L>(f0, F, tid);
        hy_commit_part<L>(pv, cw[d], cw[3 * DM + d], cw[6 * DM + d], cb[d], Z, HY_ZS, HY_ZPAD, tid);
        hy_commit_part<L>(px1, cw[DM + d], cw[4 * DM + d], cw[7 * DM + d], cb[DM + d], X, HY_XS, 0, tid);
    }
    if (L < 2048) { for (int e = tid; e < 8 * 32; e += 512) *(LAS u32x4*)(Z + ((e >> 5) * HY_ZS + HY_ZPAD + L + (e & 31) * 8) * 2) = (u32x4){0u, 0u, 0u, 0u}; }
    HyFilt<L> f1; HyPart<L> px2;
    hy_issue_filter<L>(f1, G + ((size_t)DM + d) * (2 * L), tid); hy_issue_part<L>(px2, u2, tid);
    __syncthreads();
    f32x16 acc[NT];
#pragma unroll
    for (int m = 0; m < NT; ++m)
#pragma unroll
        for (int q = 0; q < 16; ++q) acc[m][q] = 0.f;
    if (active) hy_conv_loop<L, NT, NSTEP>(acc, F, Z, T0w, lane);
    __syncthreads();
    if (active) {
#pragma unroll
        for (int m = 0; m < NT; ++m)
#pragma unroll
            for (int g = 0; g < 4; ++g) { const int t4 = T0w + 128 * m + 32 * di + 8 * g + 4 * hh;
                const u32x2 xv = *(const LAS u32x2*)(X + (b * HY_XS + t4) * 2);
                const float z0 = __uint_as_float(xv.x << 16) * acc[m][4 * g + 0], z1 = __uint_as_float(xv.x & 0xffff0000u) * acc[m][4 * g + 1];
                const float z2 = __uint_as_float(xv.y << 16) * acc[m][4 * g + 2], z3 = __uint_as_float(xv.y & 0xffff0000u) * acc[m][4 * g + 3];
                u32x2 zw; zw.x = pk_bf16(z0, z1); zw.y = pk_bf16(z2, z3);
                *(LAS u32x2*)(Z + (b * HY_ZS + HY_ZPAD + t4) * 2) = zw; }
    }
    hy_commit_filter<L>(f1, F, tid);
    __syncthreads();
    hy_commit_part<L>(px2, cw[2 * DM + d], cw[5 * DM + d], cw[8 * DM + d], cb[2 * DM + d], X, HY_XS, 0, tid);
    __syncthreads();
#pragma unroll
    for (int m = 0; m < NT; ++m)
#pragma unroll
        for (int q = 0; q < 16; ++q) acc[m][q] = 0.f;
    if (active) hy_conv_loop<L, NT, NSTEP>(acc, F, Z, T0w, lane);
    if (active) {
#pragma unroll
        for (int m = 0; m < NT; ++m)
#pragma unroll
            for (int g = 0; g < 4; ++g) { const int t4 = T0w + 128 * m + 32 * di + 8 * g + 4 * hh;
                lptr xp = X + (b * HY_XS + t4) * 2; const u32x2 xv = *(const LAS u32x2*)xp;
                const float y0 = __uint_as_float(xv.x << 16) * acc[m][4 * g + 0], y1 = __uint_as_float(xv.x & 0xffff0000u) * acc[m][4 * g + 1];
                const float y2 = __uint_as_float(xv.y << 16) * acc[m][4 * g + 2], y3 = __uint_as_float(xv.y & 0xffff0000u) * acc[m][4 * g + 3];
                u32x2 yw; yw.x = pk_bf16(y0, y1); yw.y = pk_bf16(y2, y3);
                *(LAS u32x2*)xp = yw; }
    }
    __syncthreads();
    for (int e8 = tid; e8 < L; e8 += 512) { const int e = e8 * 8, bb = e / L, t0 = e % L; *(u32x4*)(Yt + (size_t)d * T_ALL + tok0 + e) = *(const LAS u32x4*)(X + (bb * HY_XS + t0) * 2); }
    __syncthreads();
}
template <bool WITH_CTX> DI void p_hyena(unsigned char* lds, const bf16_t* __restrict__ Ut, const float* __restrict__ cw, const float* __restrict__ cb, const bf16_t* __restrict__ G, const bf16_t* __restrict__ Gc, bf16_t* __restrict__ Yt) {
    for (int e = tid_opaque(); e < 8 * HY_ZS / 8; e += 512) *(LAS u32x4*)((lptr)lds + HY_Z_OFF + e * 16) = (u32x4){0u, 0u, 0u, 0u};
    __syncthreads();
    for (int d = blockIdx.x; d < DM; d += gridDim.x) {
        p_hyena_unit<SEQ>(lds, Ut, cw, cb, G, Yt, d, 0);
        if constexpr (WITH_CTX) p_hyena_unit<CTX>(lds, Ut, cw, cb, Gc, Yt, d, T_LAT);
    }
}
DI void p_transpose_yt(unsigned char* lds_, const bf16_t* __restrict__ Yt, bf16_t* __restrict__ Y, int nrows) {
    const int t = tid_opaque(), half = t >> 8, tt = t & 255; lptr tile = (lptr)lds_ + half * (64 * 66 * 2);
    const int ntok = nrows / 64, nun = ntok * (DM / 64), nvb = gridDim.x * 2;
    for (int it = 0, u = blockIdx.x * 2 + half; it < (nun + nvb - 1) / nvb; ++it, u += nvb) {
        const bool act = u < nun; const int tk0 = (u % ntok) * 64, d0 = (u / ntok) * 64;
        if (act) { for (int k = tt; k < 64 * 8; k += 256) { const int dr = k >> 3, c8 = (k & 7) * 8; const u32x4 v = *(const u32x4*)(Yt + (size_t)(d0 + dr) * T_ALL + tk0 + c8);
                LAS unsigned* p = (LAS unsigned*)(tile + (dr * 66 + c8) * 2); p[0] = v.x; p[1] = v.y; p[2] = v.z; p[3] = v.w; } }
        __syncthreads();
        if (act) { for (int k = tt; k < 64 * 8; k += 256) { const int tr = k >> 3, d8 = (k & 7) * 8; unsigned short e[8];
#pragma unroll
                for (int j = 0; j < 8; ++j) e[j] = *(const LAS unsigned short*)(tile + ((d8 + j) * 66 + tr) * 2);
                u32x4 w; w.x = e[0] | ((unsigned)e[1] << 16); w.y = e[2] | ((unsigned)e[3] << 16); w.z = e[4] | ((unsigned)e[5] << 16); w.w = e[6] | ((unsigned)e[7] << 16);
                *(u32x4*)(Y + (size_t)(tk0 + tr) * DM + d0 + d8) = w; } }
        __syncthreads();
    }
}


constexpr int AT_KS = 288, AT_VS = 272;
constexpr int AT_K_OFF = 0, AT_V_OFF = 128 * AT_KS, AT_END = AT_V_OFF + 128 * AT_VS;
static_assert(AT_END <= 2 * LDS_HALF, "attention LDS");
DI void at_prefetch(u32x4 (&kr)[4], u32x4 (&vr)[4], const bf16_t* __restrict__ Kb, const bf16_t* __restrict__ Vt, int kvh, int krow0, int tid) {
#pragma unroll
    for (int i = 0; i < 4; ++i) { const int c = tid + 512 * i, row = c >> 4, part = c & 15;
        kr[i] = *(const u32x4*)(Kb + (size_t)(krow0 + row) * 512 + kvh * 128 + part * 8);
        vr[i] = *(const u32x4*)(Vt + (size_t)(kvh * 128 + row) * T_ALL + krow0 + part * 8); }
}
DI void at_commit(const u32x4 (&kr)[4], const u32x4 (&vr)[4], lptr lds, int tid) {
#pragma unroll
    for (int i = 0; i < 4; ++i) { const int c = tid + 512 * i, row = c >> 4, part = c & 15;
        *(LAS u32x4*)(lds + AT_K_OFF + row * AT_KS + part * 16) = kr[i];
        *(LAS u32x4*)(lds + AT_V_OFF + row * AT_VS + part * 16) = vr[i]; }
}
DI void p_attn(unsigned char* lds_, const bf16_t* __restrict__ Q, const bf16_t* __restrict__ Kb, const bf16_t* __restrict__ Vt, const float* __restrict__ sink, bf16_t* __restrict__ O, bool with_ctxq) {
    lptr lds = (lptr)lds_;
    const int tid = tid_opaque(), wave = tid >> 6, lane = tid & 63, fr = lane & 15, g = lane >> 4;
    const int nlat = NB * 16 * NQH, nun = nlat + (with_ctxq ? NB * NQH * 2 : 0);
    const float c2 = 0.08838834764831845f * 1.4426950408889634f;
    for (int u = blockIdx.x; u < nun; u += gridDim.x) {
        int b, j, hq, qrow0, nwin, jlo;
        if (u < nlat) { hq = u & 15; j = (u >> 4) & 15; b = u >> 8; qrow0 = b * SEQ + j * 128; jlo = j > 0 ? j - 1 : 0; nwin = (j < 15 ? j + 1 : 15) - jlo + 1; }
        else { const int v = u - nlat; hq = v & 15; const int cb = (v >> 4) & 1; b = v >> 5; j = 0; jlo = 0; nwin = 0; qrow0 = T_LAT + b * CTX + cb * 128; }
        const int nblk = nwin + 2, kvh = hq >> 2;
#define AT_KROW(kb) ((kb) < nwin ? b * SEQ + (jlo + (kb)) * 128 : T_LAT + b * CTX + ((kb) - nwin) * 128)
        const int qw = 16 * wave;
        bf16x8 qf[4];
#pragma unroll
        for (int ks = 0; ks < 4; ++ks) qf[ks] = *(const bf16x8*)(Q + (size_t)(qrow0 + qw + fr) * DM + hq * 128 + 32 * ks + 8 * g);
        const float sk2 = sink[hq] * 1.4426950408889634f;
        float mrun = sk2, lrun = g == 0 ? 1.f : 0.f;
        f32x4 oacc[8];
#pragma unroll
        for (int dt = 0; dt < 8; ++dt) oacc[dt] = (f32x4){0.f, 0.f, 0.f, 0.f};
        u32x4 kr[4], vr[4];
        at_prefetch(kr, vr, Kb, Vt, kvh, AT_KROW(0), tid);
#pragma unroll 1
        for (int kb = 0; kb < nblk; ++kb) {
            const int mask = kb < nwin ? (jlo + kb < j ? 1 : (jlo + kb > j ? 2 : 0)) : 0; const int krow_next = AT_KROW(kb + 1);
            __syncthreads();
            at_commit(kr, vr, lds, tid);
            __syncthreads();
            if (kb + 1 < nblk) at_prefetch(kr, vr, Kb, Vt, kvh, krow_next, tid);
            f32x4 sacc[8];
#pragma unroll
            for (int kt = 0; kt < 8; ++kt) { sacc[kt] = (f32x4){0.f, 0.f, 0.f, 0.f};
#pragma unroll
                for (int ks = 0; ks < 4; ++ks) { const bf16x8 kf = *(const LAS bf16x8*)(lds + AT_K_OFF + (16 * kt + fr) * AT_KS + (32 * ks + 8 * g) * 2);
                    sacc[kt] = __builtin_amdgcn_mfma_f32_16x16x32_bf16(kf, qf[ks], sacc[kt], 0, 0, 0); } }
            bf16x8 pf[4];
            {
                const int a = qw + fr; float mx = mrun;
                const int klo = (mask == 1 ? a : 0) - 4 * g, kspan = (mask == 1 ? 127 - a : (mask == 2 ? a : 127));
                if (mask != 0) {
#pragma unroll
                    for (int kt = 0; kt < 8; ++kt)
#pragma unroll
                        for (int r = 0; r < 4; ++r) { float v = sacc[kt][r] * c2;
                            const bool dead = (unsigned)(16 * kt + r - klo) > (unsigned)kspan; v = dead ? -__builtin_inff() : v; sacc[kt][r] = v; mx = fmaxf(mx, v); }
                } else {
#pragma unroll
                    for (int kt = 0; kt < 8; ++kt)
#pragma unroll
                        for (int r = 0; r < 4; ++r) { const float v = sacc[kt][r] * c2; sacc[kt][r] = v; mx = fmaxf(mx, v); }
                }
                mx = fmaxf(mx, __shfl_xor(mx, 16)); mx = fmaxf(mx, __shfl_xor(mx, 32));
                const float alpha = __builtin_amdgcn_exp2f(mrun - mx); mrun = mx; float ls = 0.f;
#pragma unroll
                for (int kt = 0; kt < 8; ++kt)
#pragma unroll
                    for (int r = 0; r < 4; ++r) { const float p = __builtin_amdgcn_exp2f(sacc[kt][r] - mx); sacc[kt][r] = p; ls += p; }
                lrun = lrun * alpha + ls;
#pragma unroll
                for (int dt = 0; dt < 8; ++dt) oacc[dt] *= alpha;
#pragma unroll
                for (int p4 = 0; p4 < 4; ++p4) { u32x4 w; w.x = pk_bf16(sacc[2 * p4][0], sacc[2 * p4][1]); w.y = pk_bf16(sacc[2 * p4][2], sacc[2 * p4][3]);
                    w.z = pk_bf16(sacc[2 * p4 + 1][0], sacc[2 * p4 + 1][1]); w.w = pk_bf16(sacc[2 * p4 + 1][2], sacc[2 * p4 + 1][3]); pf[p4] = __builtin_bit_cast(bf16x8, w); }
            }
            u32x2 vlo[2][4], vhi[2][4];
#define AT_LOADV(s_, dt_) do { _Pragma("unroll") for (int p4 = 0; p4 < 4; ++p4) { lptr vp = lds + AT_V_OFF + (16 * (dt_) + fr) * AT_VS + (32 * p4 + 4 * g) * 2; vlo[s_][p4] = *(const volatile LAS u32x2*)vp; vhi[s_][p4] = *(const volatile LAS u32x2*)(vp + 32); } } while (0)
            AT_LOADV(0, 0);
#pragma unroll
            for (int dt = 0; dt < 8; ++dt) {
                if (dt + 1 < 8) { if (dt & 1) AT_LOADV(0, dt + 1); else AT_LOADV(1, dt + 1); }
                __builtin_amdgcn_sched_barrier(0);
#pragma unroll
                for (int p4 = 0; p4 < 4; ++p4) { u32x4 vv; vv.x = vlo[dt & 1][p4].x; vv.y = vlo[dt & 1][p4].y; vv.z = vhi[dt & 1][p4].x; vv.w = vhi[dt & 1][p4].y; const bf16x8 vf = __builtin_bit_cast(bf16x8, vv);
                    oacc[dt] = __builtin_amdgcn_mfma_f32_16x16x32_bf16(vf, pf[p4], oacc[dt], 0, 0, 0); }
                __builtin_amdgcn_sched_barrier(0);
            }
#undef AT_LOADV
        }
        {   float l = lrun; l += __shfl_xor(l, 16); l += __shfl_xor(l, 32); const float inv = 1.0f / l;
            unsigned char* op = (unsigned char*)O + (size_t)(qrow0 + qw + fr) * DM + hq * 128 + 4 * g;
#pragma unroll
            for (int dt = 0; dt < 8; ++dt) *(unsigned*)(op + 16 * dt) = pk_fp8x4(oacc[dt][0] * inv, oacc[dt][1] * inv, oacc[dt][2] * inv, oacc[dt][3] * inv, F8_O); }
    }
    __syncthreads();
}


constexpr int TK_KS = 288;
constexpr int TK_K_OFF = 0, TK_W_OFF = 2 * 128 * TK_KS, TK_END = TK_W_OFF + 8 * 768;
static_assert(TK_END <= 2 * LDS_HALF, "topk LDS");
DI unsigned ord_key(float v) { const unsigned b = __float_as_uint(v); return b ^ ((unsigned)((int)b >> 31) | 0x80000000u); }
DI float ord_val(unsigned k) { return __uint_as_float((k & 0x80000000u) ? (k ^ 0x80000000u) : ~k); }
template <int CTRL> DI unsigned dpp_u(unsigned x) { return (unsigned)__builtin_amdgcn_update_dpp(0, (int)x, CTRL, 0xF, 0xF, true); }
DI unsigned umax(unsigned a, unsigned b) { return a > b ? a : b; }
DI unsigned rowmax16(unsigned x) { x = umax(x, dpp_u<0xB1>(x)); x = umax(x, dpp_u<0x4E>(x)); x = umax(x, dpp_u<0x141>(x)); x = umax(x, dpp_u<0x140>(x)); return x; }
DI float rowsum16(float x) { x += __uint_as_float(dpp_u<0xB1>(__float_as_uint(x))); x += __uint_as_float(dpp_u<0x4E>(__float_as_uint(x))); x += __uint_as_float(dpp_u<0x141>(__float_as_uint(x))); x += __uint_as_float(dpp_u<0x140>(__float_as_uint(x))); return x; }
DI unsigned umin(unsigned a, unsigned b) { return a < b ? a : b; }
#define TK_CE(i, j) do { const unsigned _a = umax(key[i], key[j]), _b = umin(key[i], key[j]); key[i] = _a; key[j] = _b; } while (0)
DI unsigned row_top16(unsigned (&key)[8], int fr) {
    TK_CE(0, 1); TK_CE(2, 3); TK_CE(4, 5); TK_CE(6, 7);
    TK_CE(0, 2); TK_CE(1, 3); TK_CE(4, 6); TK_CE(5, 7);
    TK_CE(1, 2); TK_CE(5, 6);
    TK_CE(0, 4); TK_CE(1, 5); TK_CE(2, 6); TK_CE(3, 7);
    TK_CE(2, 4); TK_CE(3, 5);
    TK_CE(1, 2); TK_CE(3, 4); TK_CE(5, 6);
    unsigned sel = 0u;
#pragma unroll 16
    for (int t = 0; t < 16; ++t) {
        const unsigned m = rowmax16(key[0]); sel = (fr == t) ? m : sel;
        const bool own = key[0] == m;
        key[0] = own ? key[1] : key[0]; key[1] = own ? key[2] : key[1]; key[2] = own ? key[3] : key[2]; key[3] = own ? key[4] : key[3];
        key[4] = own ? key[5] : key[4]; key[5] = own ? key[6] : key[5]; key[6] = own ? key[7] : key[6]; key[7] = own ? 0u : key[7];
    }
    return sel;
}
#undef TK_CE
DI void p_peer_topk(unsigned char* lds_, const bf16_t* __restrict__ qb, const float* __restrict__ keys1, const float* __restrict__ keys2, int* __restrict__ idx, float* __restrict__ gate, int nrows) {
    lptr lds = (lptr)lds_;
    const int tid = tid_opaque(), wave = tid >> 6, lane = tid & 63, fr = lane & 15, g = lane >> 4;
    const int ntile = nrows / 16, nchunk = 32, tpc = (ntile + nchunk - 1) / nchunk;
    LAS float* wl = (LAS float*)(lds + TK_W_OFF + wave * 768 + g * 192);
    for (int u = blockIdx.x; u < 8 * nchunk; u += gridDim.x) {
        const int h = u & 7, chunk = u >> 3;
        __syncthreads();
        for (int e = tid; e < 2 * 128 * 16; e += 512) {
            const int half = e >> 11, key = (e >> 4) & 127, part = e & 15; const float* src = (half ? keys2 : keys1) + ((size_t)h * 128 + key) * 128 + part * 8;
            const float4 a = *(const float4*)src, b2 = *(const float4*)(src + 4);
            u32x4 w; w.x = pk_bf16(a.x, a.y); w.y = pk_bf16(a.z, a.w); w.z = pk_bf16(b2.x, b2.y); w.w = pk_bf16(b2.z, b2.w);
            *(LAS u32x4*)(lds + TK_K_OFF + (half * 128 + key) * TK_KS + part * 16) = w; }
        __syncthreads();
        for (int tl = chunk * tpc + wave; tl < (chunk + 1) * tpc && tl < ntile; tl += 8) {
            const int tok0 = tl * 16;
            unsigned W1[4], W2[4];
#pragma unroll
            for (int half = 0; half < 2; ++half) {
                bf16x8 qf[4];
#pragma unroll
                for (int ks = 0; ks < 4; ++ks) qf[ks] = *(const bf16x8*)(qb + (size_t)(tok0 + fr) * DM + h * 256 + half * 128 + 32 * ks + 8 * g);
                f32x4 sc[8];
#pragma unroll
                for (int nt = 0; nt < 8; ++nt) { sc[nt] = (f32x4){0.f, 0.f, 0.f, 0.f};
#pragma unroll
                    for (int ks = 0; ks < 4; ++ks) { const bf16x8 kf = *(const LAS bf16x8*)(lds + TK_K_OFF + (half * 128 + 16 * nt + fr) * TK_KS + (32 * ks + 8 * g) * 2);
                        sc[nt] = __builtin_amdgcn_mfma_f32_16x16x32_bf16(qf[ks], kf, sc[nt], 0, 0, 0); } }
#pragma unroll
                for (int r = 0; r < 4; ++r) { unsigned key[8];
#pragma unroll
                    for (int nt = 0; nt < 8; ++nt) key[nt] = (ord_key(sc[nt][r]) & ~127u) | (unsigned)(127 - (fr + 16 * nt));
                    const unsigned w = row_top16(key, fr); if (half == 0) W1[r] = w; else W2[r] = w; }
            }
#pragma unroll
            for (int r = 0; r < 4; ++r) {
                const float v1 = ord_val(W1[r] & ~127u), v2 = ord_val(W2[r] & ~127u);
                wl[fr] = v2; ((LAS int*)wl)[16 + fr] = 127 - (int)(W1[r] & 127u); ((LAS int*)wl)[32 + fr] = 127 - (int)(W2[r] & 127u);
                int j = 0; float v2c = wl[0]; unsigned sel = 0u;
#pragma unroll 16
                for (int t = 0; t < 16; ++t) {
                    const float cand = v1 + v2c;
                    const unsigned key = j < 16 ? ((ord_key(cand) & ~255u) | (unsigned)(255 - (fr * 16 + j))) : 0u;
                    const unsigned m = rowmax16(key); sel = (fr == t) ? m : sel;
                    j += (key == m) ? 1 : 0; v2c = wl[j < 16 ? j : 15];
                }
                const float sm = ord_val(sel & ~255u); const int flat = 255 - (int)(sel & 255u);
                const int e1 = ((LAS int*)wl)[16 + (flat >> 4)], e2 = ((LAS int*)wl)[32 + (flat & 15)];
                const float mx = ord_val(rowmax16(sel) & ~255u); const float p = __expf(sm - mx); const float tot = rowsum16(p);
                const size_t o = (size_t)(tok0 + 4 * g + r) * 128 + h * 16 + fr;
                idx[o] = e1 * 128 + e2; gate[o] = p / tot;
            }
        }
    }
    __syncthreads();
}


typedef float f32x2_t __attribute__((ext_vector_type(2)));
constexpr int CVT_CHUNK = 16;
constexpr int CVT_Q_WORD = 24576;
DI void p_cvt_pull(unsigned* __restrict__ qw, int max_chunks, int drain_to, const float* __restrict__ su_all, const float* __restrict__ sv_all, unsigned char* __restrict__ du_all, unsigned char* __restrict__ dv_all, float* __restrict__ sc_all) {
    const int tid = tid_opaque(), lane = tid & 63;
    constexpr int CPL = 2 * NEXP / CVT_CHUNK;
    for (int n = 0; max_chunks < 0 || n < max_chunks; ++n) {
        if (max_chunks < 0) { if ((int)__builtin_amdgcn_readfirstlane((int)__hip_atomic_load(qw, __ATOMIC_RELAXED, __HIP_MEMORY_SCOPE_AGENT)) >= drain_to) break; }
        int g0 = 0; if (lane == 0) g0 = (int)__hip_atomic_fetch_add(qw, 1u, __ATOMIC_RELAXED, __HIP_MEMORY_SCOPE_AGENT);
        g0 = __builtin_amdgcn_readfirstlane(g0);
        if (g0 >= 4 * CPL) break;
        const int L = g0 / CPL, c0 = g0 % CPL;
        const float* su = su_all + (size_t)L * NEXP * DM; const float* sv = sv_all + (size_t)L * NEXP * DM;
        unsigned char* du = du_all + (size_t)L * (NEXP * DM / 2); unsigned char* dv = dv_all + (size_t)L * (NEXP * DM / 2); float* sc = sc_all + (size_t)L * 2 * NEXP;
#pragma unroll 2
        for (int rr = 0; rr < CVT_CHUNK; ++rr) {
            const int row = c0 * CVT_CHUNK + rr;
            const bool second = row >= NEXP; const int e = second ? row - NEXP : row; const float* src = (second ? sv : su) + (size_t)e * DM + lane * 4;
            float4 v[8]; float amax = 0.f;
#pragma unroll
            for (int i = 0; i < 8; ++i) { v[i] = *(const float4*)(src + i * 256); amax = fmaxf(amax, fmaxf(fmaxf(fabsf(v[i].x), fabsf(v[i].y)), fmaxf(fabsf(v[i].z), fabsf(v[i].w)))); }
            amax = wave_max(amax);
            const float scale = amax > 0.f ? (second ? 8.0f : 10.0f) / amax : 1.0f, inv = amax > 0.f ? amax * (second ? 0.125f : 0.1f) : 1.0f;
            unsigned char* dst = (second ? dv : du) + (size_t)e * 128 + (second ? 16 * (lane & 7) + 2 * (lane >> 3) : lane * 2);
            if (second) {
#pragma unroll
                for (int i = 0; i < 8; ++i) { unsigned p = 0u; p = __builtin_amdgcn_cvt_scalef32_pk_fp4_f32(p, v[i].x * scale, v[i].y * scale, 1.0f, 0); p = __builtin_amdgcn_cvt_scalef32_pk_fp4_f32(p, v[i].z * scale, v[i].w * scale, 1.0f, 1);
                    *(unsigned short*)(dst + (size_t)i * (NEXP * 128)) = (unsigned short)p; }
            } else {
#pragma unroll
                for (int i = 0; i < 8; ++i) { const int q0 = max(-7, min(7, (int)rintf(v[i].x * scale))), q1 = max(-7, min(7, (int)rintf(v[i].y * scale))), q2 = max(-7, min(7, (int)rintf(v[i].z * scale))), q3 = max(-7, min(7, (int)rintf(v[i].w * scale)));
                    *(unsigned short*)(dst + (size_t)i * (NEXP * 128)) = (unsigned short)((unsigned)(q0 & 15) | ((unsigned)(q1 & 15) << 4) | ((unsigned)(q2 & 15) << 8) | ((unsigned)(q3 & 15) << 12)); }
            }
            if (lane == 0) sc[row] = inv;
        }
    }
}
DI int gemm_units_of(int M, int N, int G, int c) { const int nwg = (M / 256) * (N / 256); return c < nwg ? (nwg - c + G - 1) / G : 0; }
constexpr int PG_GRP = 16;
constexpr int PG_NSL = 8;
#define P4_LOAD4(buf, tab, idq, k0) do { _Pragma("unroll") for (int _kk = 0; _kk < 4; ++_kk) { const unsigned _id = idq[((k0) + _kk) >> 2][((k0) + _kk) & 3]; \
        buf[_kk] = *(const u32x4*)((tab) + (_id * 128u + toff)); } asm volatile("" ::: "memory"); } while (0)
#define P4_LOAD8(buf, tab, idq, k0) do { _Pragma("unroll") for (int _kk = 0; _kk < 8; ++_kk) { const unsigned _id = idq[((k0) + _kk) >> 2][((k0) + _kk) & 3]; \
        buf[_kk] = *(const u32x4*)((tab) + (_id * 128u + toff)); } asm volatile("" ::: "memory"); } while (0)
typedef _Float16 h2v_t __attribute__((ext_vector_type(2)));
DI int rowsum8i(int x) { x += (int)dpp_u<0xB1>((unsigned)x); x += (int)dpp_u<0x4E>((unsigned)x); x += (int)dpp_u<0x141>((unsigned)x); return x; }
DI void peer_u_wave(int t0, int xs, const unsigned* __restrict__ xd, const float* __restrict__ xsc, const int* __restrict__ idx, const unsigned char* __restrict__ pu4, float* __restrict__ part, int lane) {
    const int sub = lane & 7, eg = lane >> 3; const unsigned toff = (unsigned)xs * (NEXP * 128) + 16 * sub; const int xoff = 8 * (8 * xs + sub);
    u32x4 idA[4], idB[4], xwA[2], xwB[2];
    const float sxl = xsc[t0 + (lane & (PG_GRP - 1))];
    u32x4 bA0[8], bA1[8], bB0[8], bB1[8];
    {   u32x4 id0[4];
#pragma unroll
        for (int q = 0; q < 4; ++q) { id0[q] = *(const u32x4*)(idx + (size_t)t0 * 128 + 16 * eg + 4 * q); idA[q] = *(const u32x4*)(idx + (size_t)(t0 + 1) * 128 + 16 * eg + 4 * q); }
        xwA[0] = *(const u32x4*)(xd + (size_t)t0 * 512 + xoff); xwA[1] = *(const u32x4*)(xd + (size_t)t0 * 512 + xoff + 4);
        P4_LOAD8(bA0, pu4, id0, 0); P4_LOAD8(bA1, pu4, id0, 8); }
#define P4_DOT8(buf, k0) do { _Pragma("unroll") for (int _kk = 0; _kk < 8; ++_kk) { int ah, al; \
          \
        { const int r0_ = (int)buf[_kk][0], x0_ = (int)xh8[0]; asm("v_dot8_i32_i4 %0, %1, %2, 0" : "=v"(ah) : "v"(r0_), "v"(x0_)); } \
        _Pragma("unroll") for (int d = 1; d < 4; ++d) ah = __builtin_amdgcn_sdot8((int)buf[_kk][d], (int)xh8[d], ah, false); \
        al = ah << 4; \
        _Pragma("unroll") for (int d = 0; d < 4; ++d) al = __builtin_amdgcn_sdot8((int)buf[_kk][d], (int)xl8[d], al, false); \
        const int sd = rowsum8i(al); const int _k = (k0) + _kk; \
        if ((_k & 1) == 0) d0 = (sub == (_k >> 1)) ? sd : d0; else d1 = (sub == (_k >> 1)) ? sd : d1; } } while (0)
    typedef _Float16 h2_t __attribute__((ext_vector_type(2)));
#define P4_USTEP(C0, C1, N0, N1, IDC, IDN, XWC, XWN, tt_) do { const int t = t0 + (tt_), tn1 = (tt_) < PG_GRP - 1 ? t + 1 : t, tn2 = (tt_) < PG_GRP - 2 ? t + 2 : t; \
        _Pragma("unroll") for (int q = 0; q < 4; ++q) IDN[q] = *(const u32x4*)(idx + (size_t)tn2 * 128 + 16 * eg + 4 * q); \
        XWN[0] = *(const u32x4*)(xd + (size_t)tn1 * 512 + xoff); XWN[1] = *(const u32x4*)(xd + (size_t)tn1 * 512 + xoff + 4); \
        asm volatile("" ::: "memory"); \
        P4_LOAD8(N0, pu4, IDC, 0); P4_LOAD8(N1, pu4, IDC, 8); \
        __builtin_amdgcn_sched_barrier(0); \
        unsigned xh8[4], xl8[4]; \
        _Pragma("unroll") for (int d = 0; d < 4; ++d) { const unsigned w0 = XWC[d >> 1][2 * (d & 1)], w1 = XWC[d >> 1][2 * (d & 1) + 1]; \
            xh8[d] = __builtin_amdgcn_perm(w1, w0, 0x05040100u); xl8[d] = __builtin_amdgcn_perm(w1, w0, 0x07060302u); } \
        int d0 = 0, d1 = 0; P4_DOT8(C0, 0); P4_DOT8(C1, 8); \
        const float sx = __builtin_bit_cast(float, __builtin_amdgcn_readlane(__builtin_bit_cast(int, sxl), (tt_))); \
        *(h2_t*)(part + ((size_t)xs * T_ALL + t) * 64 + 8 * eg + sub) = (h2_t){(_Float16)((float)d0 * sx), (_Float16)((float)d1 * sx)}; \
        __builtin_amdgcn_sched_barrier(0); } while (0)
#pragma unroll 1
    for (int tt = 0; tt < PG_GRP; tt += 2) { P4_USTEP(bA0, bA1, bB0, bB1, idA, idB, xwA, xwB, tt); P4_USTEP(bB0, bB1, bA0, bA1, idB, idA, xwB, xwA, tt + 1); }
}
DI void p_peer_combine(const int* __restrict__ idx, const float* __restrict__ gate, unsigned* __restrict__ wh, const float* __restrict__ part, const float* __restrict__ sc, int nrows) {
    typedef _Float16 h2_t __attribute__((ext_vector_type(2)));
    const int tid = tid_opaque(), lane = tid & 63; const int nw = gridDim.x * 8;
    for (int t = blockIdx.x * 8 + (tid >> 6); t < nrows; t += nw) {
        const int2 id2 = *(const int2*)(idx + (size_t)t * 128 + 2 * lane); float dA = 0.f, dB = 0.f;
#pragma unroll
        for (int s2 = 0; s2 < PG_NSL; ++s2) { const h2_t p = *(const h2_t*)(part + ((size_t)s2 * T_ALL + t) * 64 + lane); dA += (float)p.x; dB += (float)p.y; }
        float2 g = *(const float2*)(gate + (size_t)t * 128 + 2 * lane);
        g.x = g.x * gelu_erf(dA * sc[id2.x]) * sc[NEXP + id2.x]; g.y = g.y * gelu_erf(dB * sc[id2.y]) * sc[NEXP + id2.y];
        const h2_t w = (h2_t){(_Float16)g.x, (_Float16)g.y}; wh[(size_t)t * 64 + lane] = __builtin_bit_cast(unsigned, w);
    }
}
template <bool DLT, bool W16, bool H32> DI void peer_v_wave(int t0, int xs, const int* __restrict__ idx, const unsigned* __restrict__ wh, const unsigned char* __restrict__ pv4, const float* __restrict__ adaL, int g_off, const float* hin, const unsigned short* __restrict__ dl, float* hio, unsigned short* h16, int lane) {
    const int sub = lane & 7, eg = lane >> 3, ccol = 256 * xs + 4 * lane; const unsigned toff = (unsigned)xs * (NEXP * 128) + 16 * sub;
    typedef _Float16 h2_t __attribute__((ext_vector_type(2)));
    auto H2U = [](h2_t x) { return __builtin_bit_cast(unsigned, x); }; auto U2H = [](unsigned x) { return __builtin_bit_cast(h2_t, x); };
    u32x4 idA[4], idB[4], whA[2], whB[2], hA, hB; u32x2 dA, dB;
    const int bi = t0 < T_LAT ? t0 >> 11 : 8;
    const f32x4 gg = *(const f32x4*)(adaL + (size_t)bi * NMOD * DM + g_off + ccol);
    u32x4 bA0[8], bA1[8], bB0[8], bB1[8];
    {   u32x4 id0[4];
#pragma unroll
        for (int q = 0; q < 4; ++q) { id0[q] = *(const u32x4*)(idx + (size_t)t0 * 128 + 16 * eg + 4 * q); idA[q] = *(const u32x4*)(idx + (size_t)(t0 + 1) * 128 + 16 * eg + 4 * q); }
        whA[0] = *(const u32x4*)(wh + (size_t)t0 * 64 + 8 * eg); whA[1] = *(const u32x4*)(wh + (size_t)t0 * 64 + 8 * eg + 4); hA = (u32x4){0u, 0u, 0u, 0u}; hB = hA; if constexpr (H32) hA = *(const u32x4*)(hin + (size_t)t0 * DM + ccol); else { const u32x2 hw_ = *(const u32x2*)(h16 + (size_t)t0 * DM + ccol); hA.x = hw_.x; hA.y = hw_.y; } dA = (u32x2){0u, 0u}; dB = dA; if constexpr (DLT) dA = *(const u32x2*)(dl + (size_t)t0 * DM + ccol);
        P4_LOAD8(bA0, pv4, id0, 0); P4_LOAD8(bA1, pv4, id0, 8); }
#define P4_ACC8(buf, WHC, k0) do { _Pragma("unroll") for (int _kk = 0; _kk < 8; ++_kk) { const h2_t wp = U2H(WHC[((k0) + _kk) >> 3][(((k0) + _kk) >> 1) & 3]); const _Float16 w1 = (((k0) + _kk) & 1) ? wp.y : wp.x; const h2_t w2 = (h2_t){w1, w1}; \
        _Pragma("unroll") for (int d = 0; d < 4; ++d) { acc[4 * d] += w2 * __builtin_amdgcn_cvt_scalef32_pk_f16_fp4(buf[_kk][d], 1.0f, 0); acc[4 * d + 1] += w2 * __builtin_amdgcn_cvt_scalef32_pk_f16_fp4(buf[_kk][d], 1.0f, 1); \
            acc[4 * d + 2] += w2 * __builtin_amdgcn_cvt_scalef32_pk_f16_fp4(buf[_kk][d], 1.0f, 2); acc[4 * d + 3] += w2 * __builtin_amdgcn_cvt_scalef32_pk_f16_fp4(buf[_kk][d], 1.0f, 3); } } } while (0)
#define P4_VSTEP(C0, C1, N0, N1, IDC, IDN, WHC, WHN, HC, HN, DC, DN, tt_) do { const int t = t0 + (tt_), tn1 = (tt_) < PG_GRP - 1 ? t + 1 : t, tn2 = (tt_) < PG_GRP - 2 ? t + 2 : t; \
        _Pragma("unroll") for (int q = 0; q < 4; ++q) IDN[q] = *(const u32x4*)(idx + (size_t)tn2 * 128 + 16 * eg + 4 * q); \
        WHN[0] = *(const u32x4*)(wh + (size_t)tn1 * 64 + 8 * eg); WHN[1] = *(const u32x4*)(wh + (size_t)tn1 * 64 + 8 * eg + 4); if constexpr (H32) HN = *(const u32x4*)(hin + (size_t)tn1 * DM + ccol); else { const u32x2 hw_ = *(const u32x2*)(h16 + (size_t)tn1 * DM + ccol); HN.x = hw_.x; HN.y = hw_.y; } if constexpr (DLT) DN = *(const u32x2*)(dl + (size_t)tn1 * DM + ccol); \
        asm volatile("" ::: "memory"); \
        P4_LOAD8(N0, pv4, IDC, 0); P4_LOAD8(N1, pv4, IDC, 8); \
        __builtin_amdgcn_sched_barrier(0); \
        h2_t acc[16]; \
        _Pragma("unroll") for (int i = 0; i < 16; ++i) acc[i] = (h2_t){(_Float16)0.f, (_Float16)0.f}; \
        P4_ACC8(C0, WHC, 0); P4_ACC8(C1, WHC, 8); \
        h2_t s1[8], s2[4], s3[2]; \
        _Pragma("unroll") for (int i = 0; i < 8; ++i) { const auto r = __builtin_amdgcn_permlane32_swap(H2U(acc[i]), H2U(acc[i + 8]), false, false); s1[i] = U2H(r[0]) + U2H(r[1]); } \
        _Pragma("unroll") for (int i = 0; i < 4; ++i) { const auto r = __builtin_amdgcn_permlane16_swap(H2U(s1[i]), H2U(s1[i + 4]), false, false); s2[i] = U2H(r[0]) + U2H(r[1]); } \
        _Pragma("unroll") for (int i = 0; i < 2; ++i) { const bool up = (lane & 8) != 0; const unsigned keep = up ? H2U(s2[i + 2]) : H2U(s2[i]), send = up ? H2U(s2[i]) : H2U(s2[i + 2]); \
            s3[i] = U2H(keep) + U2H(dpp_u<0x128>(send)); } \
        const h2_t dd0 = U2H(DC.x), dd1 = U2H(DC.y); f32x4 o; if constexpr (H32) o = __builtin_bit_cast(f32x4, HC); else { const h2_t b0 = U2H(HC.x), b1 = U2H(HC.y); o = (f32x4){(float)b0.x, (float)b0.y, (float)b1.x, (float)b1.y}; } o[0] += (float)dd0.x + gg[0] * (float)s3[0].x; o[1] += (float)dd0.y + gg[1] * (float)s3[0].y; o[2] += (float)dd1.x + gg[2] * (float)s3[1].x; o[3] += (float)dd1.y + gg[3] * (float)s3[1].y; \
        if constexpr (W16) { u32x2 ow; ow.x = pk_f16(o[0], o[1]); ow.y = pk_f16(o[2], o[3]); *(u32x2*)(h16 + (size_t)t * DM + ccol) = ow; } else *(f32x4*)(hio + (size_t)t * DM + ccol) = o; \
        __builtin_amdgcn_sched_barrier(0); } while (0)
#pragma unroll 1
    for (int tt = 0; tt < PG_GRP; tt += 2) { P4_VSTEP(bA0, bA1, bB0, bB1, idA, idB, whA, whB, hA, hB, dA, dB, tt); P4_VSTEP(bB0, bB1, bA0, bA1, idB, idA, whB, whA, hB, hA, dB, dA, tt + 1); }
}
template <bool VPHASE, bool DLT = false, bool W16 = false, bool H32 = true> DI void p_peer_sliced(unsigned* __restrict__ qctr, int nrows, const unsigned* __restrict__ xd, const float* __restrict__ xsc, const int* __restrict__ idx, const unsigned* __restrict__ wh, float* __restrict__ part,
                                            const unsigned char* __restrict__ tab4, const float* __restrict__ adaL, int g_off, float* __restrict__ hio, const float* __restrict__ xin = nullptr, const float* __restrict__ cin = nullptr, const unsigned short* __restrict__ dl = nullptr, unsigned short* h16 = nullptr) {
    const int lane = tid_opaque() & 63;
    const int x0 = (int)(xb_xcc_id() & 7u);
    int j = 0, xs = x0;
    int nxt = 0; if (lane == 0) nxt = (int)__hip_atomic_fetch_add(qctr + 64 * xs, (unsigned)PG_GRP, __ATOMIC_RELAXED, __HIP_MEMORY_SCOPE_AGENT);
    while (j < PG_NSL) {
        const int t0 = __builtin_amdgcn_readfirstlane(nxt);
        if (t0 >= nrows) { ++j; if (j >= PG_NSL) break; xs = (x0 + j) & 7;
            nxt = 0; if (lane == 0) nxt = (int)__hip_atomic_fetch_add(qctr + 64 * xs, (unsigned)PG_GRP, __ATOMIC_RELAXED, __HIP_MEMORY_SCOPE_AGENT);
            continue; }
        const int xcur = xs;
        nxt = 0; if (lane == 0) nxt = (int)__hip_atomic_fetch_add(qctr + 64 * xs, (unsigned)PG_GRP, __ATOMIC_RELAXED, __HIP_MEMORY_SCOPE_AGENT);
        if constexpr (VPHASE) { const float* hin = xin ? (t0 < T_LAT ? xin : cin - (size_t)T_LAT * DM) : hio;
            peer_v_wave<DLT, W16, H32>(t0, xcur, idx, wh, tab4, adaL, g_off, hin, dl, hio, h16, lane); }
        else peer_u_wave(t0, xcur, xd, xsc, idx, tab4, part, lane);
    }
}

struct Params {
    const float* in[28]; float* out; unsigned char* ws;
};

struct Ctx {
    const Params* P;
    DI unsigned char* ws() const { size_t z = 0; asm volatile("" : "+s"(z)); return P->ws + z; }
    DI float* ada() const { return (float*)(ws() + W.ada); }
    DI float2* rope() const { return (float2*)(ws() + W.rope); }
    DI float* h() const { return (float*)(ws() + W.h); }
    DI bf16_t* a() const { return (bf16_t*)(ws() + W.a); }
    DI bf16_t* q() const { return (bf16_t*)(ws() + W.q); }
    DI bf16_t* kb() const { return (bf16_t*)(ws() + W.k); }
    DI bf16_t* vt() const { return (bf16_t*)(ws() + W.vt); }
    DI bf16_t* o() const { return (bf16_t*)(ws() + W.o); }
    DI bf16_t* ut() const { return (bf16_t*)(ws() + W.ut); }
    DI int* idx() const { return (int*)(ws() + W.idx); }
    DI float* gate() const { return (float*)(ws() + W.gate); }
    DI bf16_t* wqkv() const { return (bf16_t*)(ws() + W.wqkv); }
    DI bf16_t* wo() const { return (bf16_t*)(ws() + W.wo); }
    DI bf16_t* win() const { return (bf16_t*)(ws() + W.win); }
    DI bf16_t* wout() const { return (bf16_t*)(ws() + W.wout); }
    DI bf16_t* wq() const { return (bf16_t*)(ws() + W.wq); }
    DI bf16_t* filt() const { return (bf16_t*)(ws() + W.filt); }
    DI bf16_t* filtc() const { return (bf16_t*)(ws() + W.filtc); }
    DI unsigned char* pu(int L = 0) const { return ws() + W.pu + (size_t)L * (NEXP * DM / 2); }
    DI unsigned char* pv(int L = 0) const { return ws() + W.pv + (size_t)L * (NEXP * DM / 2); }
    DI bf16_t* yt() const { return (bf16_t*)(ws() + W.yt); }
    DI unsigned short* h16() const { return (unsigned short*)(ws() + W.h16); }
    DI unsigned short* dl() const { return (unsigned short*)(ws() + W.dl); }
    DI float* psc(int L = 0) const { return (float*)(ws() + W.psc) + (size_t)L * 2 * NEXP; }
    DI float* part() const { return (float*)(ws() + W.part); }
    DI unsigned* xd() const { return (unsigned*)(ws() + W.xd); }
    DI float* xsc() const { return (float*)(ws() + W.xsc); }
    DI unsigned* wh() const { return (unsigned*)(ws() + W.wh); }
    DI unsigned* qctr() const { return (unsigned*)(ws() + W.bar) + PQ_OFF_WORDS; }
    DI const float* x() const { return P->in[0]; }
    DI const float* ctx() const { return P->in[2]; }
    DI const float* norm_mix_g() const { return P->in[6]; }
    DI const float* norm_ffn_g() const { return P->in[7]; }
    DI const float* attn_sink() const { return P->in[11]; }
    DI const float* hy_conv_w() const { return P->in[13]; }
    DI const float* hy_conv_b() const { return P->in[14]; }
    DI const float* peer_keys1() const { return P->in[24]; }
    DI const float* peer_keys2() const { return P->in[25]; }
    DI const float* peer_u() const { return P->in[26]; }
    DI const float* peer_v() const { return P->in[27]; }
};
template <int I> DI void run_layer(const XcdBarrier& bar, const Ctx& C, unsigned char* lds) {
    constexpr bool is_attn = (I % 2) == 0, ctx_upd = I < 2; constexpr int j = I / 2;
    constexpr bool H16 = DELTA_LAYERS == 3;
    constexpr bool DLT = DELTA_LAYERS == 3 || (DELTA_LAYERS == 1 && is_attn) || (DELTA_LAYERS == 2 && !is_attn);
    const float* adaL = C.ada() + (size_t)I * 9 * NMOD * DM;
    constexpr int rows_a = I <= 2 ? T_ALL : T_LAT;
    constexpr int rows_u = ctx_upd ? T_ALL : T_LAT;
    const float* x0 = I == 0 ? C.x() : nullptr; const float* ctx0 = I == 0 ? C.ctx() : nullptr;
    const int Gn = (int)gridDim.x, cb_ = (int)blockIdx.x;
#define CVT_PULL(n) p_cvt_pull((unsigned*)(C.ws() + W.bar) + CVT_Q_WORD, (n), (I + 1) * (2 * NEXP / CVT_CHUNK), C.peer_u(), C.peer_v(), C.pu(), C.pv(), C.psc())
#define CVT_TAIL(mine, most) do { if ((mine) < (most)) CVT_PULL((most) - (mine)); } while (0)
    p_normmod<false, is_attn>(make_vb(lds), C.h(), x0, ctx0, C.norm_mix_g() + I * DM, adaL, 0, DM, C.a(), rows_a, nullptr, nullptr, nullptr, H16 && I > 0 ? C.h16() : nullptr);
    xcd_barrier(bar);
    if constexpr (is_attn) {
        const unsigned char* wj = (const unsigned char*)C.wqkv() + (size_t)j * QKVW * DM; const int G = (int)gridDim.x;
        p_gemm8(lds, C.a(), wj, T_ALL, 2560, DM, (int)blockIdx.x, EpiQK{C.q(), C.kb(), C.rope()}, F8_SC_AW);
        p_gemm8(lds, wj + (size_t)2560 * DM, C.a(), 512, T_ALL, DM, (int)((blockIdx.x + G - (720 % G)) % G), EpiBfP{C.vt(), T_ALL}, F8_SC_AW);
        {   const int cv = (cb_ + Gn - (720 % Gn)) % Gn; const int mine = gemm_units_of(T_ALL, 2560, Gn, cb_) + gemm_units_of(512, T_ALL, Gn, cv), most = (864 + Gn - 1) / Gn; CVT_TAIL(mine, most); }
        xcd_barrier(bar);
        p_attn(lds, C.q(), C.kb(), C.vt(), C.attn_sink() + j * NQH, C.o(), ctx_upd);
        if (PROBE_DUP == 3) p_attn(lds, C.q(), C.kb(), C.vt(), C.attn_sink() + j * NQH, C.o(), ctx_upd);
        xcd_barrier(bar);
        if constexpr (DLT) p_gemm8(lds, C.o(), (const unsigned char*)C.wo() + (size_t)j * DM * DM, rows_u, DM, DM, (int)blockIdx.x, EpiDelta{C.dl(), adaL, 2 * DM}, F8_SC_OW);
        else p_gemm8(lds, C.o(), (const unsigned char*)C.wo() + (size_t)j * DM * DM, rows_u, DM, DM, (int)blockIdx.x, EpiResid{C.h(), x0, ctx0, C.h(), adaL, 2 * DM}, F8_SC_OW);
        CVT_TAIL(gemm_units_of(rows_u, DM, Gn, cb_), ((rows_u / 256) * (DM / 256) + Gn - 1) / Gn);
    } else {
        p_gemm(lds, C.win() + (size_t)j * 3 * DM * DM, C.a(), 3 * DM, rows_u, DM, (int)blockIdx.x, EpiBfP{C.ut(), T_ALL});
        CVT_TAIL(gemm_units_of(3 * DM, rows_u, Gn, cb_), ((3 * DM / 256) * (rows_u / 256) + Gn - 1) / Gn);
        xcd_barrier(bar);
        p_hyena<ctx_upd>(lds, C.ut(), C.hy_conv_w() + (size_t)j * 9 * DM, C.hy_conv_b() + (size_t)j * 3 * DM, C.filt() + (size_t)j * 2 * DM * 4096, C.filtc(), C.yt());
        if (PROBE_DUP == 3) p_hyena<ctx_upd>(lds, C.ut(), C.hy_conv_w() + (size_t)j * 9 * DM, C.hy_conv_b() + (size_t)j * 3 * DM, C.filt() + (size_t)j * 2 * DM * 4096, C.filtc(), C.yt());
        xcd_barrier(bar);
        p_transpose_yt(lds, C.yt(), C.o(), rows_u);
        xcd_barrier(bar);
        if constexpr (DLT) p_gemm(lds, C.o(), C.wout() + (size_t)j * DM * DM, rows_u, DM, DM, (int)blockIdx.x, EpiDelta{C.dl(), adaL, 2 * DM});
        else p_gemm(lds, C.o(), C.wout() + (size_t)j * DM * DM, rows_u, DM, DM, (int)blockIdx.x, EpiResidP{C.h(), adaL, 2 * DM});
        CVT_TAIL(gemm_units_of(rows_u, DM, Gn, cb_), ((rows_u / 256) * (DM / 256) + Gn - 1) / Gn);
    }
    xcd_barrier(bar);
    p_normmod<true, true>(make_vb(lds), C.h(), DLT ? x0 : nullptr, DLT ? ctx0 : nullptr, C.norm_ffn_g() + I * DM, adaL, 3 * DM, 4 * DM, C.a(), rows_u, C.xd(), C.xsc(), DLT ? C.dl() : nullptr, H16 && I > 0 ? C.h16() : nullptr);
    xcd_barrier(bar);
    p_gemm8(lds, C.a(), (const unsigned char*)C.wq() + (size_t)I * DM * DM, rows_u, DM, DM, (int)blockIdx.x, EpiBfP{C.q(), DM}, F8_SC_AW);
    CVT_TAIL(gemm_units_of(rows_u, DM, Gn, cb_), ((rows_u / 256) * (DM / 256) + Gn - 1) / Gn);
    xcd_barrier(bar);
    p_peer_topk(lds, C.q(), C.peer_keys1() + (size_t)I * 8 * 128 * 128, C.peer_keys2() + (size_t)I * 8 * 128 * 128, C.idx(), C.gate(), rows_u);
    if (PROBE_DUP == 3) p_peer_topk(lds, C.q(), C.peer_keys1() + (size_t)I * 8 * 128 * 128, C.peer_keys2() + (size_t)I * 8 * 128 * 128, C.idx(), C.gate(), rows_u);
    CVT_PULL(-1);
    xcd_barrier(bar);
    p_peer_sliced<false>(C.qctr() + 64 * PG_NSL * (2 * I), rows_u, C.xd(), C.xsc(), C.idx(), C.wh(), C.part(), (const unsigned char*)C.pu(I), adaL, 5 * DM, C.h());
    xcd_barrier(bar);
    p_peer_combine(C.idx(), C.gate(), C.wh(), C.part(), C.psc(I), rows_u);
    xcd_barrier(bar);
    p_peer_sliced<true, DLT, H16, (!H16 || I == 0)>(C.qctr() + 64 * PG_NSL * (2 * I + 1), rows_u, C.xd(), C.xsc(), C.idx(), C.wh(), C.part(), (const unsigned char*)C.pv(I), adaL, 5 * DM, C.h(), DLT ? x0 : nullptr, DLT ? ctx0 : nullptr, C.dl(), C.h16());
    xcd_barrier(bar);
#undef CVT_PULL
#undef CVT_TAIL
}

__global__ void __launch_bounds__(512, 2) mega_fwd(Params P) {
    extern __shared__ __attribute__((aligned(16))) unsigned char lds[];
    volatile LAS unsigned* xbw = (volatile LAS unsigned*)(LAS unsigned char*)(lds + 2 * LDS_HALF);
    if (threadIdx.x < 4) xbw[threadIdx.x] = 0u;
    __syncthreads();
    unsigned char* ws = P.ws;
    XcdBarrier bar = xcd_barrier_post((unsigned*)(ws + W.bar), xbw);

    const float* c = P.in[1]; const float* c_ctx = P.in[3];
    const float* ada_w = P.in[4]; const float* ada_b = P.in[5];
    const float* final_g = P.in[8]; const float* attn_w_qkv = P.in[9]; const float* attn_w_o = P.in[10];
    const float* hy_w_in = P.in[12]; const float* hy_f_w1 = P.in[15];
    const float* hy_f_b1 = P.in[16]; const float* hy_f_w2 = P.in[17]; const float* hy_f_b2 = P.in[18]; const float* hy_f_w3 = P.in[19];
    const float* hy_decay = P.in[20]; const float* hy_fbias = P.in[21]; const float* hy_w_out = P.in[22]; const float* peer_w_q = P.in[23];
    float* cond = (float*)(ws + W.cond); float* h3 = (float*)(ws + W.h3);
    Ctx C; C.P = &P;

    p_cond(make_vb(lds), c, c_ctx, cond);
    p_rope(make_vb(lds), C.rope());
    for (int j = 0; j < 2; ++j) {
        p_wt<true>(make_vb(lds), attn_w_qkv + (size_t)j * DM * QKVW, (bf16_t*)((unsigned char*)C.wqkv() + (size_t)j * QKVW * DM), DM, QKVW, 2560);
        p_wt<true>(make_vb(lds), attn_w_o + (size_t)j * DM * DM, (bf16_t*)((unsigned char*)C.wo() + (size_t)j * DM * DM), DM, DM, 0);
        p_wt(make_vb(lds), hy_w_in + (size_t)j * DM * 3 * DM, C.win() + (size_t)j * 3 * DM * DM, DM, 3 * DM, 0);
        p_wt(make_vb(lds), hy_w_out + (size_t)j * DM * DM, C.wout() + (size_t)j * DM * DM, DM, DM, 0);
        float* h3l = h3 + (size_t)j * (SEQ + CTX) * 64;
        p_hy_h3(make_vb(lds), hy_f_w1 + j * 33 * 64, hy_f_b1 + j * 64, hy_f_w2 + j * 2 * 64 * 64, hy_f_b2 + j * 2 * 64, h3l, SEQ);
        if (j == 0) p_hy_h3(make_vb(lds), hy_f_w1, hy_f_b1, hy_f_w2, hy_f_b2, h3l + SEQ * 64, CTX);
    }
    for (int i = 0; i < 4; ++i) p_wt<true>(make_vb(lds), peer_w_q + (size_t)i * DM * DM, (bf16_t*)((unsigned char*)C.wq() + (size_t)i * DM * DM), DM, DM, 0);
    xcd_barrier(bar);
    p_ada2(lds, cond, ada_w, ada_b, C.ada());
    for (int j = 0; j < 2; ++j) {
        float* h3l = h3 + (size_t)j * (SEQ + CTX) * 64;
        p_hy_filt3<SEQ>(h3l, hy_f_w3 + (size_t)j * 64 * 4 * DM, hy_decay + j * 2 * DM, hy_fbias + j * 2 * DM, C.filt() + (size_t)j * 2 * DM * 4096);
        if (j == 0) p_hy_filt3<CTX>(h3l + SEQ * 64, hy_f_w3, hy_decay, hy_fbias, C.filtc());
    }
    xcd_barrier(bar);
    run_layer<0>(bar, C, lds);
    run_layer<1>(bar, C, lds);
    run_layer<2>(bar, C, lds);
    run_layer<3>(bar, C, lds);
    p_final(make_vb(lds), C.h16(), final_g, P.out);
}

extern "C" void kernel_launch(void* const* d_in, const int* in_sizes, int n_in, void* d_out, int out_size, void* d_ws, size_t ws_size, hipStream_t stream) {
    static int grid = 0;
    if (grid == 0) {
        if (n_in != 28 || ws_size < W.end) { fprintf(stderr, "kernel_launch: bad inputs / workspace too small: %zu < %zu\n", ws_size, W.end); grid = -1; return; }
        int dev = 0, cus = 0, per_cu = 0;
        if (hipGetDevice(&dev) != hipSuccess || hipDeviceGetAttribute(&cus, hipDeviceAttributeMultiprocessorCount, dev) != hipSuccess) { grid = -1; return; }
        if (hipFuncSetAttribute((const void*)mega_fwd, hipFuncAttributeMaxDynamicSharedMemorySize, LDS_BYTES) != hipSuccess) { fprintf(stderr, "kernel_launch: hipFuncSetAttribute failed\n"); grid = -1; return; }
        if (hipOccupancyMaxActiveBlocksPerMultiprocessor(&per_cu, (const void*)mega_fwd, 512, LDS_BYTES) != hipSuccess || per_cu < 1) fprintf(stderr, "kernel_launch: occupancy query says %d\n", per_cu);
        (void)hipGetLastError();
        grid = cus;
    }
    if (grid < 0) return;
    (void)hipMemsetAsync((unsigned char*)d_ws + W.bar, 0, 128 * 1024, stream);
    Params P{};
    for (int i = 0; i < 28; ++i) P.in[i] = (const float*)d_in[i];
    P.out = (float*)d_out; P.ws = (unsigned char*)d_ws;
    hipLaunchKernelGGL(mega_fwd, dim3(grid), dim3(512), LDS_BYTES, stream, P);
}
```
